# Optimizing an MI355X kernel written in HIP

```python
import math
import jax, jax.numpy as jnp
from jax import lax
import numpy as np

D_MODEL = 2048
BATCH = 32
SEQ = 256
DEPTH = 2
DEC_BATCH = 8
DEC_SEQ = 1024
PAST_LEN = 512

GRID_W = 64
N_FNO_LAYERS = (DEPTH + 1) // 2
N_SSD_LAYERS = DEPTH // 2
FNO_WIDTH = 2 * D_MODEL
FNO_GROUPS = 16
FNO_GROUP_DIM = FNO_WIDTH // FNO_GROUPS
SSD_WIDTH = 2 * D_MODEL
SSD_HEAD_DIM = 64
SSD_HEADS = SSD_WIDTH // SSD_HEAD_DIM
SSD_GROUPS = 8
SSD_D_STATE = 128
SSD_CONV_W = 5
SSD_CONV_DIM = SSD_WIDTH + 2 * SSD_GROUPS * SSD_D_STATE
SSD_IN_DIM = SSD_WIDTH + SSD_CONV_DIM + 2 * SSD_HEADS
CHUNK = 128
DEEPNORM_ALPHA = (2 * DEPTH) ** 0.25
DEEPNORM_BETA = (8 * DEPTH) ** -0.25
LN_EPS = 1e-5

kernel_name = "fnet_ssd_hybrid_diffusion_step"


def _layer_norm(x, g=None, b=None):
    xf = x.astype(jnp.float32)
    mu = jnp.mean(xf, axis=-1, keepdims=True)
    var = jnp.mean(jnp.square(xf - mu), axis=-1, keepdims=True)
    y = (xf - mu) * lax.rsqrt(var + LN_EPS)
    if g is not None:
        y = y * g.astype(jnp.float32) + b.astype(jnp.float32)
    return y.astype(x.dtype)


def _rms_norm(x, w):
    xf = x.astype(jnp.float32)
    y = xf * lax.rsqrt(jnp.mean(jnp.square(xf), axis=-1, keepdims=True) + LN_EPS)
    return (y * w.astype(jnp.float32)).astype(x.dtype)


def _sincos_1d(pos, dim):
    omega = 1.0 / (10000.0 ** (jnp.arange(dim // 2, dtype=jnp.float32) / (dim / 2)))
    ang = pos.astype(jnp.float32)[:, None] * omega[None, :]
    return jnp.concatenate([jnp.sin(ang), jnp.cos(ang)], axis=-1)


def _grid_pos_embed(n_tokens, dim):
    t = jnp.arange(n_tokens)
    row, col = t // GRID_W, t % GRID_W
    return jnp.concatenate([_sincos_1d(row, dim // 2), _sincos_1d(col, dim // 2)], axis=-1)


def _centred_dwconv(u, w, bias):
    pad = SSD_CONV_W // 2
    L = u.shape[1]
    up = jnp.pad(u, ((0, 0), (pad, pad), (0, 0)))
    acc = bias
    for k in range(SSD_CONV_W):
        acc = acc + up[:, k:k + L] * w[k]
    return acc


def _segsum_exp(a_cs):
    T = a_cs.shape[-1]
    diff = a_cs[..., :, None] - a_cs[..., None, :]
    mask = jnp.tril(jnp.ones((T, T), dtype=bool))
    return jnp.where(mask, jnp.exp(jnp.where(mask, diff, 0.0)), 0.0)


def _ssd_scan(x, dt, a, bm, cm, init):
    b, L, H, P = x.shape
    G, N = bm.shape[2], bm.shape[3]
    R = H // G
    nc = L // CHUNK
    x = x.astype(jnp.float32)
    dt = dt.astype(jnp.float32)
    xdt = (x * dt[..., None]).reshape(b, nc, CHUNK, G, R, P)
    da = (dt * a.astype(jnp.float32)).reshape(b, nc, CHUNK, G, R).transpose(0, 3, 4, 1, 2)
    bm = bm.astype(jnp.float32).reshape(b, nc, CHUNK, G, N)
    cm = cm.astype(jnp.float32).reshape(b, nc, CHUNK, G, N)
    a_cs = jnp.cumsum(da, axis=-1)
    lmat = _segsum_exp(a_cs)
    y_diag = jnp.einsum('bclgn,bcsgn,bgrcls,bcsgrp->bclgrp', cm, bm, lmat, xdt)
    decay_states = jnp.exp(a_cs[..., -1:] - a_cs)
    states = jnp.einsum('bclgn,bgrcl,bclgrp->bcgrpn', bm, decay_states, xdt)
    init = init.astype(jnp.float32).reshape(b, 1, G, R, P, N)
    states = jnp.concatenate([init, states], axis=1)
    chunk_tot = jnp.pad(a_cs[..., -1], ((0, 0), (0, 0), (0, 0), (1, 0)))
    decay_chunk = _segsum_exp(jnp.cumsum(chunk_tot, axis=-1))
    new_states = jnp.einsum('bgrzc,bcgrpn->bzgrpn', decay_chunk, states)
    states_in, final = new_states[:, :-1], new_states[:, -1]
    y_off = jnp.einsum('bclgn,bcgrpn,bgrcl->bclgrp', cm, states_in, jnp.exp(a_cs))
    y = (y_diag + y_off).reshape(b, L, H, P)
    return y, final.reshape(b, H, P, N)


def _fourier_mixer(h, w_in, w_out):
    b, L, _ = h.shape
    uz = h @ w_in
    u, z = uz[..., :FNO_WIDTH], uz[..., FNO_WIDTH:]
    u = u.reshape(b, L, FNO_GROUPS, FNO_GROUP_DIM).astype(jnp.float32)
    y = jnp.fft.fftn(u, axes=(1, 3), norm='ortho').real
    y = y.reshape(b, L, FNO_WIDTH).astype(h.dtype) * jax.nn.silu(z)
    return y @ w_out


def _ssd_mixer(h, init, w_in, conv_w, conv_b, dt_bias, a_log, d_skip, norm_w, w_out):
    b, L, _ = h.shape
    proj = h @ w_in
    z = proj[..., :SSD_WIDTH]
    xbc = proj[..., SSD_WIDTH:SSD_WIDTH + SSD_CONV_DIM]
    dt_raw = proj[..., SSD_WIDTH + SSD_CONV_DIM:].reshape(b, L, 2, SSD_HEADS)
    xbc = jax.nn.silu(_centred_dwconv(xbc, conv_w, conv_b))
    gn = SSD_GROUPS * SSD_D_STATE
    xs = xbc[..., :SSD_WIDTH].reshape(b, L, SSD_HEADS, SSD_HEAD_DIM)
    bm = xbc[..., SSD_WIDTH:SSD_WIDTH + gn].reshape(b, L, SSD_GROUPS, SSD_D_STATE)
    cm = xbc[..., SSD_WIDTH + gn:].reshape(b, L, SSD_GROUPS, SSD_D_STATE)
    dt = jax.nn.softplus(dt_raw.astype(jnp.float32) + dt_bias.astype(jnp.float32))
    a = -jnp.exp(a_log.astype(jnp.float32))
    y_f, s_f = _ssd_scan(xs, dt[:, :, 0], a[0], bm, cm, init[:, 0])
    flip = lambda t: jnp.flip(t, axis=1)
    y_b, s_b = _ssd_scan(flip(xs), flip(dt[:, :, 1]), a[1], flip(bm), flip(cm), init[:, 1])
    y = y_f + flip(y_b) + d_skip.astype(jnp.float32)[:, None] * xs.astype(jnp.float32)
    y = y.reshape(b, L, SSD_WIDTH).astype(h.dtype) * jax.nn.silu(z)
    y = _rms_norm(y, norm_w)
    return y @ w_out, jnp.stack([s_f, s_b], axis=1)


def _trunk(x, cond, init_states, w_ada, b_ada, ln_g, ln_b, fno_w_in, fno_w_out,
           ssd_w_in, ssd_conv_w, ssd_conv_b, ssd_dt_bias, ssd_a_log, ssd_d, ssd_norm_w, ssd_w_out):
    finals = []
    for i in range(DEPTH):
        mod = jax.nn.silu(cond) @ w_ada[i] + b_ada[i]
        shift = mod[:, None, :D_MODEL]
        scale = mod[:, None, D_MODEL:2 * D_MODEL]
        gate = mod[:, None, 2 * D_MODEL:]
        h = _layer_norm(x) * (1.0 + scale) + shift
        j = i // 2
        if i % 2 == 0:
            out = _fourier_mixer(h, fno_w_in[j], fno_w_out[j])
        else:
            out, fin = _ssd_mixer(h, init_states[:, j], ssd_w_in[j], ssd_conv_w[j], ssd_conv_b[j],
                                  ssd_dt_bias[j], ssd_a_log[j], ssd_d[j], ssd_norm_w[j], ssd_w_out[j])
            finals.append(fin)
        x = _layer_norm(DEEPNORM_ALPHA * x + gate * out, ln_g[i], ln_b[i])
    return x, finals


def setup_inputs(seed: int = 0) -> dict:
    key = jax.random.key(seed)
    ks = jax.random.split(key, 24)
    f32 = jnp.float32
    nrm = lambda k, s, sc: jax.random.normal(k, s, f32) * sc
    dt0 = jnp.exp(jax.random.uniform(ks[14], (N_SSD_LAYERS, 2, SSD_HEADS), f32,
                                     math.log(1e-3), math.log(1e-1)))
    return {
        "x_prompt": nrm(ks[0], (BATCH, SEQ, D_MODEL), 1.0),
        "x_sample": nrm(ks[1], (DEC_BATCH, DEC_SEQ, D_MODEL), 1.0),
        "state_ssd_ctx": nrm(ks[2], (DEC_BATCH, N_SSD_LAYERS, 2, SSD_HEADS, SSD_HEAD_DIM, SSD_D_STATE), 0.1),
        "c": nrm(ks[3], (DEC_BATCH, D_MODEL), 1.0),
        "c_ctx": nrm(ks[4], (D_MODEL,), 1.0),
        "w_ada": nrm(ks[5], (DEPTH, D_MODEL, 3 * D_MODEL), 0.5 * D_MODEL ** -0.5),
        "b_ada": nrm(ks[6], (DEPTH, 3 * D_MODEL), 0.02),
        "ln_g": 1.0 + nrm(ks[7], (DEPTH, D_MODEL), 0.02),
        "ln_b": nrm(ks[8], (DEPTH, D_MODEL), 0.02),
        "fno_w_in": nrm(ks[9], (N_FNO_LAYERS, D_MODEL, 2 * FNO_WIDTH), D_MODEL ** -0.5),
        "fno_w_out": nrm(ks[10], (N_FNO_LAYERS, FNO_WIDTH, D_MODEL), DEEPNORM_BETA * FNO_WIDTH ** -0.5),
        "ssd_w_in": nrm(ks[11], (N_SSD_LAYERS, D_MODEL, SSD_IN_DIM), D_MODEL ** -0.5),
        "ssd_conv_w": nrm(ks[12], (N_SSD_LAYERS, SSD_CONV_W, SSD_CONV_DIM), SSD_CONV_W ** -0.5),
        "ssd_conv_b": nrm(ks[13], (N_SSD_LAYERS, SSD_CONV_DIM), 0.02),
        "ssd_dt_bias": dt0 + jnp.log(-jnp.expm1(-dt0)),
        "ssd_a_log": jnp.log(jax.random.uniform(ks[15], (N_SSD_LAYERS, 2, SSD_HEADS), f32, 1.0, 16.0)),
        "ssd_d": 1.0 + nrm(ks[16], (N_SSD_LAYERS, SSD_HEADS), 0.1),
        "ssd_norm_w": 1.0 + nrm(ks[17], (N_SSD_LAYERS, SSD_WIDTH), 0.02),
        "ssd_w_out": nrm(ks[18], (N_SSD_LAYERS, SSD_WIDTH, D_MODEL), DEEPNORM_BETA * SSD_WIDTH ** -0.5),
    }


def reference(x_prompt, x_sample, state_ssd_ctx, c, c_ctx, w_ada, b_ada, ln_g, ln_b,
              fno_w_in, fno_w_out, ssd_w_in, ssd_conv_w, ssd_conv_b, ssd_dt_bias, ssd_a_log,
              ssd_d, ssd_norm_w, ssd_w_out):
    weights = (w_ada, b_ada, ln_g, ln_b, fno_w_in, fno_w_out, ssd_w_in, ssd_conv_w, ssd_conv_b,
               ssd_dt_bias, ssd_a_log, ssd_d, ssd_norm_w, ssd_w_out)
    zero_init = jnp.zeros((x_prompt.shape[0], N_SSD_LAYERS, 2, SSD_HEADS, SSD_HEAD_DIM, SSD_D_STATE),
                          dtype=jnp.float32)
    y_prompt, finals = _trunk(x_prompt, c_ctx[None, :], zero_init, *weights)
    state_ssd = jnp.stack(finals, axis=1).astype(x_prompt.dtype)
    n_lat = x_sample.shape[1]
    pos = _grid_pos_embed(n_lat, D_MODEL).astype(x_sample.dtype)
    y_sample, _ = _trunk(x_sample + pos[None], c, state_ssd_ctx, *weights)
    return (y_prompt, y_sample, state_ssd)
```

```cpp
#include <hip/hip_runtime.h>
#include <cstdio>
#include <cstdint>

#ifndef MK_PER_PHASE
#define MK_PER_PHASE 0
#endif
#ifndef MK_CHECK
#define MK_CHECK 0
#endif

#define GAS __attribute__((address_space(1)))
#define LAS __attribute__((address_space(3)))
typedef unsigned short bf16;
typedef unsigned v4u __attribute__((ext_vector_type(4)));
typedef unsigned v2u __attribute__((ext_vector_type(2)));
typedef float f32x4 __attribute__((ext_vector_type(4)));
typedef short bf16x8 __attribute__((ext_vector_type(8)));
#define LDS_WAIT() asm volatile("s_waitcnt lgkmcnt(0)" ::: "memory")
#define VM_WAIT() asm volatile("s_waitcnt vmcnt(0)" ::: "memory")

constexpr int NWAVES = 8, NTHR = 512;
constexpr int DM = 2048, NTOK = 16384, NPR = 8192, LPR = 256, LSA = 1024, NBP = 32, NBS = 8;
constexpr int FW = 4096;
constexpr int SSD_IN = 10368, SSD_IN_PAD = 10496, CONVD = 6144;
constexpr float LN_EPS = 1e-5f;
constexpr float DN_ALPHA = 1.41421356237f;
constexpr int NPHASE = 12;

constexpr size_t MiB = 1u << 20;
constexpr size_t WS_CTL = 0, WS_MOD = 1 * MiB, CTL_ZERO_BYTES = 2 * MiB;
constexpr size_t WS_D256 = 2 * MiB, WS_A4P = 3 * MiB, WS_A4S = 4 * MiB, WS_POS = 8 * MiB;
constexpr size_t WS_WFI = 16 * MiB, WS_WFO = 48 * MiB, WS_WSI = 64 * MiB, WS_WSO = 106 * MiB;
constexpr size_t WS_DT = 122 * MiB, WS_SSQ = 130 * MiB, WS_CHK = 131 * MiB;
constexpr size_t WS_H = 132 * MiB, WS_U = 196 * MiB, WS_Z = 324 * MiB, WS_T = 452 * MiB, WS_V = 708 * MiB, WS_Y = 836 * MiB, WS_END = 964 * MiB;
constexpr size_t WS_XBC = WS_T, WS_BC = 644 * MiB, WS_XS = WS_U;
constexpr int CW_BAR = 4096;

constexpr int LDS_BYTES = 163840;
constexpr int MISC_OFF = LDS_BYTES - 256;

__device__ __forceinline__ unsigned f2bf(float f) { unsigned u = __builtin_bit_cast(unsigned, f); return (u + 0x7fffu + ((u >> 16) & 1u)) >> 16; }
__device__ __forceinline__ unsigned pk2(float lo, float hi) { return f2bf(lo) | (f2bf(hi) << 16); }
__device__ __forceinline__ float bf_lo(unsigned w) { return __builtin_bit_cast(float, w << 16); }
__device__ __forceinline__ float bf_hi(unsigned w) { return __builtin_bit_cast(float, w & 0xffff0000u); }
__device__ __forceinline__ float bf2f(bf16 b) { return __builtin_bit_cast(float, ((unsigned)b) << 16); }
__device__ __forceinline__ float silu_f(float x) { return x / (1.f + __expf(-x)); }
__device__ __forceinline__ float wave_sum(float v) {
#pragma unroll
    for (int o = 1; o < 64; o <<= 1) v += __shfl_xor(v, o);
    return v;
}

#define XB_TMO      128
#define XB_XCNT(j)  (256  + 64 * (j))
#define XB_XSUB(j)  (1280 + 64 * (j))
#define XB_XGEN(j)  (2304 + 64 * (j))
#define XB_TOP      3328
#define XB_TOPGEN   3392
#define XCD_BAR_WORDS 3456
#define XB_SPIN_CAP (1u << 20)
__device__ __forceinline__ unsigned xb_ld(unsigned* p)              { return __hip_atomic_load(p, __ATOMIC_RELAXED, __HIP_MEMORY_SCOPE_AGENT); }
__device__ __forceinline__ unsigned xb_add(unsigned* p, unsigned v) { return __hip_atomic_fetch_add(p, v, __ATOMIC_RELAXED, __HIP_MEMORY_SCOPE_AGENT); }
__device__ __forceinline__ unsigned xb_xcc_id() { return (unsigned)__builtin_amdgcn_s_getreg((3 << 11) | 20) & 0xFu; }
#define XB_SPIN(cond, bar) do { unsigned _sp = 0; while (cond) { __builtin_amdgcn_s_sleep(1); \
    if ((++_sp & 255u) == 0u) { if (xb_ld(&(bar)[XB_TMO])) break; if (_sp > XB_SPIN_CAP) { atomicAdd(&(bar)[XB_TMO], 1u); break; } } } } while (0)
struct XcdBarrier { unsigned* bar; unsigned x; volatile LAS unsigned* st; };
__device__ __forceinline__ XcdBarrier xcd_barrier_post(unsigned* bar, volatile LAS unsigned* st) {
    XcdBarrier b; b.bar = bar; b.x = xb_xcc_id(); b.st = st;
    if (threadIdx.x == 0) (void)xb_add(&bar[XB_XCNT(b.x)], 1u);
    return b;
}
__device__ __forceinline__ void xcd_barrier_complete(unsigned* bar, unsigned x, unsigned& nloc, unsigned& nx) {
    const unsigned G = gridDim.x * gridDim.y * gridDim.z;
    unsigned sum, cnt, mine, sp = 0u;
    for (;;) {
        sum = 0u; cnt = 0u; mine = 0u;
#pragma unroll
        for (unsigned j = 0; j < 16; ++j) { const unsigned c = xb_ld(&bar[XB_XCNT(j)]); sum += c; cnt += (c > 0u) ? 1u : 0u; mine = (j == x) ? c : mine; }
        if (sum == G) break;
        __builtin_amdgcn_s_sleep(1);
        if ((++sp & 255u) == 0u) { if (xb_ld(&bar[XB_TMO])) break; if (sp > XB_SPIN_CAP) { atomicAdd(&bar[XB_TMO], 1u); break; } }
    }
    nloc = mine > 0u ? mine : 1u; nx = cnt > 0u ? cnt : 1u;
}
__device__ __forceinline__ void xcd_barrier(const XcdBarrier& b) {
    asm volatile("s_waitcnt vmcnt(0)" ::: "memory");
    __syncthreads();
    if (threadIdx.x == 0) {
        unsigned* bar = b.bar;
        __builtin_amdgcn_s_waitcnt(0);
        unsigned nloc = b.st[0], nx = b.st[1];
        if (nloc == 0u) { xcd_barrier_complete(bar, b.x, nloc, nx); b.st[0] = nloc; b.st[1] = nx; }
        const unsigned old = xb_add(&bar[XB_XSUB(b.x)], 1u);
        const unsigned gen = old / nloc;
        if (old + 1u == (gen + 1u) * nloc) {
            __builtin_amdgcn_fence(__ATOMIC_RELEASE, "agent");
            asm volatile("s_waitcnt vmcnt(0)" ::: "memory");
            const unsigned og = xb_add(&bar[XB_TOP], 1u);
            const unsigned tg = og / nx;
            if (og + 1u == (tg + 1u) * nx) xb_add(&bar[XB_TOPGEN], 1u);
            else XB_SPIN(xb_ld(&bar[XB_TOPGEN]) == tg, bar);
            __builtin_amdgcn_fence(__ATOMIC_ACQUIRE, "agent");
            xb_add(&bar[XB_XGEN(b.x)], 1u);
            asm volatile("s_waitcnt vmcnt(0)" ::: "memory");
        } else {
            XB_SPIN(xb_ld(&bar[XB_XGEN(b.x)]) == gen, bar);
            __builtin_amdgcn_fence(__ATOMIC_ACQUIRE, "agent");
            asm volatile("s_waitcnt vmcnt(0)" ::: "memory");
        }
    }
    __syncthreads();
}

struct Args { const float* in[19]; float* out; unsigned char* ws; int ph_lo, ph_hi; };
struct Frame {
    LAS unsigned char* lds;
    int tid, lane, wave, G, bx;
    const float *x_prompt, *x_sample, *state_ctx, *c, *c_ctx, *w_ada, *b_ada, *ln_g, *ln_b, *fno_w_in, *fno_w_out, *ssd_w_in, *conv_w, *conv_b, *dt_bias, *a_log, *d_skip, *norm_w, *ssd_w_out;
    float* out; unsigned char* ws;
};
__device__ __forceinline__ int row0_of(int bb) { return bb < NBP ? bb * LPR : NPR + (bb - NBP) * LSA; }
__device__ __forceinline__ size_t tb_of(int bb) { return bb < NBP ? (size_t)bb * FW * 2 * LPR : (size_t)NBP * FW * 2 * LPR + (size_t)(bb - NBP) * FW * 2 * LSA; }
__device__ __forceinline__ int cond_of_row(int r) { return r < NPR ? 0 : 1 + (r - NPR) / LSA; }

namespace pg8 {
constexpr int BM = 256, BK = 64, HALF = 128, HTB = HALF * BK * 2, NXCD = 8, WGM = 8;
__host__ __device__ __forceinline__ int lds_byte(int r, int c) { const int st = (r >> 4) * 2 + (c >> 5), rr = r & 15, cc = c & 31, ob = rr * 64 + cc * 2; return st * 1024 + (ob ^ (((ob >> 9) & 1) << 5)); }
__host__ __device__ __forceinline__ void stage_rc(int b, int& R, int& C) { const int st = b / 1024, sb = b % 1024, swz = sb ^ (((sb >> 9) & 1) << 5); R = (st >> 1) * 16 + swz / 64; C = (st & 1) * 32 + (swz % 64) / 2; }
__host__ __device__ __forceinline__ int perm32(int rho) { const int n = rho >> 4, i = rho & 15; return 8 * (i >> 2) + 4 * n + (i & 3); }
struct Unit { const char* a; const char* b; int x0, x1; };
typedef f32x4 Acc[2][2][4][2];

__device__ __forceinline__ bool static_tile(int i, int G, int c, int nM, int nN, int& pm, int& pn) {
    const int nwg = nM * nN; const long L = (long)i * G + c; if (L >= nwg) return false;
    int wgid = (int)L; { const int q = nwg / NXCD, r = nwg % NXCD, xcd = wgid % NXCD, off = wgid / NXCD; wgid = (xcd < r ? xcd * (q + 1) : r * (q + 1) + (xcd - r) * q) + off; }
    const int nig = WGM * nN, gid = wgid / nig, fm = gid * WGM, gsz = (nM - fm) < WGM ? (nM - fm) : WGM;
    pm = fm + ((wgid % nig) % gsz); pn = (wgid % nig) / gsz; return true;
}

template <class Epi, class Sched, bool ALIGN_EPI, bool SP2>
__device__ __forceinline__ void gemm_phase(LAS unsigned char* lds, const int K, const int lda, const int ldb, const Sched& S, const Epi& E) {
    const int tid = threadIdx.x, wid = __builtin_amdgcn_readfirstlane(tid >> 6), lane = tid & 63, wr = wid >> 2, wc = wid & 3, fr = lane & 15, fq = lane >> 4;
    const int nt = K / BK;
    unsigned voffA[2], voffB[2];
#pragma unroll
    for (int i = 0; i < 2; ++i) { int R, C; stage_rc(tid * 16 + i * 8192, R, C); const int Rb = Epi::PERM ? ((R & ~31) + perm32(R & 31)) : R;
        voffA[i] = (unsigned)(R * lda + C) * 2u; voffB[i] = (unsigned)(Rb * ldb + C) * 2u; }
    const size_t kstep = (size_t)(BK * 2);
    const size_t hstepA = (size_t)HALF * lda * 2, hstepB = (size_t)HALF * ldb * 2;
    const unsigned ldsw = (unsigned)wid * 1024u;
    const int aoff = lds_byte(wr * 64 + fr, fq * 8), boff = lds_byte(wc * 32 + fr, fq * 8);
#define PG8_SA(b, h) (((b) * 2 + (h)) * HTB)
#define PG8_SB(b, h) ((4 + (b) * 2 + (h)) * HTB)
#define PG8_STAGE(bufoff, gbase, voff) do { _Pragma("unroll") for (int _i = 0; _i < 2; ++_i) \
        __builtin_amdgcn_global_load_lds((const unsigned*)((const char*)(gbase) + (voff)[_i]), (LAS unsigned*)(lds + (bufoff) + ldsw + _i * 8192), 16, 0, 0); } while (0)
#define PG8_LDA(dst, b, h) do { _Pragma("unroll") for (int m = 0; m < 4; ++m) _Pragma("unroll") for (int k = 0; k < 2; ++k) dst[m][k] = *(const LAS bf16x8*)(lds + PG8_SA(b, h) + aoff + m * 2048 + k * 1024); } while (0)
#define PG8_LDB(dst, b, h) do { _Pragma("unroll") for (int n = 0; n < 2; ++n) _Pragma("unroll") for (int k = 0; k < 2; ++k) dst[n][k] = *(const LAS bf16x8*)(lds + PG8_SB(b, h) + boff + n * 2048 + k * 1024); } while (0)
#define PG8_MMA(ai, bj, At, Bt) do { __builtin_amdgcn_s_setprio(1); _Pragma("unroll") for (int m = 0; m < 4; ++m) _Pragma("unroll") for (int n = 0; n < 2; ++n) _Pragma("unroll") for (int k = 0; k < 2; ++k) \
        acc[ai][bj][m][n] = __builtin_amdgcn_mfma_f32_16x16x32_bf16(Bt[n][k], At[m][k], acc[ai][bj][m][n], 0, 0, 0); __builtin_amdgcn_s_setprio(0); } while (0)
#define PG8_WAIT_V(n) asm volatile("s_waitcnt vmcnt(" #n ")" ::: "memory")
#define PG8_WAIT_L(n) asm volatile("s_waitcnt lgkmcnt(" #n ")" ::: "memory")
#define PG8_BAR __builtin_amdgcn_s_barrier()
#define PG8_SCHED __builtin_amdgcn_sched_barrier(0)
    Unit cur, nxt; int ui = 0;
    if (!S.next(0, cur)) return;
    Acc acc;
#pragma unroll
    for (int a = 0; a < 2; ++a)
#pragma unroll
        for (int b = 0; b < 2; ++b)
#pragma unroll
            for (int m = 0; m < 4; ++m)
#pragma unroll
                for (int n = 0; n < 2; ++n) acc[a][b][m][n] = (f32x4){0.f, 0.f, 0.f, 0.f};
    bf16x8 At[4][2], B0[2][2], B1[2][2];
    const char* cA = cur.a; const char* cB = cur.b;
    if constexpr (SP2) {
        PG8_STAGE(PG8_SB(0, 0), cB, voffB); PG8_STAGE(PG8_SB(0, 1), cB + hstepB, voffB); PG8_STAGE(PG8_SA(0, 0), cA, voffA); PG8_STAGE(PG8_SA(0, 1), cA + hstepA, voffA);
        if (wr == 1) PG8_BAR;
        PG8_WAIT_V(2); PG8_BAR;
        PG8_STAGE(PG8_SB(1, 0), cB + kstep, voffB); PG8_STAGE(PG8_SA(1, 0), cA + kstep, voffA); PG8_STAGE(PG8_SB(1, 1), cB + hstepB + kstep, voffB);
        PG8_WAIT_V(6); PG8_BAR;
    } else {
        PG8_STAGE(PG8_SB(0, 0), cB, voffB); PG8_STAGE(PG8_SA(0, 0), cA, voffA); PG8_STAGE(PG8_SB(0, 1), cB + hstepB, voffB); PG8_STAGE(PG8_SA(0, 1), cA + hstepA, voffA);
        if (wr == 1) PG8_BAR;
        PG8_WAIT_V(4); PG8_BAR;
        PG8_STAGE(PG8_SB(1, 0), cB + kstep, voffB); PG8_STAGE(PG8_SA(1, 0), cA + kstep, voffA); PG8_STAGE(PG8_SB(1, 1), cB + hstepB + kstep, voffB);
        PG8_WAIT_V(6); PG8_BAR;
    }
    for (;;) {
        const bool has_next = S.next(ui + 1, nxt);
        const char* nA = has_next ? nxt.a : cA; const char* nB = has_next ? nxt.b : cB;
#pragma unroll 1
        for (int t = 0; t < nt; t += 2) {
            const bool last = (t == nt - 2);
            const char* a1 = cA + (size_t)(t + 1) * kstep;
            const char* a2 = last ? nA : cA + (size_t)(t + 2) * kstep; const char* b2 = last ? nB : cB + (size_t)(t + 2) * kstep;
            const char* a3 = a2 + kstep; const char* b3 = b2 + kstep;
            if constexpr (SP2) {
            PG8_LDB(B0, 0, 0); PG8_LDB(B1, 0, 1); PG8_SCHED; PG8_LDA(At, 0, 0); PG8_STAGE(PG8_SA(1, 1), a1 + hstepA, voffA);
            PG8_WAIT_V(8); PG8_WAIT_L(0); PG8_BAR; PG8_MMA(0, 0, At, B0); PG8_MMA(0, 1, At, B1); PG8_BAR; PG8_SCHED;
            PG8_LDA(At, 0, 1); PG8_STAGE(PG8_SB(0, 0), b2, voffB); PG8_STAGE(PG8_SB(0, 1), b2 + hstepB, voffB); PG8_STAGE(PG8_SA(0, 0), a2, voffA);
            PG8_WAIT_V(8); PG8_WAIT_L(0); PG8_BAR; PG8_MMA(1, 0, At, B0); PG8_MMA(1, 1, At, B1); PG8_BAR; PG8_SCHED;
            PG8_LDB(B0, 1, 0); PG8_LDB(B1, 1, 1); PG8_SCHED; PG8_LDA(At, 1, 0); PG8_STAGE(PG8_SA(0, 1), a2 + hstepA, voffA);
            PG8_WAIT_V(8); PG8_WAIT_L(0); PG8_BAR; PG8_MMA(0, 0, At, B0); PG8_MMA(0, 1, At, B1); PG8_BAR; PG8_SCHED;
            PG8_LDA(At, 1, 1); PG8_STAGE(PG8_SB(1, 0), b3, voffB); PG8_STAGE(PG8_SB(1, 1), b3 + hstepB, voffB); PG8_STAGE(PG8_SA(1, 0), a3, voffA);
            PG8_WAIT_V(8); PG8_WAIT_L(0); PG8_BAR; PG8_MMA(1, 0, At, B0); PG8_MMA(1, 1, At, B1); PG8_BAR; PG8_SCHED;
            } else {
            PG8_LDB(B0, 0, 0); PG8_SCHED; PG8_LDA(At, 0, 0); PG8_STAGE(PG8_SA(1, 1), a1 + hstepA, voffA);
            PG8_WAIT_L(8); PG8_BAR; PG8_WAIT_L(0); PG8_MMA(0, 0, At, B0); PG8_BAR; PG8_SCHED;
            PG8_LDB(B1, 0, 1); PG8_STAGE(PG8_SB(0, 0), b2, voffB);
            PG8_BAR; PG8_WAIT_L(0); PG8_MMA(0, 1, At, B1); PG8_BAR;
            PG8_LDA(At, 0, 1); PG8_STAGE(PG8_SA(0, 0), a2, voffA);
            PG8_BAR; PG8_WAIT_L(0); PG8_MMA(1, 0, At, B0); PG8_BAR; PG8_SCHED;
            PG8_STAGE(PG8_SB(0, 1), b2 + hstepB, voffB);
            PG8_WAIT_V(6); PG8_BAR; PG8_MMA(1, 1, At, B1); PG8_BAR;
            PG8_LDB(B0, 1, 0); PG8_SCHED; PG8_LDA(At, 1, 0); PG8_STAGE(PG8_SA(0, 1), a2 + hstepA, voffA);
            PG8_WAIT_L(8); PG8_BAR; PG8_WAIT_L(0); PG8_MMA(0, 0, At, B0); PG8_BAR; PG8_SCHED;
            PG8_LDB(B1, 1, 1); PG8_STAGE(PG8_SB(1, 0), b3, voffB);
            PG8_BAR; PG8_WAIT_L(0); PG8_MMA(0, 1, At, B1); PG8_BAR;
            PG8_LDA(At, 1, 1); PG8_STAGE(PG8_SA(1, 0), a3, voffA);
            PG8_BAR; PG8_WAIT_L(0); PG8_MMA(1, 0, At, B0); PG8_BAR; PG8_SCHED;
            PG8_STAGE(PG8_SB(1, 1), b3 + hstepB, voffB);
            PG8_WAIT_V(6); PG8_BAR; PG8_MMA(1, 1, At, B1); PG8_BAR;
            }
        }
        if constexpr (ALIGN_EPI) { if (wr == 0) PG8_BAR; }
        E(acc, cur, wr, wc, fr, fq);
        if (!has_next) break;
#pragma unroll
        for (int a = 0; a < 2; ++a)
#pragma unroll
            for (int b = 0; b < 2; ++b)
#pragma unroll
                for (int m = 0; m < 4; ++m)
#pragma unroll
                    for (int n = 0; n < 2; ++n) acc[a][b][m][n] = (f32x4){0.f, 0.f, 0.f, 0.f};
        cur = nxt; cA = nA; cB = nB; ++ui;
        if constexpr (ALIGN_EPI) { if (wr == 1) PG8_BAR; }
    }
    PG8_WAIT_V(0);
    if constexpr (!ALIGN_EPI) { if (wr == 0) PG8_BAR; }
    PG8_BAR;
#undef PG8_SA
#undef PG8_SB
#undef PG8_STAGE
#undef PG8_LDA
#undef PG8_LDB
#undef PG8_MMA
#undef PG8_WAIT_V
#undef PG8_WAIT_L
#undef PG8_BAR
#undef PG8_SCHED
}
}
using pg8::Unit; using pg8::Acc;
constexpr bool GP_ALIGN = true, GP_SP2 = true;

struct SchedGrid {
    const bf16* A; const bf16* B; int nM, nN, lda, ldb, G, c;
    __device__ __forceinline__ bool next(int i, Unit& u) const { int pm, pn; if (!pg8::static_tile(i, G, c, nM, nN, pm, pn)) return false;
        u.a = (const char*)(A + (size_t)pm * 256 * lda); u.b = (const char*)(B + (size_t)pn * 256 * ldb); u.x0 = pm; u.x1 = pn; return true; }
};
struct EpiUZ { static constexpr bool PERM = true; bf16* U; bf16* Z;
    __device__ __forceinline__ void operator()(const Acc& acc, const Unit& u, int wr, int wc, int fr, int fq) const {
        const int pm = u.x0, pn = u.x1; const bool isz = pn >= 16; bf16* base = isz ? Z : U; const int colt = (isz ? pn - 16 : pn) * 256 + wc * 32 + 8 * fq;
#pragma unroll
        for (int ai = 0; ai < 2; ++ai)
#pragma unroll
            for (int m = 0; m < 4; ++m) { const int r = pm * 256 + ai * 128 + wr * 64 + m * 16 + fr; bf16* rowp = base + (size_t)r * FW + colt;
#pragma unroll
                for (int bj = 0; bj < 2; ++bj) { f32x4 v0 = acc[ai][bj][m][0], v1 = acc[ai][bj][m][1];
                    if (isz) {
#pragma unroll
                        for (int j = 0; j < 4; ++j) { v0[j] = silu_f(v0[j]); v1[j] = silu_f(v1[j]); } }
                    v4u w; w.x = pk2(v0[0], v0[1]); w.y = pk2(v0[2], v0[3]); w.z = pk2(v1[0], v1[1]); w.w = pk2(v1[2], v1[3]);
                    *(v4u*)(rowp + bj * 128) = w; } }
    } };
struct SchedCDFT { const bf16* D; const bf16* U; int G, c;
    __device__ __forceinline__ bool next(int i, Unit& u) const { const long e = (long)i * G + c; if (e >= 2048) return false;
        const int cs = (int)e & 1, q = (int)e >> 1; int bb, g, tn;
        if (q < 512) { bb = q >> 4; g = q & 15; tn = 0; } else { const int q2 = q - 512; bb = NBP + (q2 >> 6); g = (q2 >> 2) & 15; tn = q2 & 3; }
        u.a = (const char*)(D + (size_t)cs * 256 * 256); u.b = (const char*)(U + ((size_t)(row0_of(bb) + tn * 256) * FW + g * 256));
        u.x0 = bb | (g << 8) | (cs << 16) | (tn << 20); u.x1 = 0; return true; } };
struct EpiCDFT { static constexpr bool PERM = true; bf16* T;
    __device__ __forceinline__ void operator()(const Acc& acc, const Unit& u, int wr, int wc, int fr, int fq) const {
        const int bb = u.x0 & 255, g = (u.x0 >> 8) & 255, cs = (u.x0 >> 16) & 15, tn = u.x0 >> 20; const int L = bb < NBP ? LPR : LSA;
        bf16* base = T + tb_of(bb) + (size_t)(g * 256) * (2 * L) + cs * L + tn * 256;
        const unsigned L2 = 2u * (unsigned)L; const unsigned off0 = (unsigned)(wr * 64 + fr) * L2 + (unsigned)(wc * 32 + 8 * fq);
#pragma unroll
        for (int ai = 0; ai < 2; ++ai)
#pragma unroll
            for (int m = 0; m < 4; ++m) { const unsigned off = off0 + (unsigned)(ai * 128 + m * 16) * L2;
#pragma unroll
                for (int bj = 0; bj < 2; ++bj) { const f32x4 v0 = acc[ai][bj][m][0], v1 = acc[ai][bj][m][1];
                    v4u w; w.x = pk2(v0[0], v0[1]); w.y = pk2(v0[2], v0[3]); w.z = pk2(v1[0], v1[1]); w.w = pk2(v1[2], v1[3]);
                    *(v4u*)(base + off + bj * 128) = w; }
                asm volatile("" ::: "memory"); }
    } };
struct SchedLDFT { const bf16* A4; const bf16* T; int sample, G, c;
    __device__ __forceinline__ bool next(int i, Unit& u) const { const long e = (long)i * G + c; if (e >= 512) return false; int bb, pm, pn;
        if (sample) { bb = NBP + ((int)e >> 6); pm = ((int)e >> 4) & 3; pn = (int)e & 15; } else { bb = (int)e >> 4; pm = 0; pn = (int)e & 15; }
        const int L2 = sample ? 2 * LSA : 2 * LPR;
        u.a = (const char*)(A4 + (size_t)pm * 256 * L2); u.b = (const char*)(T + tb_of(bb) + (size_t)pn * 256 * L2);
        u.x0 = row0_of(bb) + pm * 256; u.x1 = pn; return true; } };
struct EpiLDFT { static constexpr bool PERM = true; const bf16* Z; bf16* YG; float sc;
    __device__ __forceinline__ void operator()(const Acc& acc, const Unit& u, int wr, int wc, int fr, int fq) const {
        const int rb = u.x0, pn = u.x1; const int colt = pn * 256 + wc * 32 + 8 * fq;
#pragma unroll
        for (int ai = 0; ai < 2; ++ai)
#pragma unroll
            for (int m = 0; m < 4; ++m) { const size_t off = (size_t)(rb + ai * 128 + wr * 64 + m * 16 + fr) * FW + colt;
#pragma unroll
                for (int bj = 0; bj < 2; ++bj) { const f32x4 v0 = acc[ai][bj][m][0] * sc, v1 = acc[ai][bj][m][1] * sc;
                    const v4u z = *(const v4u*)(Z + off + bj * 128);
                    v4u w; w.x = pk2(v0[0] * bf_lo(z.x), v0[1] * bf_hi(z.x)); w.y = pk2(v0[2] * bf_lo(z.y), v0[3] * bf_hi(z.y));
                    w.z = pk2(v1[0] * bf_lo(z.z), v1[1] * bf_hi(z.z)); w.w = pk2(v1[2] * bf_lo(z.w), v1[3] * bf_hi(z.w));
                    *(v4u*)(YG + off + bj * 128) = w; } }
    } };
struct EpiRes0 { static constexpr bool PERM = false; const float* xp; const float* xs; const float* pos; const float* mod0; float* V;
    __device__ __forceinline__ void operator()(const Acc& acc, const Unit& u, int wr, int wc, int fr, int fq) const {
        const int pm = u.x0, pn = u.x1; const int rt = pm * 256; const bool smp = rt >= NPR;
        const float* gate = mod0 + (size_t)cond_of_row(rt) * 6144 + 4096;
        const int col0 = pn * 256 + wc * 32 + 4 * fq;
        f32x4 gv[2][2];
#pragma unroll
        for (int bj = 0; bj < 2; ++bj)
#pragma unroll
            for (int n = 0; n < 2; ++n) gv[bj][n] = *(const f32x4*)(gate + col0 + bj * 128 + n * 16);
#pragma unroll
        for (int ai = 0; ai < 2; ++ai)
#pragma unroll
            for (int m = 0; m < 4; ++m) { const int r = rt + ai * 128 + wr * 64 + m * 16 + fr;
                const float* xr = smp ? xs + (size_t)(r - NPR) * DM : xp + (size_t)r * DM; const float* pr = pos + (size_t)((r - NPR) & (LSA - 1)) * DM;
#pragma unroll
                for (int bj = 0; bj < 2; ++bj)
#pragma unroll
                    for (int n = 0; n < 2; ++n) { const int cc = col0 + bj * 128 + n * 16; f32x4 x0 = *(const f32x4*)(xr + cc); if (smp) x0 = x0 + *(const f32x4*)(pr + cc);
                        *(f32x4*)(V + (size_t)r * DM + cc) = x0 * DN_ALPHA + gv[bj][n] * acc[ai][bj][m][n]; }
                asm volatile("" ::: "memory"); }
    } };
struct EpiProj { static constexpr bool PERM = true; bf16* Z; bf16* XBC; float* DT;
    __device__ __forceinline__ void operator()(const Acc& acc, const Unit& u, int wr, int wc, int fr, int fq) const {
        const int pm = u.x0, pn = u.x1;
#pragma unroll
        for (int ai = 0; ai < 2; ++ai)
#pragma unroll
            for (int m = 0; m < 4; ++m) { const int r = pm * 256 + ai * 128 + wr * 64 + m * 16 + fr;
#pragma unroll
                for (int bj = 0; bj < 2; ++bj) { f32x4 v0 = acc[ai][bj][m][0], v1 = acc[ai][bj][m][1]; const int cl = bj * 128 + wc * 32 + 8 * fq;
                    if (pn < 16) {
#pragma unroll
                        for (int j = 0; j < 4; ++j) { v0[j] = silu_f(v0[j]); v1[j] = silu_f(v1[j]); }
                        v4u w; w.x = pk2(v0[0], v0[1]); w.y = pk2(v0[2], v0[3]); w.z = pk2(v1[0], v1[1]); w.w = pk2(v1[2], v1[3]);
                        *(v4u*)(Z + (size_t)r * FW + pn * 256 + cl) = w;
                    } else if (pn < 40) {
                        v4u w; w.x = pk2(v0[0], v0[1]); w.y = pk2(v0[2], v0[3]); w.z = pk2(v1[0], v1[1]); w.w = pk2(v1[2], v1[3]);
                        *(v4u*)(XBC + (size_t)r * CONVD + (pn - 16) * 256 + cl) = w;
                    } else if (bj == 0) {
                        *(f32x4*)(DT + (size_t)r * 128 + cl) = v0; *(f32x4*)(DT + (size_t)r * 128 + cl + 4) = v1;
                    } } }
    } };
struct EpiRes1 { static constexpr bool PERM = false; const float* mod1; const float* SSQ; float* V;
    __device__ __forceinline__ void operator()(const Acc& acc, const Unit& u, int wr, int wc, int fr, int fq) const {
        const int pm = u.x0, pn = u.x1; const int rt = pm * 256;
        const float* gate = mod1 + (size_t)cond_of_row(rt) * 6144 + 4096;
        const int col0 = pn * 256 + wc * 32 + 4 * fq;
        f32x4 gv[2][2];
#pragma unroll
        for (int bj = 0; bj < 2; ++bj)
#pragma unroll
            for (int n = 0; n < 2; ++n) gv[bj][n] = *(const f32x4*)(gate + col0 + bj * 128 + n * 16);
#pragma unroll
        for (int ai = 0; ai < 2; ++ai)
#pragma unroll
            for (int m = 0; m < 4; ++m) { const int r = rt + ai * 128 + wr * 64 + m * 16 + fr;
                const f32x4* sp = (const f32x4*)(SSQ + (size_t)r * 16); const f32x4 s0 = sp[0], s1 = sp[1], s2 = sp[2], s3 = sp[3];
                const float ss = ((s0[0] + s0[1]) + (s0[2] + s0[3])) + ((s1[0] + s1[1]) + (s1[2] + s1[3])) + ((s2[0] + s2[1]) + (s2[2] + s2[3])) + ((s3[0] + s3[1]) + (s3[2] + s3[3]));
                const float rs = 1.0f / sqrtf(ss * (1.0f / FW) + LN_EPS);
#pragma unroll
                for (int bj = 0; bj < 2; ++bj)
#pragma unroll
                    for (int n = 0; n < 2; ++n) { float* vp = V + (size_t)r * DM + col0 + bj * 128 + n * 16; const f32x4 x1 = *(const f32x4*)vp;
                        *(f32x4*)vp = x1 * DN_ALPHA + gv[bj][n] * (acc[ai][bj][m][n] * rs); }
                asm volatile("" ::: "memory"); }
    } };

__device__ __forceinline__ void p0_transpose_item(const float* W, int K, int N, bf16* WT, LAS float* scr, int item, int lane) {
    const int nblk = N / 32, kb = item / nblk, nb = item % nblk, k0 = 64 * kb, n0 = 32 * nb;
#pragma unroll 8
    for (int i = 0; i < 32; ++i) { const int kk = 2 * i + (lane >> 5); scr[kk * 33 + (lane & 31)] = W[(size_t)(k0 + kk) * N + n0 + (lane & 31)]; }
    LDS_WAIT(); asm volatile("" ::: "memory");
    const int c = lane & 7;
#pragma unroll
    for (int j = 0; j < 4; ++j) { const int n = (lane >> 3) + 8 * j; const LAS float* s = scr + (8 * c) * 33 + n;
        v4u o; o.x = pk2(s[0 * 33], s[1 * 33]); o.y = pk2(s[2 * 33], s[3 * 33]); o.z = pk2(s[4 * 33], s[5 * 33]); o.w = pk2(s[6 * 33], s[7 * 33]);
        *(v4u*)(WT + (size_t)(n0 + n) * K + k0 + 8 * c) = o; }
    LDS_WAIT(); asm volatile("" ::: "memory");
}
__device__ __forceinline__ void p0_prologue(Frame& F) {
    const int gw = F.bx * NWAVES + F.wave, NGW = F.G * NWAVES;
    const size_t gt = (size_t)F.bx * NTHR + F.tid, NGT = (size_t)F.G * NTHR;
    LAS float* sc = (LAS float*)F.lds;
    for (int i = F.tid; i < 9 * DM; i += NTHR) { const float v = i < DM ? F.c_ctx[i] : F.c[i - DM]; sc[i] = silu_f(v); }
    __syncthreads();
    float* mod = (float*)(F.ws + WS_MOD);
    for (int it = gw; it < 2 * 96 * 16; it += NGW) {
        const int ks = it & 15, cb = (it >> 4) % 96, layer = it / (16 * 96);
        const int n = cb * 64 + F.lane; const float* wp = F.w_ada + ((size_t)layer * DM + ks * 128) * 6144 + n;
        float a[9];
#pragma unroll
        for (int r = 0; r < 9; ++r) a[r] = 0.f;
#pragma unroll 8
        for (int k = 0; k < 128; ++k) { const float w = wp[(size_t)k * 6144];
#pragma unroll
            for (int r = 0; r < 9; ++r) a[r] += sc[r * DM + ks * 128 + k] * w; }
        const float bias = ks == 0 ? F.b_ada[layer * 6144 + n] : 0.f;
#pragma unroll
        for (int r = 0; r < 9; ++r) atomicAdd(mod + ((size_t)layer * 9 + r) * 6144 + n, a[r] + bias);
    }
    __syncthreads();
    LAS float* scr = (LAS float*)(F.lds + F.wave * 16384);
    constexpr int I_FI = (DM / 64) * (8192 / 32), I_FO = (FW / 64) * (DM / 32), I_SI = (DM / 64) * (SSD_IN / 32), I_SO = (FW / 64) * (DM / 32);
    for (int it = gw; it < I_FI + I_FO + I_SI + I_SO; it += NGW) {
        int r = it;
        if (r < I_FI) { p0_transpose_item(F.fno_w_in, DM, 8192, (bf16*)(F.ws + WS_WFI), scr, r, F.lane); continue; } r -= I_FI;
        if (r < I_FO) { p0_transpose_item(F.fno_w_out, FW, DM, (bf16*)(F.ws + WS_WFO), scr, r, F.lane); continue; } r -= I_FO;
        if (r < I_SI) { p0_transpose_item(F.ssd_w_in, DM, SSD_IN, (bf16*)(F.ws + WS_WSI), scr, r, F.lane); continue; } r -= I_SI;
        p0_transpose_item(F.ssd_w_out, FW, DM, (bf16*)(F.ws + WS_WSO), scr, r, F.lane);
    }
    { v4u* zp = (v4u*)((bf16*)(F.ws + WS_WSI) + (size_t)SSD_IN * DM); const size_t nz = (size_t)(SSD_IN_PAD - SSD_IN) * DM / 8;
      for (size_t i = gt; i < nz; i += NGT) zp[i] = (v4u){0u, 0u, 0u, 0u}; }
    { bf16* D = (bf16*)(F.ws + WS_D256);
      for (size_t i = gt; i < 512 * 256; i += NGT) { const int j = (int)(i >> 8), n = (int)i & 255; const int idx = ((j & 255) * n) & 255; float s, c; sincospif((float)idx * (1.0f / 128.0f), &s, &c); D[i] = (bf16)f2bf(j < 256 ? c : s); } }
    { bf16* A = (bf16*)(F.ws + WS_A4P);
      for (size_t i = gt; i < 256 * 512; i += NGT) { const int k = (int)(i >> 9), kk = (int)i & 511; const int idx = (k * (kk & 255)) & 255; float s, c; sincospif((float)idx * (1.0f / 128.0f), &s, &c); A[i] = (bf16)f2bf(kk < 256 ? c : -s); } }
    { bf16* A = (bf16*)(F.ws + WS_A4S);
      for (size_t i = gt; i < (size_t)1024 * 2048; i += NGT) { const int k = (int)(i >> 11), kk = (int)i & 2047; const int idx = (k * (kk & 1023)) & 1023; float s, c; sincospif((float)idx * (1.0f / 512.0f), &s, &c); A[i] = (bf16)f2bf(kk < 1024 ? c : -s); } }
    { float* P = (float*)(F.ws + WS_POS);
      for (size_t i = gt; i < (size_t)LSA * DM; i += NGT) { const int t = (int)(i >> 11), j = (int)i & 2047; const int qd = j >> 9, ii = j & 511; const int p = qd < 2 ? (t >> 6) : (t & 63);
          const float om = expf(-9.210340371976184f * (float)ii * (1.0f / 512.0f)); const float ang = (float)p * om; P[i] = (qd & 1) ? cosf(ang) : sinf(ang); } }
}

__device__ __forceinline__ void row_stats(const f32x4 (&v)[8], float& mean, float& rstd) {
    float s = 0.f;
#pragma unroll
    for (int j = 0; j < 8; ++j) s += (v[j][0] + v[j][1]) + (v[j][2] + v[j][3]);
    mean = wave_sum(s) * (1.f / DM); float s2 = 0.f;
#pragma unroll
    for (int j = 0; j < 8; ++j) { const f32x4 d = v[j] - mean; s2 += (d[0] * d[0] + d[1] * d[1]) + (d[2] * d[2] + d[3] * d[3]); }
    rstd = 1.f / sqrtf(wave_sum(s2) * (1.f / DM) + LN_EPS);
}
__device__ __forceinline__ void modulate_store(const f32x4 (&v)[8], float mean, float rstd, const float* modrow, bf16* hrow, int lane) {
    const f32x4* sh = (const f32x4*)modrow + lane; const f32x4* scp = (const f32x4*)(modrow + DM) + lane; v2u* o = (v2u*)hrow + lane;
#pragma unroll
    for (int j = 0; j < 8; ++j) { const f32x4 y = (v[j] - mean) * rstd * (scp[64 * j] + 1.0f) + sh[64 * j]; v2u w; w.x = pk2(y[0], y[1]); w.y = pk2(y[2], y[3]); o[64 * j] = w; }
}
__device__ __forceinline__ void p1_ln_mod(Frame& F) {
    const int gw = F.bx * NWAVES + F.wave, NGW = F.G * NWAVES; const float* mod0 = (const float*)(F.ws + WS_MOD); const float* pos = (const float*)(F.ws + WS_POS); bf16* H = (bf16*)(F.ws + WS_H);
    for (int r = gw; r < NTOK; r += NGW) {
        const bool smp = r >= NPR; const f32x4* xr = (const f32x4*)(smp ? F.x_sample + (size_t)(r - NPR) * DM : F.x_prompt + (size_t)r * DM) + F.lane;
        const f32x4* pr = (const f32x4*)(pos + (size_t)((r - NPR) & (LSA - 1)) * DM) + F.lane;
        f32x4 v[8];
#pragma unroll
        for (int j = 0; j < 8; ++j) { v[j] = xr[64 * j]; if (smp) v[j] = v[j] + pr[64 * j]; }
        float mean, rstd; row_stats(v, mean, rstd);
        modulate_store(v, mean, rstd, mod0 + (size_t)cond_of_row(r) * 6144, H + (size_t)r * DM, F.lane);
    }
}
__device__ __forceinline__ void p6_ln_ln_mod(Frame& F) {
    const int gw = F.bx * NWAVES + F.wave, NGW = F.G * NWAVES; const float* mod1 = (const float*)(F.ws + WS_MOD) + 9 * 6144; float* V = (float*)(F.ws + WS_V); bf16* H = (bf16*)(F.ws + WS_H);
    const f32x4* gp = (const f32x4*)F.ln_g + F.lane; const f32x4* bp = (const f32x4*)F.ln_b + F.lane;
    for (int r = gw; r < NTOK; r += NGW) {
        f32x4* vr = (f32x4*)(V + (size_t)r * DM) + F.lane; f32x4 v[8];
#pragma unroll
        for (int j = 0; j < 8; ++j) v[j] = vr[64 * j];
        float mean, rstd; row_stats(v, mean, rstd);
#pragma unroll
        for (int j = 0; j < 8; ++j) { v[j] = (v[j] - mean) * rstd * gp[64 * j] + bp[64 * j]; vr[64 * j] = v[j]; }
        row_stats(v, mean, rstd);
        modulate_store(v, mean, rstd, mod1 + (size_t)cond_of_row(r) * 6144, H + (size_t)r * DM, F.lane);
    }
}
__device__ __forceinline__ void p11_final_ln(Frame& F) {
    const int gw = F.bx * NWAVES + F.wave, NGW = F.G * NWAVES; const float* V = (const float*)(F.ws + WS_V);
    const f32x4* gp = (const f32x4*)(F.ln_g + DM) + F.lane; const f32x4* bp = (const f32x4*)(F.ln_b + DM) + F.lane;
    for (int r = gw; r < NTOK; r += NGW) {
        const f32x4* vr = (const f32x4*)(V + (size_t)r * DM) + F.lane; f32x4* o = (f32x4*)(F.out + (size_t)r * DM) + F.lane; f32x4 v[8];
#pragma unroll
        for (int j = 0; j < 8; ++j) v[j] = vr[64 * j];
        float mean, rstd; row_stats(v, mean, rstd);
#pragma unroll
        for (int j = 0; j < 8; ++j) o[64 * j] = (v[j] - mean) * rstd * gp[64 * j] + bp[64 * j];
    }
}
__device__ __forceinline__ void p8_conv(Frame& F) {
    const bf16* XBC = (const bf16*)(F.ws + WS_XBC); bf16* XS = (bf16*)(F.ws + WS_XS); bf16* BC = (bf16*)(F.ws + WS_BC);
    for (int item = F.bx; item < NTOK / 64; item += F.G) {
        const int t0 = item * 64; const int lo = t0 < NPR ? (t0 & ~(LPR - 1)) : NPR + ((t0 - NPR) & ~(LSA - 1)); const int hi = lo + (t0 < NPR ? LPR : LSA);
        for (int co = F.tid; co < CONVD / 8; co += NTHR) {
            const int ch = co * 8; float w[5][8], bias[8];
#pragma unroll
            for (int k = 0; k < 5; ++k) { const f32x4 a = *(const f32x4*)(F.conv_w + (size_t)k * CONVD + ch), b = *(const f32x4*)(F.conv_w + (size_t)k * CONVD + ch + 4);
#pragma unroll
                for (int e = 0; e < 4; ++e) { w[k][e] = a[e]; w[k][4 + e] = b[e]; } }
            { const f32x4 a = *(const f32x4*)(F.conv_b + ch), b = *(const f32x4*)(F.conv_b + ch + 4);
#pragma unroll
              for (int e = 0; e < 4; ++e) { bias[e] = a[e]; bias[4 + e] = b[e]; } }
            float win[5][8];
#pragma unroll
            for (int k = 0; k < 4; ++k) { const int tt = t0 + k - 2; v4u v = (v4u){0u, 0u, 0u, 0u}; if (tt >= lo && tt < hi) v = *(const v4u*)(XBC + (size_t)tt * CONVD + ch);
                win[k + 1][0] = bf_lo(v.x); win[k + 1][1] = bf_hi(v.x); win[k + 1][2] = bf_lo(v.y); win[k + 1][3] = bf_hi(v.y); win[k + 1][4] = bf_lo(v.z); win[k + 1][5] = bf_hi(v.z); win[k + 1][6] = bf_lo(v.w); win[k + 1][7] = bf_hi(v.w); }
            for (int t = t0; t < t0 + 64; ++t) {
#pragma unroll
                for (int k = 0; k < 4; ++k)
#pragma unroll
                    for (int e = 0; e < 8; ++e) win[k][e] = win[k + 1][e];
                { const int tt = t + 2; v4u v = (v4u){0u, 0u, 0u, 0u}; if (tt < hi) v = *(const v4u*)(XBC + (size_t)tt * CONVD + ch);
                  win[4][0] = bf_lo(v.x); win[4][1] = bf_hi(v.x); win[4][2] = bf_lo(v.y); win[4][3] = bf_hi(v.y); win[4][4] = bf_lo(v.z); win[4][5] = bf_hi(v.z); win[4][6] = bf_lo(v.w); win[4][7] = bf_hi(v.w); }
                float o[8];
#pragma unroll
                for (int e = 0; e < 8; ++e) { float a = bias[e];
#pragma unroll
                    for (int k = 0; k < 5; ++k) a += win[k][e] * w[k][e];
                    o[e] = silu_f(a); }
                v4u pw; pw.x = pk2(o[0], o[1]); pw.y = pk2(o[2], o[3]); pw.z = pk2(o[4], o[5]); pw.w = pk2(o[6], o[7]);
                if (ch < FW) *(v4u*)(XS + (size_t)t * FW + ch) = pw; else *(v4u*)(BC + (size_t)t * 2048 + (ch - FW)) = pw;
            }
        }
    }
}

namespace scan {
constexpr int STR = 136;
constexpr int IMG = 128 * STR * 2;
constexpr int CM_OFF = 0, BMT_OFF = IMG, GI_OFF = 2 * IMG, BM_OFF = 3 * IMG, XT_OFF = BM_OFF, SH_OFF = BM_OFF + 64 * STR * 2;
constexpr int TAB_OFF = 4 * IMG;
constexpr int T_DA = TAB_OFF, T_DTS = TAB_OFF + 2048, T_ACS = TAB_OFF + 4096, T_EA = TAB_OFF + 6144, T_WV = TAB_OFF + 8192, T_TOT = TAB_OFF + 10240;
static_assert(T_TOT + 64 <= MISC_OFF, "scan LDS map");
__device__ __forceinline__ float softplus_f(float x) { return x > 20.f ? x : log1pf(expf(x)); }
__device__ __forceinline__ bf16x8 ld8(const LAS bf16* p) { return *(const LAS bf16x8*)p; }

__device__ __forceinline__ void unit(Frame& F, const int bb, const int g, const int hh) {
    LAS unsigned char* lds = F.lds;
    LAS bf16* CM = (LAS bf16*)(lds + CM_OFF); LAS bf16* BMT = (LAS bf16*)(lds + BMT_OFF); LAS bf16* GI = (LAS bf16*)(lds + GI_OFF);
    LAS bf16* BM = (LAS bf16*)(lds + BM_OFF); LAS bf16* XT = (LAS bf16*)(lds + XT_OFF); LAS bf16* SH = (LAS bf16*)(lds + SH_OFF);
    LAS float* tDA = (LAS float*)(lds + T_DA); LAS float* tDTS = (LAS float*)(lds + T_DTS); LAS float* tACS = (LAS float*)(lds + T_ACS);
    LAS float* tEA = (LAS float*)(lds + T_EA); LAS float* tWV = (LAS float*)(lds + T_WV); LAS float* tTOT = (LAS float*)(lds + T_TOT);
    const int tid = F.tid, lane = F.lane, wid = F.wave, c16 = lane & 15, q = lane >> 4;
    const bool smp = bb >= NBP; const int L = smp ? LSA : LPR, nc = L / 128, row0 = row0_of(bb);
    const bf16* BCg = (const bf16*)(F.ws + WS_BC); const bf16* XSg = (const bf16*)(F.ws + WS_XS); const bf16* Zg = (const bf16*)(F.ws + WS_Z);
    const float* DTg = (const float*)(F.ws + WS_DT); bf16* Yg = (bf16*)(F.ws + WS_Y); float* SSQ = (float*)(F.ws + WS_SSQ);
    const int hbase = g * 8 + hh * 4;
    for (int dir = 0; dir < 2; ++dir) {
        f32x4 S[4][4];
#pragma unroll
        for (int hd = 0; hd < 4; ++hd)
#pragma unroll
            for (int pt = 0; pt < 4; ++pt) {
                if (smp) S[hd][pt] = *(const f32x4*)(F.state_ctx + ((((size_t)(bb - NBP) * 2 + dir) * 64 + hbase + hd) * 64 + 16 * pt + c16) * 128 + 16 * wid + 4 * q);
                else S[hd][pt] = (f32x4){0.f, 0.f, 0.f, 0.f}; }
        for (int step = 0; step < nc; ++step) {
            const int ck = dir == 0 ? step : nc - 1 - step; const int t0 = row0 + ck * 128;
            __syncthreads();
#pragma unroll
            for (int j = 0; j < 4; ++j) { const int id = tid + 512 * j, s = id >> 4, oct = id & 15; const bf16* src = BCg + (size_t)(t0 + s) * 2048 + g * 128 + oct * 8;
                const v4u vb = *(const v4u*)src, vc = *(const v4u*)(src + 1024);
                *(LAS v4u*)(CM + s * STR + oct * 8) = vc; *(LAS v4u*)(BM + s * STR + oct * 8) = vb;
                LAS bf16* d = BMT + (oct * 8) * STR + s;
                d[0 * STR] = (bf16)(vb.x & 0xffff); d[1 * STR] = (bf16)(vb.x >> 16); d[2 * STR] = (bf16)(vb.y & 0xffff); d[3 * STR] = (bf16)(vb.y >> 16);
                d[4 * STR] = (bf16)(vb.z & 0xffff); d[5 * STR] = (bf16)(vb.z >> 16); d[6 * STR] = (bf16)(vb.w & 0xffff); d[7 * STR] = (bf16)(vb.w >> 16); }
            { const int hd = tid >> 7, l = tid & 127, h = hbase + hd; const float raw = DTg[(size_t)(t0 + l) * 128 + dir * 64 + h];
              const float dtv = softplus_f(raw + F.dt_bias[dir * 64 + h]); tDTS[tid] = dtv; tDA[tid] = dtv * (-expf(F.a_log[dir * 64 + h])); }
            __syncthreads();
            { const int hd = tid >> 7, l = tid & 127; const LAS float* da = tDA + hd * 128; float part = 0.f, tot = 0.f;
              for (int t = 0; t < 128; ++t) { const float v = da[t]; tot += v; const bool in = dir == 0 ? (t <= l) : (t >= l); part += in ? v : 0.f; }
              tACS[tid] = part; tEA[tid] = expf(part); tWV[tid] = expf(tot - part) * tDTS[tid]; if (l == 0) tTOT[hd] = tot; }
            { bf16x8 cf[4];
#pragma unroll
              for (int ks = 0; ks < 4; ++ks) cf[ks] = ld8(CM + (16 * wid + c16) * STR + 32 * ks + 8 * q);
#pragma unroll
              for (int st = 0; st < 8; ++st) { f32x4 a = (f32x4){0.f, 0.f, 0.f, 0.f};
#pragma unroll
                  for (int ks = 0; ks < 4; ++ks) a = __builtin_amdgcn_mfma_f32_16x16x32_bf16(ld8(BM + (16 * st + c16) * STR + 32 * ks + 8 * q), cf[ks], a, 0, 0, 0);
                  v2u w; w.x = pk2(a[0], a[1]); w.y = pk2(a[2], a[3]); *(LAS v2u*)(GI + (16 * wid + c16) * STR + 16 * st + 4 * q) = w; } }
            __syncthreads();
            float ssq[4] = {0.f, 0.f, 0.f, 0.f};
#pragma unroll 1
            for (int hd = 0; hd < 4; ++hd) {
                const int h = hbase + hd;
#pragma unroll
                for (int j = 0; j < 2; ++j) { const int id = tid + 512 * j, l = id >> 3, oct = id & 7; const v4u v = *(const v4u*)(XSg + (size_t)(t0 + l) * FW + h * 64 + oct * 8);
                    LAS bf16* d = XT + (oct * 8) * STR + l;
                    d[0 * STR] = (bf16)(v.x & 0xffff); d[1 * STR] = (bf16)(v.x >> 16); d[2 * STR] = (bf16)(v.y & 0xffff); d[3 * STR] = (bf16)(v.y >> 16);
                    d[4 * STR] = (bf16)(v.z & 0xffff); d[5 * STR] = (bf16)(v.z >> 16); d[6 * STR] = (bf16)(v.w & 0xffff); d[7 * STR] = (bf16)(v.w >> 16); }
#pragma unroll
                for (int pt = 0; pt < 4; ++pt) { v2u w; w.x = pk2(S[0][pt][0], S[0][pt][1]); w.y = pk2(S[0][pt][2], S[0][pt][3]); *(LAS v2u*)(SH + (16 * pt + c16) * STR + 16 * wid + 4 * q) = w; }
                __syncthreads();
                f32x4 acc[4];
#pragma unroll
                for (int pt = 0; pt < 4; ++pt) acc[pt] = (f32x4){0.f, 0.f, 0.f, 0.f};
#pragma unroll
                for (int ks = 0; ks < 4; ++ks) { const bf16x8 a = ld8(CM + (16 * wid + c16) * STR + 32 * ks + 8 * q);
#pragma unroll
                    for (int pt = 0; pt < 4; ++pt) acc[pt] = __builtin_amdgcn_mfma_f32_16x16x32_bf16(a, ld8(SH + (16 * pt + c16) * STR + 32 * ks + 8 * q), acc[pt], 0, 0, 0); }
                { const f32x4 e4 = *(const LAS f32x4*)(tEA + hd * 128 + 16 * wid + 4 * q);
#pragma unroll
                  for (int pt = 0; pt < 4; ++pt) acc[pt] = acc[pt] * e4; }
                { const float al = tACS[hd * 128 + 16 * wid + c16]; const int l = 16 * wid + c16;
#pragma unroll
                  for (int ks = 0; ks < 4; ++ks) { const bf16x8 g8 = ld8(GI + (16 * wid + c16) * STR + 32 * ks + 8 * q); const int s0 = 32 * ks + 8 * q;
                      const f32x4 as0 = *(const LAS f32x4*)(tACS + hd * 128 + s0), as1 = *(const LAS f32x4*)(tACS + hd * 128 + s0 + 4);
                      const f32x4 d0 = *(const LAS f32x4*)(tDTS + hd * 128 + s0), d1 = *(const LAS f32x4*)(tDTS + hd * 128 + s0 + 4);
                      float f[8];
#pragma unroll
                      for (int j = 0; j < 8; ++j) { const int s = s0 + j; const bool in = dir == 0 ? (s <= l) : (s >= l); const float as = j < 4 ? as0[j & 3] : as1[j & 3]; const float dd = j < 4 ? d0[j & 3] : d1[j & 3];
                          const float ex = __expf(in ? (al - as) : 0.f); f[j] = in ? ex * dd * bf2f((bf16)g8[j]) : 0.f; }
                      bf16x8 a; { v4u w; w.x = pk2(f[0], f[1]); w.y = pk2(f[2], f[3]); w.z = pk2(f[4], f[5]); w.w = pk2(f[6], f[7]); a = __builtin_bit_cast(bf16x8, w); }
#pragma unroll
                      for (int pt = 0; pt < 4; ++pt) acc[pt] = __builtin_amdgcn_mfma_f32_16x16x32_bf16(a, ld8(XT + (16 * pt + c16) * STR + s0), acc[pt], 0, 0, 0); } }
                { const float dsk = F.d_skip[h];
#pragma unroll
                  for (int pt = 0; pt < 4; ++pt) { const v2u xw = *(const LAS v2u*)(XT + (16 * pt + c16) * STR + 16 * wid + 4 * q); const int col = h * 64 + 16 * pt + c16;
                      const float xv[4] = {bf_lo(xw.x), bf_hi(xw.x), bf_lo(xw.y), bf_hi(xw.y)}; const float nw = F.norm_w[col];
#pragma unroll
                      for (int rg = 0; rg < 4; ++rg) { const size_t o = (size_t)(t0 + 16 * wid + 4 * q + rg) * FW + col; float y = acc[pt][rg];
                          if (dir == 0) Yg[o] = (bf16)f2bf(y + dsk * xv[rg]);
                          else { y = (y + bf2f(Yg[o])) * bf2f(Zg[o]); ssq[rg] += y * y; Yg[o] = (bf16)f2bf(y * nw); } } } }
                { const float dec = expf(tTOT[hd]);
#pragma unroll
                  for (int pt = 0; pt < 4; ++pt) S[0][pt] = S[0][pt] * dec;
#pragma unroll
                  for (int ks = 0; ks < 4; ++ks) { const int s0 = 32 * ks + 8 * q; const bf16x8 a = ld8(BMT + (16 * wid + c16) * STR + s0);
                      const f32x4 w0 = *(const LAS f32x4*)(tWV + hd * 128 + s0), w1 = *(const LAS f32x4*)(tWV + hd * 128 + s0 + 4);
#pragma unroll
                      for (int pt = 0; pt < 4; ++pt) { const bf16x8 x8 = ld8(XT + (16 * pt + c16) * STR + s0);
                          v4u w; w.x = pk2(bf2f((bf16)x8[0]) * w0[0], bf2f((bf16)x8[1]) * w0[1]); w.y = pk2(bf2f((bf16)x8[2]) * w0[2], bf2f((bf16)x8[3]) * w0[3]);
                          w.z = pk2(bf2f((bf16)x8[4]) * w1[0], bf2f((bf16)x8[5]) * w1[1]); w.w = pk2(bf2f((bf16)x8[6]) * w1[2], bf2f((bf16)x8[7]) * w1[3]);
                          S[0][pt] = __builtin_amdgcn_mfma_f32_16x16x32_bf16(a, __builtin_bit_cast(bf16x8, w), S[0][pt], 0, 0, 0); } } }
#pragma unroll
                for (int pt = 0; pt < 4; ++pt) { const f32x4 t0v = S[0][pt]; S[0][pt] = S[1][pt]; S[1][pt] = S[2][pt]; S[2][pt] = S[3][pt]; S[3][pt] = t0v; }
                __syncthreads();
            }
            if (dir == 1) {
#pragma unroll
                for (int rg = 0; rg < 4; ++rg) { float v = ssq[rg]; v += __shfl_xor(v, 1); v += __shfl_xor(v, 2); v += __shfl_xor(v, 4); v += __shfl_xor(v, 8);
                    if (c16 == 0) SSQ[(size_t)(t0 + 16 * wid + 4 * q + rg) * 16 + g * 2 + hh] = v; }
            }
        }
        if (!smp) {
            float* so = F.out + (size_t)NTOK * DM;
#pragma unroll
            for (int hd = 0; hd < 4; ++hd)
#pragma unroll
                for (int pt = 0; pt < 4; ++pt) *(f32x4*)(so + ((((size_t)bb * 2 + dir) * 64 + hbase + hd) * 64 + 16 * pt + c16) * 128 + 16 * wid + 4 * q) = S[hd][pt];
        }
    }
}
__device__ __forceinline__ void decode_unit(int u, int& bb, int& g, int& hh) {
    if (u < 128) { bb = NBP + (u >> 4); g = (u >> 1) & 7; hh = u & 1; } else { const int p = u - 128; bb = p >> 4; g = (p >> 1) & 7; hh = p & 1; }
}
__device__ __forceinline__ void phase(Frame& F) {
    int bb, g, hh;
    if (F.G == 256) {
        if (F.bx < 128) { decode_unit(F.bx, bb, g, hh); unit(F, bb, g, hh); }
        else for (int i = 0; i < 4; ++i) { decode_unit(128 + (F.bx - 128) * 4 + i, bb, g, hh); unit(F, bb, g, hh); }
    } else for (int u = F.bx; u < 640; u += F.G) { decode_unit(u, bb, g, hh); unit(F, bb, g, hh); }
}
}

__global__ void __launch_bounds__(NTHR, 2) fwd_kernel(Args args) {
    extern __shared__ __attribute__((aligned(16))) unsigned char lds_raw[];
    Frame F;
    F.lds = (LAS unsigned char*)lds_raw;
    F.tid = threadIdx.x; F.lane = F.tid & 63; F.wave = __builtin_amdgcn_readfirstlane(F.tid >> 6); F.G = gridDim.x; F.bx = blockIdx.x;
    F.x_prompt = args.in[0]; F.x_sample = args.in[1]; F.state_ctx = args.in[2]; F.c = args.in[3]; F.c_ctx = args.in[4]; F.w_ada = args.in[5]; F.b_ada = args.in[6];
    F.ln_g = args.in[7]; F.ln_b = args.in[8]; F.fno_w_in = args.in[9]; F.fno_w_out = args.in[10]; F.ssd_w_in = args.in[11]; F.conv_w = args.in[12]; F.conv_b = args.in[13];
    F.dt_bias = args.in[14]; F.a_log = args.in[15]; F.d_skip = args.in[16]; F.norm_w = args.in[17]; F.ssd_w_out = args.in[18];
    F.out = args.out; F.ws = args.ws;
    volatile LAS unsigned* MISC = (volatile LAS unsigned*)(F.lds + MISC_OFF);
    if (F.tid < 64) MISC[F.tid] = 0u;
    __syncthreads();
    unsigned* ctl = (unsigned*)(F.ws + WS_CTL);
    const int lo = args.ph_lo, hi = args.ph_hi;
    XcdBarrier bar; bar.bar = ctl + CW_BAR; bar.x = 0; bar.st = nullptr;
    if (hi - lo > 1) bar = xcd_barrier_post(ctl + CW_BAR, MISC + 8);
#ifndef ONLY_PHASE
#define ONLY_PHASE -1
#endif
#define IN(k) ((ONLY_PHASE < 0 || ONLY_PHASE == (k)) && lo <= (k) && (k) < hi)
#define SEAM(k) do { if (IN(k) && IN((k) + 1)) xcd_barrier(bar); } while (0)
    bf16* H = (bf16*)(F.ws + WS_H); bf16* U = (bf16*)(F.ws + WS_U); bf16* Z = (bf16*)(F.ws + WS_Z); bf16* T = (bf16*)(F.ws + WS_T); float* V = (float*)(F.ws + WS_V);
    const float* mod = (const float*)(F.ws + WS_MOD);

    if (IN(0)) { p0_prologue(F); } SEAM(0);
    if (IN(1)) { p1_ln_mod(F); } SEAM(1);
    if (IN(2)) { SchedGrid S{H, (const bf16*)(F.ws + WS_WFI), 64, 32, DM, DM, F.G, F.bx}; EpiUZ E{U, Z};
                 pg8::gemm_phase<EpiUZ, SchedGrid, GP_ALIGN, GP_SP2>(F.lds, DM, DM, DM, S, E); } SEAM(2);
    if (IN(3)) { SchedCDFT S{(const bf16*)(F.ws + WS_D256), U, F.G, F.bx}; EpiCDFT E{T};
                 pg8::gemm_phase<EpiCDFT, SchedCDFT, GP_ALIGN, GP_SP2>(F.lds, 256, 256, FW, S, E); } SEAM(3);
    if (IN(4)) { { SchedLDFT S{(const bf16*)(F.ws + WS_A4S), T, 1, F.G, F.bx}; EpiLDFT E{Z, U, 1.0f / 512.0f};
                   pg8::gemm_phase<EpiLDFT, SchedLDFT, GP_ALIGN, GP_SP2>(F.lds, 2 * LSA, 2 * LSA, 2 * LSA, S, E); }
                 { SchedLDFT S{(const bf16*)(F.ws + WS_A4P), T, 0, F.G, F.bx}; EpiLDFT E{Z, U, 1.0f / 256.0f};
                   pg8::gemm_phase<EpiLDFT, SchedLDFT, GP_ALIGN, GP_SP2>(F.lds, 2 * LPR, 2 * LPR, 2 * LPR, S, E); } } SEAM(4);
    if (IN(5)) { SchedGrid S{U, (const bf16*)(F.ws + WS_WFO), 64, 8, FW, FW, F.G, F.bx}; EpiRes0 E{F.x_prompt, F.x_sample, (const float*)(F.ws + WS_POS), mod, V};
                 pg8::gemm_phase<EpiRes0, SchedGrid, GP_ALIGN, GP_SP2>(F.lds, FW, FW, FW, S, E); } SEAM(5);
    if (IN(6)) { p6_ln_ln_mod(F); } SEAM(6);
    if (IN(7)) { SchedGrid S{H, (const bf16*)(F.ws + WS_WSI), 64, SSD_IN_PAD / 256, DM, DM, F.G, F.bx}; EpiProj E{Z, (bf16*)(F.ws + WS_XBC), (float*)(F.ws + WS_DT)};
                 pg8::gemm_phase<EpiProj, SchedGrid, GP_ALIGN, GP_SP2>(F.lds, DM, DM, DM, S, E); } SEAM(7);
    if (IN(8)) { p8_conv(F); } SEAM(8);
    if (IN(9)) { scan::phase(F); } SEAM(9);
    if (IN(10)) { SchedGrid S{(const bf16*)(F.ws + WS_Y), (const bf16*)(F.ws + WS_WSO), 64, 8, FW, FW, F.G, F.bx}; EpiRes1 E{mod + 9 * 6144, (const float*)(F.ws + WS_SSQ), V};
                  pg8::gemm_phase<EpiRes1, SchedGrid, GP_ALIGN, GP_SP2>(F.lds, FW, FW, FW, S, E); } SEAM(10);
    if (IN(11)) { p11_final_ln(F); }
#undef IN
#undef SEAM
}


extern "C" void kernel_launch(void* const* d_in, const int* in_sizes, int n_in, void* d_out, int out_size, void* d_ws, size_t ws_size, hipStream_t stream) {
    static int grid = 0;
    if (grid == 0) {
        int dev = 0, cus = 0;
        if (n_in != 19 || ws_size < WS_END || out_size != NTOK * DM + NBP * 2 * 64 * 64 * 128) { fprintf(stderr, "kernel_launch: unexpected shapes (n_in %d, ws %zu, out %d)\n", n_in, ws_size, out_size); grid = -1; return; }
        if (hipGetDevice(&dev) != hipSuccess || hipDeviceGetAttribute(&cus, hipDeviceAttributeMultiprocessorCount, dev) != hipSuccess) { grid = -1; return; }
        if (hipFuncSetAttribute((const void*)fwd_kernel, hipFuncAttributeMaxDynamicSharedMemorySize, LDS_BYTES) != hipSuccess) { fprintf(stderr, "kernel_launch: hipFuncSetAttribute failed\n"); grid = -1; return; }
        grid = cus;
    }
    if (grid < 0) return;
    (void)hipMemsetAsync((char*)d_ws + WS_CTL, 0, CTL_ZERO_BYTES, stream);
    Args a{};
    for (int i = 0; i < 19; ++i) a.in[i] = (const float*)d_in[i];
    a.out = (float*)d_out; a.ws = (unsigned char*)d_ws;
#if MK_PER_PHASE || MK_CHECK
    for (int p = 0; p < NPHASE; ++p) { a.ph_lo = p; a.ph_hi = p + 1; hipLaunchKernelGGL(fwd_kernel, dim3(grid), dim3(NTHR), LDS_BYTES, stream, a);
#if MK_CHECK
        check_after_phase(p, a, stream);
#endif
    }
#if MK_CHECK
    check_report(a, stream);
#endif
#else
    a.ph_lo = 0; a.ph_hi = NPHASE;
    hipLaunchKernelGGL(fwd_kernel, dim3(grid), dim3(NTHR), LDS_BYTES, stream, a);
#endif
}
```

```cpp
#include <hip/hip_runtime.h>
#include <cstdio>
#include <cstdint>

#ifndef MK_PER_PHASE
#define MK_PER_PHASE 0
#endif
#ifndef MK_CHECK
#define MK_CHECK 0
#endif

#define GAS __attribute__((address_space(1)))
#define LAS __attribute__((address_space(3)))
typedef unsigned short bf16;
typedef unsigned v4u __attribute__((ext_vector_type(4)));
typedef unsigned v2u __attribute__((ext_vector_type(2)));
typedef float f32x4 __attribute__((ext_vector_type(4)));
typedef short bf16x8 __attribute__((ext_vector_type(8)));
#define LDS_WAIT() asm volatile("s_waitcnt lgkmcnt(0)" ::: "memory")
#define VM_WAIT() asm volatile("s_waitcnt vmcnt(0)" ::: "memory")

constexpr int NWAVES = 8, NTHR = 512;
constexpr int DM = 2048, NTOK = 16384, NPR = 8192, LPR = 256, LSA = 1024, NBP = 32, NBS = 8;
constexpr int FW = 4096;
constexpr int SSD_IN = 10368, SSD_IN_PAD = 10496, CONVD = 6144;
constexpr float LN_EPS = 1e-5f;
constexpr float DN_ALPHA = 1.41421356237f;
constexpr int NPHASE = 12;

constexpr size_t MiB = 1u << 20;
constexpr size_t WS_CTL = 0, WS_MOD = 1 * MiB, CTL_ZERO_BYTES = 2 * MiB;
constexpr size_t WS_D256 = 2 * MiB, WS_A4P = 3 * MiB, WS_A4S = 4 * MiB, WS_POS = 8 * MiB;
constexpr size_t WS_WFI = 16 * MiB, WS_WFO = 48 * MiB, WS_WSI = 64 * MiB, WS_WSO = 106 * MiB;
constexpr size_t WS_DT = 122 * MiB, WS_SSQ = 130 * MiB, WS_CHK = 131 * MiB;
constexpr size_t WS_H = 132 * MiB, WS_U = 196 * MiB, WS_Z = 324 * MiB, WS_T = 452 * MiB, WS_V = 708 * MiB, WS_Y = 836 * MiB, WS_END = 996 * MiB;
constexpr size_t WS_XBC = WS_T, WS_BN = 644 * MiB, WS_CN = 676 * MiB, WS_XT = WS_U, WS_BT = 964 * MiB;
constexpr int CW_BAR = 4096;

constexpr int LDS_BYTES = 163840;
constexpr int MISC_OFF = LDS_BYTES - 256;

__device__ __forceinline__ unsigned f2bf(float f) { unsigned u = __builtin_bit_cast(unsigned, f); return (u + 0x7fffu + ((u >> 16) & 1u)) >> 16; }
typedef __bf16 bf2_t __attribute__((ext_vector_type(2)));
typedef float f32x2_t __attribute__((ext_vector_type(2)));
__device__ __forceinline__ unsigned pk2(float lo, float hi) { const f32x2_t v = {lo, hi}; return __builtin_bit_cast(unsigned, __builtin_convertvector(v, bf2_t)); }
__device__ __forceinline__ float bf_lo(unsigned w) { return __builtin_bit_cast(float, w << 16); }
__device__ __forceinline__ float bf_hi(unsigned w) { return __builtin_bit_cast(float, w & 0xffff0000u); }
__device__ __forceinline__ float bf2f(bf16 b) { return __builtin_bit_cast(float, ((unsigned)b) << 16); }
__device__ __forceinline__ float silu_f(float x) { return x / (1.f + __expf(-x)); }
__device__ __forceinline__ float wave_sum(float v) {
#pragma unroll
    for (int o = 1; o < 64; o <<= 1) v += __shfl_xor(v, o);
    return v;
}

#define XB_TMO      128
#define XB_XCNT(j)  (256  + 64 * (j))
#define XB_XSUB(j)  (1280 + 64 * (j))
#define XB_XGEN(j)  (2304 + 64 * (j))
#define XB_TOP      3328
#define XB_TOPGEN   3392
#define XCD_BAR_WORDS 3456
#define XB_SPIN_CAP (1u << 20)
__device__ __forceinline__ unsigned xb_ld(unsigned* p)              { return __hip_atomic_load(p, __ATOMIC_RELAXED, __HIP_MEMORY_SCOPE_AGENT); }
__device__ __forceinline__ unsigned xb_add(unsigned* p, unsigned v) { return __hip_atomic_fetch_add(p, v, __ATOMIC_RELAXED, __HIP_MEMORY_SCOPE_AGENT); }
__device__ __forceinline__ unsigned xb_xcc_id() { return (unsigned)__builtin_amdgcn_s_getreg((3 << 11) | 20) & 0xFu; }
#define XB_SPIN(cond, bar) do { unsigned _sp = 0; while (cond) { __builtin_amdgcn_s_sleep(1); \
    if ((++_sp & 255u) == 0u) { if (xb_ld(&(bar)[XB_TMO])) break; if (_sp > XB_SPIN_CAP) { atomicAdd(&(bar)[XB_TMO], 1u); break; } } } } while (0)
struct XcdBarrier { unsigned* bar; unsigned x; volatile LAS unsigned* st; };
__device__ __forceinline__ XcdBarrier xcd_barrier_post(unsigned* bar, volatile LAS unsigned* st) {
    XcdBarrier b; b.bar = bar; b.x = xb_xcc_id(); b.st = st;
    if (threadIdx.x == 0) (void)xb_add(&bar[XB_XCNT(b.x)], 1u);
    return b;
}
__device__ __forceinline__ void xcd_barrier_complete(unsigned* bar, unsigned x, unsigned& nloc, unsigned& nx) {
    const unsigned G = gridDim.x * gridDim.y * gridDim.z;
    unsigned sum, cnt, mine, sp = 0u;
    for (;;) {
        sum = 0u; cnt = 0u; mine = 0u;
#pragma unroll
        for (unsigned j = 0; j < 16; ++j) { const unsigned c = xb_ld(&bar[XB_XCNT(j)]); sum += c; cnt += (c > 0u) ? 1u : 0u; mine = (j == x) ? c : mine; }
        if (sum == G) break;
        __builtin_amdgcn_s_sleep(1);
        if ((++sp & 255u) == 0u) { if (xb_ld(&bar[XB_TMO])) break; if (sp > XB_SPIN_CAP) { atomicAdd(&bar[XB_TMO], 1u); break; } }
    }
    nloc = mine > 0u ? mine : 1u; nx = cnt > 0u ? cnt : 1u;
}
__device__ __forceinline__ void xcd_barrier(const XcdBarrier& b) {
    asm volatile("s_waitcnt vmcnt(0)" ::: "memory");
    __syncthreads();
    if (threadIdx.x == 0) {
        unsigned* bar = b.bar;
        __builtin_amdgcn_s_waitcnt(0);
        unsigned nloc = b.st[0], nx = b.st[1];
        if (nloc == 0u) { xcd_barrier_complete(bar, b.x, nloc, nx); b.st[0] = nloc; b.st[1] = nx; }
        const unsigned old = xb_add(&bar[XB_XSUB(b.x)], 1u);
        const unsigned gen = old / nloc;
        if (old + 1u == (gen + 1u) * nloc) {
            __builtin_amdgcn_fence(__ATOMIC_RELEASE, "agent");
            asm volatile("s_waitcnt vmcnt(0)" ::: "memory");
            const unsigned og = xb_add(&bar[XB_TOP], 1u);
            const unsigned tg = og / nx;
            if (og + 1u == (tg + 1u) * nx) xb_add(&bar[XB_TOPGEN], 1u);
            else XB_SPIN(xb_ld(&bar[XB_TOPGEN]) == tg, bar);
            __builtin_amdgcn_fence(__ATOMIC_ACQUIRE, "agent");
            xb_add(&bar[XB_XGEN(b.x)], 1u);
            asm volatile("s_waitcnt vmcnt(0)" ::: "memory");
        } else {
            XB_SPIN(xb_ld(&bar[XB_XGEN(b.x)]) == gen, bar);
            __builtin_amdgcn_fence(__ATOMIC_ACQUIRE, "agent");
            asm volatile("s_waitcnt vmcnt(0)" ::: "memory");
        }
    }
    __syncthreads();
}

struct Args { const float* in[19]; float* out; unsigned char* ws; int ph_lo, ph_hi; };
struct Frame {
    LAS unsigned char* lds;
    int tid, lane, wave, G, bx;
    const Args* ap;
    float* out; unsigned char* ws;
};
__device__ __forceinline__ int row0_of(int bb) { return bb < NBP ? bb * LPR : NPR + (bb - NBP) * LSA; }
__device__ __forceinline__ size_t tb_of(int bb) { return bb < NBP ? (size_t)bb * FW * 2 * LPR : (size_t)NBP * FW * 2 * LPR + (size_t)(bb - NBP) * FW * 2 * LSA; }
__device__ __forceinline__ int cond_of_row(int r) { return r < NPR ? 0 : 1 + (r - NPR) / LSA; }

namespace pg8 {
constexpr int BM = 256, BK = 64, HALF = 128, HTB = HALF * BK * 2, NXCD = 8, WGM = 8;
__host__ __device__ __forceinline__ int lds_byte(int r, int c) { const int st = (r >> 4) * 2 + (c >> 5), rr = r & 15, cc = c & 31, ob = rr * 64 + cc * 2; return st * 1024 + (ob ^ (((ob >> 9) & 1) << 5)); }
__host__ __device__ __forceinline__ void stage_rc(int b, int& R, int& C) { const int st = b / 1024, sb = b % 1024, swz = sb ^ (((sb >> 9) & 1) << 5); R = (st >> 1) * 16 + swz / 64; C = (st & 1) * 32 + (swz % 64) / 2; }
__host__ __device__ __forceinline__ int perm32(int rho) { const int n = rho >> 4, i = rho & 15; return 8 * (i >> 2) + 4 * n + (i & 3); }
struct Unit { const char* a; const char* b; int x0, x1; };
typedef f32x4 Acc[2][2][4][2];

__device__ __forceinline__ bool static_tile(int i, int G, int c, int nM, int nN, int& pm, int& pn) {
    const int nwg = nM * nN; const long L = (long)i * G + c; if (L >= nwg) return false;
    int wgid = (int)L; { const int q = nwg / NXCD, r = nwg % NXCD, xcd = wgid % NXCD, off = wgid / NXCD; wgid = (xcd < r ? xcd * (q + 1) : r * (q + 1) + (xcd - r) * q) + off; }
    const int nig = WGM * nN, gid = wgid / nig, fm = gid * WGM, gsz = (nM - fm) < WGM ? (nM - fm) : WGM;
    pm = fm + ((wgid % nig) % gsz); pn = (wgid % nig) / gsz; return true;
}

template <class Epi, class Sched, bool ALIGN_EPI, bool SP2>
__device__ __forceinline__ void gemm_phase(LAS unsigned char* lds, const int K, const int lda, const int ldb, const Sched& S, const Epi& E) {
    const int tid = threadIdx.x, wid = __builtin_amdgcn_readfirstlane(tid >> 6), lane = tid & 63, wr = wid >> 2, wc = wid & 3, fr = lane & 15, fq = lane >> 4;
    const int nt = K / BK;
    unsigned voffA[2], voffB[2];
#pragma unroll
    for (int i = 0; i < 2; ++i) { int R, C; stage_rc(tid * 16 + i * 8192, R, C); const int Rb = Epi::PERM ? ((R & ~31) + perm32(R & 31)) : R;
        voffA[i] = (unsigned)(R * lda + C) * 2u; voffB[i] = (unsigned)(Rb * ldb + C) * 2u; }
    const size_t kstep = (size_t)(BK * 2);
    const size_t hstepA = (size_t)HALF * lda * 2, hstepB = (size_t)HALF * ldb * 2;
    const unsigned ldsw = (unsigned)wid * 1024u;
    const int aoff = lds_byte(wr * 64 + fr, fq * 8), boff = lds_byte(wc * 32 + fr, fq * 8);
#define PG8_SA(b, h) (((b) * 2 + (h)) * HTB)
#define PG8_SB(b, h) ((4 + (b) * 2 + (h)) * HTB)
#define PG8_STAGE(bufoff, gbase, voff) do { _Pragma("unroll") for (int _i = 0; _i < 2; ++_i) \
        __builtin_amdgcn_global_load_lds((const unsigned*)((const char*)(gbase) + (voff)[_i]), (LAS unsigned*)(lds + (bufoff) + ldsw + _i * 8192), 16, 0, 0); } while (0)
#define PG8_LDA(dst, b, h) do { _Pragma("unroll") for (int m = 0; m < 4; ++m) _Pragma("unroll") for (int k = 0; k < 2; ++k) dst[m][k] = *(const LAS bf16x8*)(lds + PG8_SA(b, h) + aoff + m * 2048 + k * 1024); } while (0)
#define PG8_LDB(dst, b, h) do { _Pragma("unroll") for (int n = 0; n < 2; ++n) _Pragma("unroll") for (int k = 0; k < 2; ++k) dst[n][k] = *(const LAS bf16x8*)(lds + PG8_SB(b, h) + boff + n * 2048 + k * 1024); } while (0)
#define PG8_MMA(ai, bj, At, Bt) do { __builtin_amdgcn_s_setprio(1); _Pragma("unroll") for (int m = 0; m < 4; ++m) _Pragma("unroll") for (int n = 0; n < 2; ++n) _Pragma("unroll") for (int k = 0; k < 2; ++k) \
        acc[ai][bj][m][n] = __builtin_amdgcn_mfma_f32_16x16x32_bf16(Bt[n][k], At[m][k], acc[ai][bj][m][n], 0, 0, 0); __builtin_amdgcn_s_setprio(0); } while (0)
#define PG8_WAIT_V(n) asm volatile("s_waitcnt vmcnt(" #n ")" ::: "memory")
#define PG8_WAIT_L(n) asm volatile("s_waitcnt lgkmcnt(" #n ")" ::: "memory")
#define PG8_BAR __builtin_amdgcn_s_barrier()
#define PG8_SCHED __builtin_amdgcn_sched_barrier(0)
    Unit cur, nxt; int ui = 0;
    if (!S.next(0, cur)) return;
    Acc acc;
#pragma unroll
    for (int a = 0; a < 2; ++a)
#pragma unroll
        for (int b = 0; b < 2; ++b)
#pragma unroll
            for (int m = 0; m < 4; ++m)
#pragma unroll
                for (int n = 0; n < 2; ++n) acc[a][b][m][n] = (f32x4){0.f, 0.f, 0.f, 0.f};
    bf16x8 At[4][2], B0[2][2], B1[2][2];
    const char* cA = cur.a; const char* cB = cur.b;
    if constexpr (SP2) {
        PG8_STAGE(PG8_SB(0, 0), cB, voffB); PG8_STAGE(PG8_SB(0, 1), cB + hstepB, voffB); PG8_STAGE(PG8_SA(0, 0), cA, voffA); PG8_STAGE(PG8_SA(0, 1), cA + hstepA, voffA);
        if (wr == 1) PG8_BAR;
        PG8_WAIT_V(2); PG8_BAR;
        PG8_STAGE(PG8_SB(1, 0), cB + kstep, voffB); PG8_STAGE(PG8_SA(1, 0), cA + kstep, voffA); PG8_STAGE(PG8_SB(1, 1), cB + hstepB + kstep, voffB);
        PG8_WAIT_V(6); PG8_BAR;
    } else {
        PG8_STAGE(PG8_SB(0, 0), cB, voffB); PG8_STAGE(PG8_SA(0, 0), cA, voffA); PG8_STAGE(PG8_SB(0, 1), cB + hstepB, voffB); PG8_STAGE(PG8_SA(0, 1), cA + hstepA, voffA);
        if (wr == 1) PG8_BAR;
        PG8_WAIT_V(4); PG8_BAR;
        PG8_STAGE(PG8_SB(1, 0), cB + kstep, voffB); PG8_STAGE(PG8_SA(1, 0), cA + kstep, voffA); PG8_STAGE(PG8_SB(1, 1), cB + hstepB + kstep, voffB);
        PG8_WAIT_V(6); PG8_BAR;
    }
    for (;;) {
        const bool has_next = S.next(ui + 1, nxt);
        const char* nA = has_next ? nxt.a : cA; const char* nB = has_next ? nxt.b : cB;
#pragma unroll 1
        for (int t = 0; t < nt; t += 2) {
            const bool last = (t == nt - 2);
            const char* a1 = cA + (size_t)(t + 1) * kstep;
            const char* a2 = last ? nA : cA + (size_t)(t + 2) * kstep; const char* b2 = last ? nB : cB + (size_t)(t + 2) * kstep;
            const char* a3 = a2 + kstep; const char* b3 = b2 + kstep;
            if constexpr (SP2) {
            PG8_LDB(B0, 0, 0); PG8_LDB(B1, 0, 1); PG8_SCHED; PG8_LDA(At, 0, 0); PG8_STAGE(PG8_SA(1, 1), a1 + hstepA, voffA);
            PG8_WAIT_V(8); PG8_WAIT_L(0); PG8_BAR; PG8_MMA(0, 0, At, B0); PG8_MMA(0, 1, At, B1); PG8_BAR; PG8_SCHED;
            PG8_LDA(At, 0, 1); PG8_STAGE(PG8_SB(0, 0), b2, voffB); PG8_STAGE(PG8_SB(0, 1), b2 + hstepB, voffB); PG8_STAGE(PG8_SA(0, 0), a2, voffA);
            PG8_WAIT_V(8); PG8_WAIT_L(0); PG8_BAR; PG8_MMA(1, 0, At, B0); PG8_MMA(1, 1, At, B1); PG8_BAR; PG8_SCHED;
            PG8_LDB(B0, 1, 0); PG8_LDB(B1, 1, 1); PG8_SCHED; PG8_LDA(At, 1, 0); PG8_STAGE(PG8_SA(0, 1), a2 + hstepA, voffA);
            PG8_WAIT_V(8); PG8_WAIT_L(0); PG8_BAR; PG8_MMA(0, 0, At, B0); PG8_MMA(0, 1, At, B1); PG8_BAR; PG8_SCHED;
            PG8_LDA(At, 1, 1); PG8_STAGE(PG8_SB(1, 0), b3, voffB); PG8_STAGE(PG8_SB(1, 1), b3 + hstepB, voffB); PG8_STAGE(PG8_SA(1, 0), a3, voffA);
            PG8_WAIT_V(8); PG8_WAIT_L(0); PG8_BAR; PG8_MMA(1, 0, At, B0); PG8_MMA(1, 1, At, B1); PG8_BAR; PG8_SCHED;
            } else {
            PG8_LDB(B0, 0, 0); PG8_SCHED; PG8_LDA(At, 0, 0); PG8_STAGE(PG8_SA(1, 1), a1 + hstepA, voffA);
            PG8_WAIT_L(8); PG8_BAR; PG8_WAIT_L(0); PG8_MMA(0, 0, At, B0); PG8_BAR; PG8_SCHED;
            PG8_LDB(B1, 0, 1); PG8_STAGE(PG8_SB(0, 0), b2, voffB);
            PG8_BAR; PG8_WAIT_L(0); PG8_MMA(0, 1, At, B1); PG8_BAR;
            PG8_LDA(At, 0, 1); PG8_STAGE(PG8_SA(0, 0), a2, voffA);
            PG8_BAR; PG8_WAIT_L(0); PG8_MMA(1, 0, At, B0); PG8_BAR; PG8_SCHED;
            PG8_STAGE(PG8_SB(0, 1), b2 + hstepB, voffB);
            PG8_WAIT_V(6); PG8_BAR; PG8_MMA(1, 1, At, B1); PG8_BAR;
            PG8_LDB(B0, 1, 0); PG8_SCHED; PG8_LDA(At, 1, 0); PG8_STAGE(PG8_SA(0, 1), a2 + hstepA, voffA);
            PG8_WAIT_L(8); PG8_BAR; PG8_WAIT_L(0); PG8_MMA(0, 0, At, B0); PG8_BAR; PG8_SCHED;
            PG8_LDB(B1, 1, 1); PG8_STAGE(PG8_SB(1, 0), b3, voffB);
            PG8_BAR; PG8_WAIT_L(0); PG8_MMA(0, 1, At, B1); PG8_BAR;
            PG8_LDA(At, 1, 1); PG8_STAGE(PG8_SA(1, 0), a3, voffA);
            PG8_BAR; PG8_WAIT_L(0); PG8_MMA(1, 0, At, B0); PG8_BAR; PG8_SCHED;
            PG8_STAGE(PG8_SB(1, 1), b3 + hstepB, voffB);
            PG8_WAIT_V(6); PG8_BAR; PG8_MMA(1, 1, At, B1); PG8_BAR;
            }
        }
        if constexpr (ALIGN_EPI) { if (wr == 0) PG8_BAR; }
        E(acc, cur, wr, wc, fr, fq);
        if (!has_next) break;
#pragma unroll
        for (int a = 0; a < 2; ++a)
#pragma unroll
            for (int b = 0; b < 2; ++b)
#pragma unroll
                for (int m = 0; m < 4; ++m)
#pragma unroll
                    for (int n = 0; n < 2; ++n) acc[a][b][m][n] = (f32x4){0.f, 0.f, 0.f, 0.f};
        cur = nxt; cA = nA; cB = nB; ++ui;
        if constexpr (ALIGN_EPI) { if (wr == 1) PG8_BAR; }
    }
    PG8_WAIT_V(0);
    if constexpr (!ALIGN_EPI) { if (wr == 0) PG8_BAR; }
    PG8_BAR;
#undef PG8_SA
#undef PG8_SB
#undef PG8_STAGE
#undef PG8_LDA
#undef PG8_LDB
#undef PG8_MMA
#undef PG8_WAIT_V
#undef PG8_WAIT_L
#undef PG8_BAR
#undef PG8_SCHED
}
}
using pg8::Unit; using pg8::Acc;
constexpr bool GP_ALIGN = true, GP_SP2 = true;

struct SchedGrid {
    const bf16* A; const bf16* B; int nM, nN, lda, ldb, G, c;
    __device__ __forceinline__ bool next(int i, Unit& u) const { int pm, pn; if (!pg8::static_tile(i, G, c, nM, nN, pm, pn)) return false;
        u.a = (const char*)(A + (size_t)pm * 256 * lda); u.b = (const char*)(B + (size_t)pn * 256 * ldb); u.x0 = pm; u.x1 = pn; return true; }
};
struct SchedOne {
    const bf16* A; const bf16* B; int pm, pn, lda, ldb;
    __device__ __forceinline__ bool next(int i, Unit& u) const { if (i != 0 || pm < 0) return false;
        u.a = (const char*)(A + (size_t)pm * 256 * lda); u.b = (const char*)(B + (size_t)pn * 256 * ldb); u.x0 = pm; u.x1 = pn; return true; }
};
struct EpiUZ { static constexpr bool PERM = true; bf16* U; bf16* Z;
    __device__ __forceinline__ void operator()(const Acc& acc, const Unit& u, int wr, int wc, int fr, int fq) const {
        const int pm = u.x0, pn = u.x1; const bool isz = pn >= 16; bf16* base = isz ? Z : U; const int colt = (isz ? pn - 16 : pn) * 256 + wc * 32 + 8 * fq;
#pragma unroll
        for (int ai = 0; ai < 2; ++ai)
#pragma unroll
            for (int m = 0; m < 4; ++m) { const int r = pm * 256 + ai * 128 + wr * 64 + m * 16 + fr; bf16* rowp = base + (size_t)r * FW + colt;
#pragma unroll
                for (int bj = 0; bj < 2; ++bj) { f32x4 v0 = acc[ai][bj][m][0], v1 = acc[ai][bj][m][1];
                    if (isz) {
#pragma unroll
                        for (int j = 0; j < 4; ++j) { v0[j] = silu_f(v0[j]); v1[j] = silu_f(v1[j]); } }
                    v4u w; w.x = pk2(v0[0], v0[1]); w.y = pk2(v0[2], v0[3]); w.z = pk2(v1[0], v1[1]); w.w = pk2(v1[2], v1[3]);
                    *(v4u*)(rowp + bj * 128) = w; } }
    } };
struct SchedCDFT { const bf16* D; const bf16* U; int G, c;
    __device__ __forceinline__ bool next(int i, Unit& u) const { const long e = (long)i * G + c; if (e >= 2048) return false;
        const int cs = (int)e & 1, q = (int)e >> 1; int bb, g, tn;
        if (q < 512) { bb = q >> 4; g = q & 15; tn = 0; } else { const int q2 = q - 512; bb = NBP + (q2 >> 6); g = (q2 >> 2) & 15; tn = q2 & 3; }
        u.a = (const char*)(D + (size_t)cs * 256 * 256); u.b = (const char*)(U + ((size_t)(row0_of(bb) + tn * 256) * FW + g * 256));
        u.x0 = bb | (g << 8) | (cs << 16) | (tn << 20); u.x1 = 0; return true; } };
struct EpiCDFT { static constexpr bool PERM = true; bf16* T;
    __device__ __forceinline__ void operator()(const Acc& acc, const Unit& u, int wr, int wc, int fr, int fq) const {
        const int bb = u.x0 & 255, g = (u.x0 >> 8) & 255, cs = (u.x0 >> 16) & 15, tn = u.x0 >> 20; const int L = bb < NBP ? LPR : LSA;
        bf16* base = T + tb_of(bb) + (size_t)(g * 256) * (2 * L) + cs * L + tn * 256;
        const unsigned L2 = 2u * (unsigned)L; const unsigned off0 = (unsigned)(wr * 64 + fr) * L2 + (unsigned)(wc * 32 + 8 * fq);
#pragma unroll
        for (int ai = 0; ai < 2; ++ai)
#pragma unroll
            for (int m = 0; m < 4; ++m) { const unsigned off = off0 + (unsigned)(ai * 128 + m * 16) * L2;
#pragma unroll
                for (int bj = 0; bj < 2; ++bj) { const f32x4 v0 = acc[ai][bj][m][0], v1 = acc[ai][bj][m][1];
                    v4u w; w.x = pk2(v0[0], v0[1]); w.y = pk2(v0[2], v0[3]); w.z = pk2(v1[0], v1[1]); w.w = pk2(v1[2], v1[3]);
                    *(v4u*)(base + off + bj * 128) = w; }
                asm volatile("" ::: "memory"); }
    } };
struct SchedLDFT { const bf16* A4; const bf16* T; int sample, G, c;
    __device__ __forceinline__ bool next(int i, Unit& u) const { const long e = (long)i * G + c; if (e >= 512) return false; int bb, pm, pn;
        if (sample) { bb = NBP + ((int)e >> 6); pm = ((int)e >> 4) & 3; pn = (int)e & 15; } else { bb = (int)e >> 4; pm = 0; pn = (int)e & 15; }
        const int L2 = sample ? 2 * LSA : 2 * LPR;
        u.a = (const char*)(A4 + (size_t)pm * 256 * L2); u.b = (const char*)(T + tb_of(bb) + (size_t)pn * 256 * L2);
        u.x0 = row0_of(bb) + pm * 256; u.x1 = pn; return true; } };
struct EpiLDFT { static constexpr bool PERM = true; const bf16* Z; bf16* YG; float sc;
    __device__ __forceinline__ void operator()(const Acc& acc, const Unit& u, int wr, int wc, int fr, int fq) const {
        const int rb = u.x0, pn = u.x1; const int colt = pn * 256 + wc * 32 + 8 * fq;
#pragma unroll
        for (int ai = 0; ai < 2; ++ai)
#pragma unroll
            for (int m = 0; m < 4; ++m) { const size_t off = (size_t)(rb + ai * 128 + wr * 64 + m * 16 + fr) * FW + colt;
#pragma unroll
                for (int bj = 0; bj < 2; ++bj) { const f32x4 v0 = acc[ai][bj][m][0] * sc, v1 = acc[ai][bj][m][1] * sc;
                    const v4u z = *(const v4u*)(Z + off + bj * 128);
                    v4u w; w.x = pk2(v0[0] * bf_lo(z.x), v0[1] * bf_hi(z.x)); w.y = pk2(v0[2] * bf_lo(z.y), v0[3] * bf_hi(z.y));
                    w.z = pk2(v1[0] * bf_lo(z.z), v1[1] * bf_hi(z.z)); w.w = pk2(v1[2] * bf_lo(z.w), v1[3] * bf_hi(z.w));
                    *(v4u*)(YG + off + bj * 128) = w; } }
    } };
struct EpiRes0 { static constexpr bool PERM = false; const float* xp; const float* xs; const float* pos; const float* mod0; float* V;
    __device__ __forceinline__ void operator()(const Acc& acc, const Unit& u, int wr, int wc, int fr, int fq) const {
        const int pm = u.x0, pn = u.x1; const int rt = pm * 256; const bool smp = rt >= NPR;
        const float* gate = mod0 + (size_t)cond_of_row(rt) * 6144 + 4096;
        const int col0 = pn * 256 + wc * 32 + 4 * fq;
        f32x4 gv[2][2];
#pragma unroll
        for (int bj = 0; bj < 2; ++bj)
#pragma unroll
            for (int n = 0; n < 2; ++n) gv[bj][n] = *(const f32x4*)(gate + col0 + bj * 128 + n * 16);
#pragma unroll
        for (int ai = 0; ai < 2; ++ai)
#pragma unroll
            for (int m = 0; m < 4; ++m) { const int r = rt + ai * 128 + wr * 64 + m * 16 + fr;
                const float* xr = smp ? xs + (size_t)(r - NPR) * DM : xp + (size_t)r * DM; const float* pr = pos + (size_t)((r - NPR) & (LSA - 1)) * DM;
#pragma unroll
                for (int bj = 0; bj < 2; ++bj)
#pragma unroll
                    for (int n = 0; n < 2; ++n) { const int cc = col0 + bj * 128 + n * 16; f32x4 x0 = *(const f32x4*)(xr + cc); if (smp) x0 = x0 + *(const f32x4*)(pr + cc);
                        *(f32x4*)(V + (size_t)r * DM + cc) = x0 * DN_ALPHA + gv[bj][n] * acc[ai][bj][m][n]; }
                asm volatile("" ::: "memory"); }
    } };
struct EpiProj { static constexpr bool PERM = true; bf16* Z; bf16* XBC; float* DT;
    __device__ __forceinline__ void operator()(const Acc& acc, const Unit& u, int wr, int wc, int fr, int fq) const {
        const int pm = u.x0, pn = u.x1;
#pragma unroll
        for (int ai = 0; ai < 2; ++ai)
#pragma unroll
            for (int m = 0; m < 4; ++m) { const int r = pm * 256 + ai * 128 + wr * 64 + m * 16 + fr;
#pragma unroll
                for (int bj = 0; bj < 2; ++bj) { f32x4 v0 = acc[ai][bj][m][0], v1 = acc[ai][bj][m][1]; const int cl = bj * 128 + wc * 32 + 8 * fq;
                    if (pn < 16) {
#pragma unroll
                        for (int j = 0; j < 4; ++j) { v0[j] = silu_f(v0[j]); v1[j] = silu_f(v1[j]); }
                        v4u w; w.x = pk2(v0[0], v0[1]); w.y = pk2(v0[2], v0[3]); w.z = pk2(v1[0], v1[1]); w.w = pk2(v1[2], v1[3]);
                        *(v4u*)(Z + (size_t)r * FW + pn * 256 + cl) = w;
                    } else if (pn < 40) {
                        v4u w; w.x = pk2(v0[0], v0[1]); w.y = pk2(v0[2], v0[3]); w.z = pk2(v1[0], v1[1]); w.w = pk2(v1[2], v1[3]);
                        *(v4u*)(XBC + (size_t)r * CONVD + (pn - 16) * 256 + cl) = w;
                    } else if (bj == 0) {
                        *(f32x4*)(DT + (size_t)r * 128 + cl) = v0; *(f32x4*)(DT + (size_t)r * 128 + cl + 4) = v1;
                    } } }
    } };
struct EpiRes1 { static constexpr bool PERM = false; const float* mod1; const float* SSQ; float* V;
    __device__ __forceinline__ void operator()(const Acc& acc, const Unit& u, int wr, int wc, int fr, int fq) const {
        const int pm = u.x0, pn = u.x1; const int rt = pm * 256;
        const float* gate = mod1 + (size_t)cond_of_row(rt) * 6144 + 4096;
        const int col0 = pn * 256 + wc * 32 + 4 * fq;
        f32x4 gv[2][2];
#pragma unroll
        for (int bj = 0; bj < 2; ++bj)
#pragma unroll
            for (int n = 0; n < 2; ++n) gv[bj][n] = *(const f32x4*)(gate + col0 + bj * 128 + n * 16);
#pragma unroll
        for (int ai = 0; ai < 2; ++ai)
#pragma unroll
            for (int m = 0; m < 4; ++m) { const int r = rt + ai * 128 + wr * 64 + m * 16 + fr;
                const f32x4* sp = (const f32x4*)(SSQ + (size_t)r * 16); const f32x4 s0 = sp[0], s1 = sp[1], s2 = sp[2], s3 = sp[3];
                const float ss = ((s0[0] + s0[1]) + (s0[2] + s0[3])) + ((s1[0] + s1[1]) + (s1[2] + s1[3])) + ((s2[0] + s2[1]) + (s2[2] + s2[3])) + ((s3[0] + s3[1]) + (s3[2] + s3[3]));
                const float rs = 1.0f / sqrtf(ss * (1.0f / FW) + LN_EPS);
#pragma unroll
                for (int bj = 0; bj < 2; ++bj)
#pragma unroll
                    for (int n = 0; n < 2; ++n) { float* vp = V + (size_t)r * DM + col0 + bj * 128 + n * 16; const f32x4 x1 = *(const f32x4*)vp;
                        *(f32x4*)vp = x1 * DN_ALPHA + gv[bj][n] * (acc[ai][bj][m][n] * rs); }
                asm volatile("" ::: "memory"); }
    } };

__device__ __forceinline__ void p0_transpose_item(const float* W, int K, int N, bf16* WT, LAS float* scr, int item, int lane) {
    const int nblk = N / 32, kb = item / nblk, nb = item % nblk, k0 = 64 * kb, n0 = 32 * nb;
#pragma unroll 8
    for (int i = 0; i < 32; ++i) { const int kk = 2 * i + (lane >> 5); scr[kk * 33 + (lane & 31)] = W[(size_t)(k0 + kk) * N + n0 + (lane & 31)]; }
    LDS_WAIT(); asm volatile("" ::: "memory");
    const int c = lane & 7;
#pragma unroll
    for (int j = 0; j < 4; ++j) { const int n = (lane >> 3) + 8 * j; const LAS float* s = scr + (8 * c) * 33 + n;
        v4u o; o.x = pk2(s[0 * 33], s[1 * 33]); o.y = pk2(s[2 * 33], s[3 * 33]); o.z = pk2(s[4 * 33], s[5 * 33]); o.w = pk2(s[6 * 33], s[7 * 33]);
        *(v4u*)(WT + (size_t)(n0 + n) * K + k0 + 8 * c) = o; }
    LDS_WAIT(); asm volatile("" ::: "memory");
}
__device__ __forceinline__ void p0_prologue(Frame& F) {
    const int gw = F.bx * NWAVES + F.wave, NGW = F.G * NWAVES;
    const size_t gt = (size_t)F.bx * NTHR + F.tid, NGT = (size_t)F.G * NTHR;
    LAS float* sc = (LAS float*)F.lds;
    for (int i = F.tid; i < 9 * DM; i += NTHR) { const float v = i < DM ? F.ap->in[4][i] : F.ap->in[3][i - DM]; sc[i] = silu_f(v); }
    __syncthreads();
    float* mod = (float*)(F.ws + WS_MOD);
    for (int it = gw; it < 2 * 96 * 16; it += NGW) {
        const int ks = it & 15, cb = (it >> 4) % 96, layer = it / (16 * 96);
        const int n = cb * 64 + F.lane; const float* wp = F.ap->in[5] + ((size_t)layer * DM + ks * 128) * 6144 + n;
        float a[9];
#pragma unroll
        for (int r = 0; r < 9; ++r) a[r] = 0.f;
#pragma unroll 8
        for (int k = 0; k < 128; ++k) { const float w = wp[(size_t)k * 6144];
#pragma unroll
            for (int r = 0; r < 9; ++r) a[r] += sc[r * DM + ks * 128 + k] * w; }
        const float bias = ks == 0 ? F.ap->in[6][layer * 6144 + n] : 0.f;
#pragma unroll
        for (int r = 0; r < 9; ++r) atomicAdd(mod + ((size_t)layer * 9 + r) * 6144 + n, a[r] + bias);
    }
    __syncthreads();
    LAS float* scr = (LAS float*)(F.lds + F.wave * 16384);
    constexpr int I_FI = (DM / 64) * (8192 / 32), I_FO = (FW / 64) * (DM / 32), I_SI = (DM / 64) * (SSD_IN / 32), I_SO = (FW / 64) * (DM / 32);
    for (int it = gw; it < I_FI + I_FO + I_SI + I_SO; it += NGW) {
        int r = it;
        if (r < I_FI) { p0_transpose_item(F.ap->in[9], DM, 8192, (bf16*)(F.ws + WS_WFI), scr, r, F.lane); continue; } r -= I_FI;
        if (r < I_FO) { p0_transpose_item(F.ap->in[10], FW, DM, (bf16*)(F.ws + WS_WFO), scr, r, F.lane); continue; } r -= I_FO;
        if (r < I_SI) { p0_transpose_item(F.ap->in[11], DM, SSD_IN, (bf16*)(F.ws + WS_WSI), scr, r, F.lane); continue; } r -= I_SI;
        p0_transpose_item(F.ap->in[18], FW, DM, (bf16*)(F.ws + WS_WSO), scr, r, F.lane);
    }
    { v4u* zp = (v4u*)((bf16*)(F.ws + WS_WSI) + (size_t)SSD_IN * DM); const size_t nz = (size_t)(SSD_IN_PAD - SSD_IN) * DM / 8;
      for (size_t i = gt; i < nz; i += NGT) zp[i] = (v4u){0u, 0u, 0u, 0u}; }
    { bf16* D = (bf16*)(F.ws + WS_D256);
      for (size_t i = gt; i < 512 * 256; i += NGT) { const int j = (int)(i >> 8), n = (int)i & 255; const int idx = ((j & 255) * n) & 255; float s, c; sincospif((float)idx * (1.0f / 128.0f), &s, &c); D[i] = (bf16)f2bf(j < 256 ? c : s); } }
    { bf16* A = (bf16*)(F.ws + WS_A4P);
      for (size_t i = gt; i < 256 * 512; i += NGT) { const int k = (int)(i >> 9), kk = (int)i & 511; const int idx = (k * (kk & 255)) & 255; float s, c; sincospif((float)idx * (1.0f / 128.0f), &s, &c); A[i] = (bf16)f2bf(kk < 256 ? c : -s); } }
    { bf16* A = (bf16*)(F.ws + WS_A4S);
      for (size_t i = gt; i < (size_t)1024 * 2048; i += NGT) { const int k = (int)(i >> 11), kk = (int)i & 2047; const int idx = (k * (kk & 1023)) & 1023; float s, c; sincospif((float)idx * (1.0f / 512.0f), &s, &c); A[i] = (bf16)f2bf(kk < 1024 ? c : -s); } }
    { float* P = (float*)(F.ws + WS_POS);
      for (size_t i = gt; i < (size_t)LSA * DM; i += NGT) { const int t = (int)(i >> 11), j = (int)i & 2047; const int qd = j >> 9, ii = j & 511; const int p = qd < 2 ? (t >> 6) : (t & 63);
          const float om = expf(-9.210340371976184f * (float)ii * (1.0f / 512.0f)); const float ang = (float)p * om; P[i] = (qd & 1) ? cosf(ang) : sinf(ang); } }
}

__device__ __forceinline__ void row_stats(const f32x4 (&v)[8], float& mean, float& rstd) {
    float s = 0.f;
#pragma unroll
    for (int j = 0; j < 8; ++j) s += (v[j][0] + v[j][1]) + (v[j][2] + v[j][3]);
    mean = wave_sum(s) * (1.f / DM); float s2 = 0.f;
#pragma unroll
    for (int j = 0; j < 8; ++j) { const f32x4 d = v[j] - mean; s2 += (d[0] * d[0] + d[1] * d[1]) + (d[2] * d[2] + d[3] * d[3]); }
    rstd = 1.f / sqrtf(wave_sum(s2) * (1.f / DM) + LN_EPS);
}
__device__ __forceinline__ void modulate_store(const f32x4 (&v)[8], float mean, float rstd, const float* modrow, bf16* hrow, int lane) {
    const f32x4* sh = (const f32x4*)modrow + lane; const f32x4* scp = (const f32x4*)(modrow + DM) + lane; v2u* o = (v2u*)hrow + lane;
#pragma unroll
    for (int j = 0; j < 8; ++j) { const f32x4 y = (v[j] - mean) * rstd * (scp[64 * j] + 1.0f) + sh[64 * j]; v2u w; w.x = pk2(y[0], y[1]); w.y = pk2(y[2], y[3]); o[64 * j] = w; }
}
__device__ __forceinline__ void p1_ln_mod(Frame& F) {
    const int gw = F.bx * NWAVES + F.wave, NGW = F.G * NWAVES; const float* mod0 = (const float*)(F.ws + WS_MOD); const float* pos = (const float*)(F.ws + WS_POS); bf16* H = (bf16*)(F.ws + WS_H);
    for (int r = gw; r < NTOK; r += NGW) {
        const bool smp = r >= NPR; const f32x4* xr = (const f32x4*)(smp ? F.ap->in[1] + (size_t)(r - NPR) * DM : F.ap->in[0] + (size_t)r * DM) + F.lane;
        const f32x4* pr = (const f32x4*)(pos + (size_t)((r - NPR) & (LSA - 1)) * DM) + F.lane;
        f32x4 v[8];
#pragma unroll
        for (int j = 0; j < 8; ++j) { v[j] = xr[64 * j]; if (smp) v[j] = v[j] + pr[64 * j]; }
        float mean, rstd; row_stats(v, mean, rstd);
        modulate_store(v, mean, rstd, mod0 + (size_t)cond_of_row(r) * 6144, H + (size_t)r * DM, F.lane);
    }
}
__device__ __forceinline__ void p6_ln_ln_mod(Frame& F) {
    const int gw = F.bx * NWAVES + F.wave, NGW = F.G * NWAVES; const float* mod1 = (const float*)(F.ws + WS_MOD) + 9 * 6144; float* V = (float*)(F.ws + WS_V); bf16* H = (bf16*)(F.ws + WS_H);
    const f32x4* gp = (const f32x4*)F.ap->in[7] + F.lane; const f32x4* bp = (const f32x4*)F.ap->in[8] + F.lane;
    for (int r = gw; r < NTOK; r += NGW) {
        f32x4* vr = (f32x4*)(V + (size_t)r * DM) + F.lane; f32x4 v[8];
#pragma unroll
        for (int j = 0; j < 8; ++j) v[j] = vr[64 * j];
        float mean, rstd; row_stats(v, mean, rstd);
#pragma unroll
        for (int j = 0; j < 8; ++j) { v[j] = (v[j] - mean) * rstd * gp[64 * j] + bp[64 * j]; vr[64 * j] = v[j]; }
        row_stats(v, mean, rstd);
        modulate_store(v, mean, rstd, mod1 + (size_t)cond_of_row(r) * 6144, H + (size_t)r * DM, F.lane);
    }
}
__device__ __forceinline__ void p11_final_ln(Frame& F) {
    const int gw = F.bx * NWAVES + F.wave, NGW = F.G * NWAVES; const float* V = (const float*)(F.ws + WS_V);
    const f32x4* gp = (const f32x4*)(F.ap->in[7] + DM) + F.lane; const f32x4* bp = (const f32x4*)(F.ap->in[8] + DM) + F.lane;
    for (int r = gw; r < NTOK; r += NGW) {
        const f32x4* vr = (const f32x4*)(V + (size_t)r * DM) + F.lane; f32x4* o = (f32x4*)(F.out + (size_t)r * DM) + F.lane; f32x4 v[8];
#pragma unroll
        for (int j = 0; j < 8; ++j) v[j] = vr[64 * j];
        float mean, rstd; row_stats(v, mean, rstd);
#pragma unroll
        for (int j = 0; j < 8; ++j) o[64 * j] = (v[j] - mean) * rstd * gp[64 * j] + bp[64 * j];
    }
}
__device__ __forceinline__ void p8_conv(Frame& F) {
    const bf16* XBC = (const bf16*)(F.ws + WS_XBC); bf16* XT = (bf16*)(F.ws + WS_XT); bf16* BN = (bf16*)(F.ws + WS_BN); bf16* CN = (bf16*)(F.ws + WS_CN); bf16* BT = (bf16*)(F.ws + WS_BT);
    LAS bf16* tile = (LAS bf16*)F.lds;
    const int co = F.tid & 31, tr = F.tid >> 5;
    const bool bal = F.G == 256; const int NIT = (NTOK / 64) * 24;
    const int i0 = bal ? (F.bx < 64 ? F.bx : 1024 + (F.bx - 64)) : F.bx, istep = bal ? (F.bx < 64 ? 64 : 192) : F.G, iend = bal && F.bx < 64 ? 1024 : NIT;
    for (int item = i0; item < iend; item += istep) {
        const int tb = item / 24, cb = item % 24; const int t0 = tb * 64;
        const int lo = t0 < NPR ? (t0 & ~(LPR - 1)) : NPR + ((t0 - NPR) & ~(LSA - 1)); const int hi = lo + (t0 < NPR ? LPR : LSA);
        const int ch = cb * 256 + co * 8; const int tq = t0 + 4 * tr;
        float w[5][8], bias[8];
#pragma unroll
        for (int k = 0; k < 5; ++k) { const f32x4 a = *(const f32x4*)(F.ap->in[12] + (size_t)k * CONVD + ch), b = *(const f32x4*)(F.ap->in[12] + (size_t)k * CONVD + ch + 4);
#pragma unroll
            for (int e = 0; e < 4; ++e) { w[k][e] = a[e]; w[k][4 + e] = b[e]; } }
        { const f32x4 a = *(const f32x4*)(F.ap->in[13] + ch), b = *(const f32x4*)(F.ap->in[13] + ch + 4);
#pragma unroll
          for (int e = 0; e < 4; ++e) { bias[e] = a[e]; bias[4 + e] = b[e]; } }
        v4u raw[8];
#pragma unroll
        for (int k = 0; k < 8; ++k) { const int tt = tq + k - 2; raw[k] = (v4u){0u, 0u, 0u, 0u}; if (tt >= lo && tt < hi) raw[k] = *(const v4u*)(XBC + (size_t)tt * CONVD + ch); }
        float o[4][8];
#pragma unroll
        for (int j = 0; j < 4; ++j)
#pragma unroll
            for (int e = 0; e < 8; ++e) o[j][e] = bias[e];
#pragma unroll
        for (int k = 0; k < 8; ++k) { const float rv[8] = {bf_lo(raw[k].x), bf_hi(raw[k].x), bf_lo(raw[k].y), bf_hi(raw[k].y), bf_lo(raw[k].z), bf_hi(raw[k].z), bf_lo(raw[k].w), bf_hi(raw[k].w)};
#pragma unroll
            for (int j = 0; j < 4; ++j) { const int kk = k - j;
                if (kk >= 0 && kk < 5) {
#pragma unroll
                    for (int e = 0; e < 8; ++e) o[j][e] += rv[e] * w[kk][e]; } } }
        unsigned pw[4][4];
#pragma unroll
        for (int j = 0; j < 4; ++j) {
#pragma unroll
            for (int e = 0; e < 8; ++e) o[j][e] = silu_f(o[j][e]);
            pw[j][0] = pk2(o[j][0], o[j][1]); pw[j][1] = pk2(o[j][2], o[j][3]); pw[j][2] = pk2(o[j][4], o[j][5]); pw[j][3] = pk2(o[j][6], o[j][7]); }
        if (cb >= 16) {
            bf16* dst = (cb < 20 ? BN + (cb - 16) * 256 : CN + (cb - 20) * 256) + co * 8;
#pragma unroll
            for (int j = 0; j < 4; ++j) *(v4u*)(dst + (size_t)(tq + j) * 1024) = (v4u){pw[j][0], pw[j][1], pw[j][2], pw[j][3]};
        }
        if (cb < 20) {
            __syncthreads();
#pragma unroll
            for (int e = 0; e < 8; ++e) { const int row = co * 8 + e; LAS bf16* rp = tile + row * 64 + (((tr >> 1) ^ (co & 7)) << 3) + (tr & 1) * 4;
                const unsigned sh = (e & 1) * 16;
                v2u pk; pk.x = ((pw[0][e >> 1] >> sh) & 0xffffu) | (((pw[1][e >> 1] >> sh) & 0xffffu) << 16); pk.y = ((pw[2][e >> 1] >> sh) & 0xffffu) | (((pw[3][e >> 1] >> sh) & 0xffffu) << 16);
                *(LAS v2u*)rp = pk; }
            __syncthreads();
            bf16* dstT = cb < 16 ? XT + (size_t)(cb * 256) * NTOK : BT + (size_t)((cb - 16) * 256) * NTOK;
#pragma unroll
            for (int k = 0; k < 4; ++k) { const int id = F.tid + 512 * k, row = id >> 3, oct = id & 7;
                const v4u v = *(const LAS v4u*)(tile + row * 64 + ((oct ^ ((row >> 3) & 7)) << 3));
                *(v4u*)(dstT + (size_t)row * NTOK + t0 + oct * 8) = v; }
        }
    }
}

namespace scan {
constexpr int PITCH = 272, IMG = 128 * PITCH;
constexpr int CM_OFF = 0, BM_OFF = IMG, SH_OFF = BM_OFF, BMT_OFF = 2 * IMG, XT_OFF = 3 * IMG, XT_BYTES = 64 * PITCH;
constexpr int TAB_OFF = 4 * IMG;
constexpr int T_DTS = TAB_OFF, T_ACS = TAB_OFF + 2048, T_EA = TAB_OFF + 4096, T_WV = TAB_OFF + 6144, T_WT = TAB_OFF + 8192, T_TOT = TAB_OFF + 8192 + 64;
static_assert(T_TOT + 64 <= MISC_OFF, "scan LDS map");
__device__ __forceinline__ float softplus_f(float x) { return x > 20.f ? x : log1pf(expf(x)); }
__device__ __forceinline__ void dma_image(LAS unsigned char* img, const char* src, size_t rstride, int npieces, int wid, int lane) {
    for (int P = wid; P < npieces; P += 8) { const int x = 1024 * P + 16 * lane; const int row = x / PITCH; int ch = (x - row * PITCH) >> 4; ch = ch == 16 ? 0 : ch;
        __builtin_amdgcn_global_load_lds((const unsigned*)(src + (size_t)row * rstride + ch * 16), (LAS unsigned*)(img + P * 1024), 16, 0, 0); }
}
#define LD16(p) (*(const LAS bf16x8*)(p))
#define LD8(p) (*(const LAS v2u*)(p))

__device__ __forceinline__ void unit(Frame& F, const int bb, const int g, const int hh) {
    LAS unsigned char* lds = F.lds;
    LAS float* tDTS = (LAS float*)(lds + T_DTS); LAS float* tACS = (LAS float*)(lds + T_ACS);
    LAS float* tEA = (LAS float*)(lds + T_EA); LAS float* tWV = (LAS float*)(lds + T_WV); LAS float* tWT = (LAS float*)(lds + T_WT); LAS float* tTOT = (LAS float*)(lds + T_TOT);
    const int tid = F.tid, lane = F.lane, wid = F.wave, c16 = lane & 15, q = lane >> 4;
    const bool smp = bb >= NBP; const int L = smp ? LSA : LPR, nc = L / 128, row0 = row0_of(bb);
    const char* BNg = (const char*)(F.ws + WS_BN); const char* CNg = (const char*)(F.ws + WS_CN); const char* BTg = (const char*)(F.ws + WS_BT); const char* XTg = (const char*)(F.ws + WS_XT);
    const bf16* Zg = (const bf16*)(F.ws + WS_Z); const float* DTg = (const float*)(F.ws + WS_DT); bf16* Yg = (bf16*)(F.ws + WS_Y); float* SSQ = (float*)(F.ws + WS_SSQ);
    const int hbase = g * 8 + hh * 4;
    const int lcol = 16 * wid + c16;
    const int aL = lcol * PITCH + 16 * q;
    const int aP = c16 * PITCH + 16 * q;
    const int aP8 = c16 * PITCH + 8 * q;
    const int aX = (4 * q) * PITCH + 2 * lcol;
    for (int dir = 0; dir < 2; ++dir) {
        f32x4 S[4][4];
#pragma unroll
        for (int hd = 0; hd < 4; ++hd)
#pragma unroll
            for (int pt = 0; pt < 4; ++pt) {
                if (smp) S[hd][pt] = *(const f32x4*)(F.ap->in[2] + ((((size_t)(bb - NBP) * 2 + dir) * 64 + hbase + hd) * 64 + 16 * pt + c16) * 128 + 16 * wid + 4 * q);
                else S[hd][pt] = (f32x4){0.f, 0.f, 0.f, 0.f}; }
        for (int step = 0; step < nc; ++step) {
            const int ck = dir == 0 ? step : nc - 1 - step; const int t0 = row0 + ck * 128;
            __syncthreads();
            dma_image(lds + CM_OFF, CNg + ((size_t)t0 * 1024 + g * 128) * 2, 2048, 34, wid, lane);
            dma_image(lds + BM_OFF, BNg + ((size_t)t0 * 1024 + g * 128) * 2, 2048, 34, wid, lane);
            dma_image(lds + BMT_OFF, BTg + ((size_t)(g * 128) * NTOK + t0) * 2, (size_t)NTOK * 2, 34, wid, lane);
            dma_image(lds + XT_OFF, XTg + ((size_t)(hbase * 64) * NTOK + t0) * 2, (size_t)NTOK * 2, 17, wid, lane);
            { const int hd = tid >> 7, l = tid & 127, h = hbase + hd; const float raw = DTg[(size_t)(t0 + l) * 128 + dir * 64 + h];
              const float dtv = softplus_f(raw + F.ap->in[14][dir * 64 + h]); const float da = dtv * (-expf(F.ap->in[15][dir * 64 + h]));
              float v = da;
#pragma unroll
              for (int o = 1; o < 64; o <<= 1) { const float t = __shfl_up(v, o); if (lane >= o) v += t; }
              if (lane == 63) tWT[wid] = v;
              tDTS[tid] = dtv;
              asm volatile("s_waitcnt vmcnt(0) lgkmcnt(0)" ::: "memory");
              __syncthreads();
              const float lowt = tWT[2 * hd], tot = lowt + tWT[2 * hd + 1];
              if (l >= 64) v += lowt;
              const float acs = dir == 0 ? v : (tot - v + da);
              tACS[tid] = acs; tEA[tid] = expf(acs); tWV[tid] = expf(tot - acs) * dtv; if (l == 0) tTOT[hd] = tot; }
            v2u Gt[8];
            { bf16x8 cf[4];
#pragma unroll
              for (int ks = 0; ks < 4; ++ks) cf[ks] = LD16(lds + CM_OFF + aL + 64 * ks);
#pragma unroll
              for (int st = 0; st < 8; ++st) { f32x4 a = (f32x4){0.f, 0.f, 0.f, 0.f};
#pragma unroll
                  for (int ks = 0; ks < 4; ++ks) a = __builtin_amdgcn_mfma_f32_16x16x32_bf16(LD16(lds + BM_OFF + aP + st * (16 * PITCH) + 64 * ks), cf[ks], a, 0, 0, 0);
                  Gt[st].x = pk2(a[0], a[1]); Gt[st].y = pk2(a[2], a[3]); } }
            __syncthreads();
            float ssq = 0.f;
#pragma unroll 1
            for (int hd = 0; hd < 4; ++hd) {
                const int h = hbase + hd;
                LAS unsigned char* XT = lds + XT_OFF + (hd & 1) * XT_BYTES;
                if (hd < 3) dma_image(lds + XT_OFF + ((hd + 1) & 1) * XT_BYTES, XTg + ((size_t)((h + 1) * 64) * NTOK + t0) * 2, (size_t)NTOK * 2, 17, wid, lane);
                const size_t go = (size_t)(t0 + lcol) * FW + h * 64 + 4 * q;
#pragma unroll
                for (int pt = 0; pt < 4; ++pt) { v2u w; w.x = pk2(S[0][pt][0], S[0][pt][1]); w.y = pk2(S[0][pt][2], S[0][pt][3]); *(LAS v2u*)(lds + SH_OFF + aP8 + 32 * wid + pt * (16 * PITCH)) = w; }
                LDS_WAIT();
                __syncthreads();
                f32x4 acc[4];
#pragma unroll
                for (int pt = 0; pt < 4; ++pt) acc[pt] = (f32x4){0.f, 0.f, 0.f, 0.f};
#pragma unroll
                for (int ks = 0; ks < 4; ++ks) { const bf16x8 b = LD16(lds + CM_OFF + aL + 64 * ks);
#pragma unroll
                    for (int pt = 0; pt < 4; ++pt) acc[pt] = __builtin_amdgcn_mfma_f32_16x16x32_bf16(LD16(lds + SH_OFF + aP + pt * (16 * PITCH) + 64 * ks), b, acc[pt], 0, 0, 0); }
                asm volatile("" ::: "memory");
                { const float e = tEA[hd * 128 + lcol];
#pragma unroll
                  for (int pt = 0; pt < 4; ++pt) acc[pt] = acc[pt] * e; }
                v2u zz[4], yp[4];
#pragma unroll
                for (int pt = 0; pt < 4; ++pt) { zz[pt] = (v2u){0u, 0u}; yp[pt] = (v2u){0u, 0u}; }
                if (dir == 1) {
#pragma unroll
                    for (int pt = 0; pt < 4; ++pt) { zz[pt] = *(const v2u*)(Zg + go + 16 * pt); yp[pt] = *(const v2u*)(Yg + go + 16 * pt); } }
                { int lc = lcol; asm volatile("" : "+v"(lc)); const float al = tACS[hd * 128 + lcol];
#pragma unroll
                  for (int ks = 0; ks < 4; ++ks) { const int s0 = 32 * ks + 4 * q;
                      const f32x4 as0 = *(const LAS f32x4*)(tACS + hd * 128 + s0), as1 = *(const LAS f32x4*)(tACS + hd * 128 + s0 + 16);
                      const f32x4 d0 = *(const LAS f32x4*)(tDTS + hd * 128 + s0), d1 = *(const LAS f32x4*)(tDTS + hd * 128 + s0 + 16);
                      float f[8];
#pragma unroll
                      for (int j = 0; j < 8; ++j) { const int s = s0 + (j & 3) + 16 * (j >> 2); const bool in = dir == 0 ? (s <= lc) : (s >= lc);
                          const float as = j < 4 ? as0[j & 3] : as1[j & 3]; const float dd = j < 4 ? d0[j & 3] : d1[j & 3]; const unsigned gw = (j & 2) ? (j < 4 ? Gt[2 * ks].y : Gt[2 * ks + 1].y) : (j < 4 ? Gt[2 * ks].x : Gt[2 * ks + 1].x); const float gv = (j & 1) ? bf_hi(gw) : bf_lo(gw);
                          const float ex = __expf(in ? (al - as) : 0.f); f[j] = in ? ex * dd * gv : 0.f; }
                      v4u bw; bw.x = pk2(f[0], f[1]); bw.y = pk2(f[2], f[3]); bw.z = pk2(f[4], f[5]); bw.w = pk2(f[6], f[7]); const bf16x8 b = __builtin_bit_cast(bf16x8, bw);
#pragma unroll
                      for (int pt = 0; pt < 4; ++pt) { const v2u x0 = LD8(XT + aP8 + pt * (16 * PITCH) + 64 * ks), x1 = LD8(XT + aP8 + pt * (16 * PITCH) + 64 * ks + 32);
                          const v4u aw = (v4u){x0.x, x0.y, x1.x, x1.y};
                          acc[pt] = __builtin_amdgcn_mfma_f32_16x16x32_bf16(__builtin_bit_cast(bf16x8, aw), b, acc[pt], 0, 0, 0); } } }
                asm volatile("" ::: "memory");
                if (dir == 0) { const float dsk = F.ap->in[16][h];
#pragma unroll
                    for (int pt = 0; pt < 4; ++pt) { float y[4];
#pragma unroll
                        for (int r = 0; r < 4; ++r) y[r] = acc[pt][r] + dsk * bf2f(*(const LAS bf16*)(XT + aX + (16 * pt + r) * PITCH));
                        v2u o; o.x = pk2(y[0], y[1]); o.y = pk2(y[2], y[3]); *(v2u*)(Yg + go + 16 * pt) = o; }
                } else {
#pragma unroll
                    for (int pt = 0; pt < 4; ++pt) { const f32x4 nw = *(const f32x4*)(F.ap->in[17] + h * 64 + 16 * pt + 4 * q);
                        const float y0 = (acc[pt][0] + bf_lo(yp[pt].x)) * bf_lo(zz[pt].x), y1 = (acc[pt][1] + bf_hi(yp[pt].x)) * bf_hi(zz[pt].x);
                        const float y2 = (acc[pt][2] + bf_lo(yp[pt].y)) * bf_lo(zz[pt].y), y3 = (acc[pt][3] + bf_hi(yp[pt].y)) * bf_hi(zz[pt].y);
                        ssq += (y0 * y0 + y1 * y1) + (y2 * y2 + y3 * y3);
                        v2u o; o.x = pk2(y0 * nw[0], y1 * nw[1]); o.y = pk2(y2 * nw[2], y3 * nw[3]); *(v2u*)(Yg + go + 16 * pt) = o; }
                }
                asm volatile("" ::: "memory");
                { const float dec = expf(tTOT[hd]);
#pragma unroll
                  for (int pt = 0; pt < 4; ++pt) S[0][pt] = S[0][pt] * dec;
#pragma unroll
                  for (int ks = 0; ks < 4; ++ks) { const int s0 = 32 * ks + 8 * q; const v4u b8 = *(const LAS v4u*)(lds + BMT_OFF + aL + 64 * ks);
                      const f32x4 w0 = *(const LAS f32x4*)(tWV + hd * 128 + s0), w1 = *(const LAS f32x4*)(tWV + hd * 128 + s0 + 4);
                      v4u w; w.x = pk2(bf_lo(b8.x) * w0[0], bf_hi(b8.x) * w0[1]); w.y = pk2(bf_lo(b8.y) * w0[2], bf_hi(b8.y) * w0[3]);
                      w.z = pk2(bf_lo(b8.z) * w1[0], bf_hi(b8.z) * w1[1]); w.w = pk2(bf_lo(b8.w) * w1[2], bf_hi(b8.w) * w1[3]);
                      const bf16x8 a = __builtin_bit_cast(bf16x8, w);
#pragma unroll
                      for (int pt = 0; pt < 4; ++pt) S[0][pt] = __builtin_amdgcn_mfma_f32_16x16x32_bf16(a, LD16(XT + aP + pt * (16 * PITCH) + 64 * ks), S[0][pt], 0, 0, 0); } }
#pragma unroll
                for (int pt = 0; pt < 4; ++pt) { const f32x4 t0v = S[0][pt]; S[0][pt] = S[1][pt]; S[1][pt] = S[2][pt]; S[2][pt] = S[3][pt]; S[3][pt] = t0v; }
                asm volatile("s_waitcnt vmcnt(0) lgkmcnt(0)" ::: "memory");
                __syncthreads();
            }
            if (dir == 1) { float v = ssq; v += __shfl_xor(v, 16); v += __shfl_xor(v, 32);
                if (q == 0) SSQ[(size_t)(t0 + lcol) * 16 + g * 2 + hh] = v; }
        }
        if (!smp) {
            float* so = F.out + (size_t)NTOK * DM;
#pragma unroll
            for (int hd = 0; hd < 4; ++hd)
#pragma unroll
                for (int pt = 0; pt < 4; ++pt) *(f32x4*)(so + ((((size_t)bb * 2 + dir) * 64 + hbase + hd) * 64 + 16 * pt + c16) * 128 + 16 * wid + 4 * q) = S[hd][pt];
        }
    }
}
#undef LD16
#undef LD8
__device__ __forceinline__ void phase(Frame& F) {
    const bool bal = F.G == 256;
    const int nu = bal ? (F.bx < 128 ? 1 : 4) : (640 - F.bx + F.G - 1) / F.G;
#pragma unroll 1
    for (int i = 0; i < nu; ++i) {
        int bb, g, hh;
        if (bal) {
            if (F.bx < 128) { const int u = F.bx; bb = NBP + (u >> 4); g = u & 7; hh = (u >> 3) & 1; }
            else { const int w2 = F.bx - 128, rest = (w2 & 7) | ((w2 >> 4) << 3), idx = rest * 4 + i; hh = (w2 >> 3) & 1; bb = idx >> 3; g = idx & 7; }
        } else { const int u = F.bx + i * F.G; if (u < 128) { bb = NBP + (u >> 4); g = (u >> 1) & 7; hh = u & 1; } else { const int p = u - 128; bb = p >> 4; g = (p >> 1) & 7; hh = p & 1; } }
        unit(F, bb, g, hh);
    }
}
}

__global__ void __launch_bounds__(NTHR, 2) fwd_kernel(Args args) {
    extern __shared__ __attribute__((aligned(16))) unsigned char lds_raw[];
    Frame F;
    F.lds = (LAS unsigned char*)lds_raw;
    F.tid = threadIdx.x; F.lane = F.tid & 63; F.wave = __builtin_amdgcn_readfirstlane(F.tid >> 6); F.G = gridDim.x; F.bx = blockIdx.x;
    F.ap = &args;
    F.out = args.out; F.ws = args.ws;
    volatile LAS unsigned* MISC = (volatile LAS unsigned*)(F.lds + MISC_OFF);
    if (F.tid < 64) MISC[F.tid] = 0u;
    __syncthreads();
    unsigned* ctl = (unsigned*)(F.ws + WS_CTL);
    const int lo = args.ph_lo, hi = args.ph_hi;
    XcdBarrier bar; bar.bar = ctl + CW_BAR; bar.x = 0; bar.st = nullptr;
    if (hi - lo > 1) bar = xcd_barrier_post(ctl + CW_BAR, MISC + 8);
#ifndef ONLY_PHASE
#define ONLY_PHASE -1
#endif
#define IN(k) ((ONLY_PHASE < 0 || ONLY_PHASE == (k)) && lo <= (k) && (k) < hi)
#define SEAM(k) do { if (IN(k) && IN((k) + 1)) xcd_barrier(bar); } while (0)
#ifndef DUP_MASK
#define DUP_MASK 0
#endif
#define REP(k) for (int _rep = 0; _rep < 1 + ((DUP_MASK >> (k)) & 1); ++_rep, __syncthreads())
    bf16* H = (bf16*)(F.ws + WS_H); bf16* U = (bf16*)(F.ws + WS_U); bf16* Z = (bf16*)(F.ws + WS_Z); bf16* T = (bf16*)(F.ws + WS_T); float* V = (float*)(F.ws + WS_V);
    const float* mod = (const float*)(F.ws + WS_MOD);

    if (IN(0)) REP(0) { p0_prologue(F); } SEAM(0);
    if (IN(1)) REP(1) { p1_ln_mod(F); } SEAM(1);
    if (IN(2)) REP(2) { SchedGrid S{H, (const bf16*)(F.ws + WS_WFI), 64, 32, DM, DM, F.G, F.bx}; EpiUZ E{U, Z};
                 pg8::gemm_phase<EpiUZ, SchedGrid, GP_ALIGN, GP_SP2>(F.lds, DM, DM, DM, S, E); } SEAM(2);
    if (IN(3)) REP(3) { SchedCDFT S{(const bf16*)(F.ws + WS_D256), U, F.G, F.bx}; EpiCDFT E{T};
                 pg8::gemm_phase<EpiCDFT, SchedCDFT, GP_ALIGN, GP_SP2>(F.lds, 256, 256, FW, S, E); } SEAM(3);
    if (IN(4)) REP(4) { { SchedLDFT S{(const bf16*)(F.ws + WS_A4S), T, 1, F.G, F.bx}; EpiLDFT E{Z, U, 1.0f / 512.0f};
                   pg8::gemm_phase<EpiLDFT, SchedLDFT, GP_ALIGN, GP_SP2>(F.lds, 2 * LSA, 2 * LSA, 2 * LSA, S, E); }
                 { SchedLDFT S{(const bf16*)(F.ws + WS_A4P), T, 0, F.G, F.bx}; EpiLDFT E{Z, U, 1.0f / 256.0f};
                   pg8::gemm_phase<EpiLDFT, SchedLDFT, GP_ALIGN, GP_SP2>(F.lds, 2 * LPR, 2 * LPR, 2 * LPR, S, E); } } SEAM(4);
    if (IN(5)) REP(5) { SchedGrid S{U, (const bf16*)(F.ws + WS_WFO), 64, 8, FW, FW, F.G, F.bx}; EpiRes0 E{F.ap->in[0], F.ap->in[1], (const float*)(F.ws + WS_POS), mod, V};
                 pg8::gemm_phase<EpiRes0, SchedGrid, GP_ALIGN, GP_SP2>(F.lds, FW, FW, FW, S, E); } SEAM(5);
    if (IN(6)) REP(6) { p6_ln_ln_mod(F); } SEAM(6);
    if (IN(7)) REP(7) { SchedGrid S{H, (const bf16*)(F.ws + WS_WSI), 64, 40, DM, DM, F.G, F.bx}; EpiProj E{Z, (bf16*)(F.ws + WS_XBC), (float*)(F.ws + WS_DT)};
                 pg8::gemm_phase<EpiProj, SchedGrid, GP_ALIGN, GP_SP2>(F.lds, DM, DM, DM, S, E); } SEAM(7);
    if (IN(8)) REP(8) {
        const bool dtw = (F.G == 256) && F.bx < 64;
        if (F.G != 256 || dtw) { SchedOne S{H, (const bf16*)(F.ws + WS_WSI), 0, 40, DM, DM}; EpiProj E{Z, (bf16*)(F.ws + WS_XBC), (float*)(F.ws + WS_DT)};
            if (F.G == 256) { S.pm = F.bx; pg8::gemm_phase<EpiProj, SchedOne, GP_ALIGN, GP_SP2>(F.lds, DM, DM, DM, S, E); }
            else for (int pm = F.bx; pm < 64; pm += F.G) { S.pm = pm; pg8::gemm_phase<EpiProj, SchedOne, GP_ALIGN, GP_SP2>(F.lds, DM, DM, DM, S, E); } }
        p8_conv(F); } SEAM(8);
    if (IN(9)) REP(9) { scan::phase(F); } SEAM(9);
    if (IN(10)) REP(10) { SchedGrid S{(const bf16*)(F.ws + WS_Y), (const bf16*)(F.ws + WS_WSO), 64, 8, FW, FW, F.G, F.bx}; EpiRes1 E{mod + 9 * 6144, (const float*)(F.ws + WS_SSQ), V};
                  pg8::gemm_phase<EpiRes1, SchedGrid, GP_ALIGN, GP_SP2>(F.lds, FW, FW, FW, S, E); } SEAM(10);
    if (IN(11)) REP(11) { p11_final_ln(F); }
#undef IN
#undef SEAM
}


extern "C" void kernel_launch(void* const* d_in, const int* in_sizes, int n_in, void* d_out, int out_size, void* d_ws, size_t ws_size, hipStream_t stream) {
    static int grid = 0;
    if (grid == 0) {
        int dev = 0, cus = 0;
        if (n_in != 19 || ws_size < WS_END || out_size != NTOK * DM + NBP * 2 * 64 * 64 * 128) { fprintf(stderr, "kernel_launch: unexpected shapes (n_in %d, ws %zu, out %d)\n", n_in, ws_size, out_size); grid = -1; return; }
        if (hipGetDevice(&dev) != hipSuccess || hipDeviceGetAttribute(&cus, hipDeviceAttributeMultiprocessorCount, dev) != hipSuccess) { grid = -1; return; }
        if (hipFuncSetAttribute((const void*)fwd_kernel, hipFuncAttributeMaxDynamicSharedMemorySize, LDS_BYTES) != hipSuccess) { fprintf(stderr, "kernel_launch: hipFuncSetAttribute failed\n"); grid = -1; return; }
        grid = cus;
    }
    if (grid < 0) return;
    (void)hipMemsetAsync((char*)d_ws + WS_CTL, 0, CTL_ZERO_BYTES, stream);
    Args a{};
    for (int i = 0; i < 19; ++i) a.in[i] = (const float*)d_in[i];
    a.out = (float*)d_out; a.ws = (unsigned char*)d_ws;
#if MK_PER_PHASE || MK_CHECK
    for (int p = 0; p < NPHASE; ++p) { a.ph_lo = p; a.ph_hi = p + 1; hipLaunchKernelGGL(fwd_kernel, dim3(grid), dim3(NTHR), LDS_BYTES, stream, a);
#if MK_CHECK
        check_after_phase(p, a, stream);
#endif
    }
#if MK_CHECK
    check_report(a, stream);
#endif
#else
    a.ph_lo = 0; a.ph_hi = NPHASE;
    hipLaunchKernelGGL(fwd_kernel, dim3(grid), dim3(NTHR), LDS_BYTES, stream, a);
#endif
}
```

```cpp
#include <hip/hip_runtime.h>
#include <cstdio>
#include <cstdint>

#ifndef MK_PER_PHASE
#define MK_PER_PHASE 0
#endif
#ifndef MK_CHECK
#define MK_CHECK 0
#endif

#define GAS __attribute__((address_space(1)))
#define LAS __attribute__((address_space(3)))
typedef unsigned short bf16;
typedef unsigned v4u __attribute__((ext_vector_type(4)));
typedef unsigned v2u __attribute__((ext_vector_type(2)));
typedef float f32x4 __attribute__((ext_vector_type(4)));
typedef short bf16x8 __attribute__((ext_vector_type(8)));
#define LDS_WAIT() asm volatile("s_waitcnt lgkmcnt(0)" ::: "memory")
#define VM_WAIT() asm volatile("s_waitcnt vmcnt(0)" ::: "memory")

constexpr int NWAVES = 8, NTHR = 512;
constexpr int DM = 2048, NTOK = 16384, NPR = 8192, LPR = 256, LSA = 1024, NBP = 32, NBS = 8;
constexpr int FW = 4096;
constexpr int SSD_IN = 10368, SSD_IN_PAD = 10496, CONVD = 6144;
constexpr float LN_EPS = 1e-5f;
constexpr float DN_ALPHA = 1.41421356237f;
constexpr int NPHASE = 12;

constexpr size_t MiB = 1u << 20;
constexpr size_t WS_CTL = 0, WS_MOD = 1 * MiB, WS_SSQ = 1 * MiB + 512 * 1024, CTL_ZERO_BYTES = 2 * MiB;
constexpr size_t WS_D256 = 2 * MiB, WS_A4P = 3 * MiB, WS_A4S = 4 * MiB, WS_POS = 8 * MiB;
constexpr size_t WS_WFI = 16 * MiB, WS_WFO = 48 * MiB, WS_WSI = 64 * MiB, WS_WSO = 106 * MiB;
constexpr size_t WS_DT = 122 * MiB;
constexpr size_t WS_H = 132 * MiB, WS_U = 196 * MiB, WS_Z = 324 * MiB, WS_T = 452 * MiB, WS_V = 708 * MiB, WS_Y = 836 * MiB, WS_END = 996 * MiB;
constexpr size_t WS_XBC = WS_T, WS_BN = 644 * MiB, WS_CN = 676 * MiB, WS_XT = WS_U, WS_BT = 964 * MiB;
constexpr int CW_BAR = 4096;

constexpr int LDS_BYTES = 163840;
constexpr int MISC_OFF = LDS_BYTES - 256;

__device__ __forceinline__ unsigned f2bf(float f) { unsigned u = __builtin_bit_cast(unsigned, f); return (u + 0x7fffu + ((u >> 16) & 1u)) >> 16; }
typedef __bf16 bf2_t __attribute__((ext_vector_type(2)));
typedef float f32x2_t __attribute__((ext_vector_type(2)));
__device__ __forceinline__ unsigned pk2(float lo, float hi) { const f32x2_t v = {lo, hi}; return __builtin_bit_cast(unsigned, __builtin_convertvector(v, bf2_t)); }
__device__ __forceinline__ float bf_lo(unsigned w) { return __builtin_bit_cast(float, w << 16); }
__device__ __forceinline__ float bf_hi(unsigned w) { return __builtin_bit_cast(float, w & 0xffff0000u); }
__device__ __forceinline__ float bf2f(bf16 b) { return __builtin_bit_cast(float, ((unsigned)b) << 16); }
__device__ __forceinline__ float silu_f(float x) { return x / (1.f + __expf(-x)); }
__device__ __forceinline__ float wave_sum(float v) {
#pragma unroll
    for (int o = 1; o < 64; o <<= 1) v += __shfl_xor(v, o);
    return v;
}

#define XB_TMO      128
#define XB_XCNT(j)  (256  + 64 * (j))
#define XB_XSUB(j)  (1280 + 64 * (j))
#define XB_XGEN(j)  (2304 + 64 * (j))
#define XB_TOP      3328
#define XB_TOPGEN   3392
#define XCD_BAR_WORDS 3456
#define XB_SPIN_CAP (1u << 20)
__device__ __forceinline__ unsigned xb_ld(unsigned* p)              { return __hip_atomic_load(p, __ATOMIC_RELAXED, __HIP_MEMORY_SCOPE_AGENT); }
__device__ __forceinline__ unsigned xb_add(unsigned* p, unsigned v) { return __hip_atomic_fetch_add(p, v, __ATOMIC_RELAXED, __HIP_MEMORY_SCOPE_AGENT); }
__device__ __forceinline__ unsigned xb_xcc_id() { return (unsigned)__builtin_amdgcn_s_getreg((3 << 11) | 20) & 0xFu; }
#define XB_SPIN(cond, bar) do { unsigned _sp = 0; while (cond) { __builtin_amdgcn_s_sleep(1); \
    if ((++_sp & 255u) == 0u) { if (xb_ld(&(bar)[XB_TMO])) break; if (_sp > XB_SPIN_CAP) { atomicAdd(&(bar)[XB_TMO], 1u); break; } } } } while (0)
struct XcdBarrier { unsigned* bar; unsigned x; volatile LAS unsigned* st; };
__device__ __forceinline__ XcdBarrier xcd_barrier_post(unsigned* bar, volatile LAS unsigned* st) {
    XcdBarrier b; b.bar = bar; b.x = xb_xcc_id(); b.st = st;
    if (threadIdx.x == 0) (void)xb_add(&bar[XB_XCNT(b.x)], 1u);
    return b;
}
__device__ __forceinline__ void xcd_barrier_complete(unsigned* bar, unsigned x, unsigned& nloc, unsigned& nx) {
    const unsigned G = gridDim.x * gridDim.y * gridDim.z;
    unsigned sum, cnt, mine, sp = 0u;
    for (;;) {
        sum = 0u; cnt = 0u; mine = 0u;
#pragma unroll
        for (unsigned j = 0; j < 16; ++j) { const unsigned c = xb_ld(&bar[XB_XCNT(j)]); sum += c; cnt += (c > 0u) ? 1u : 0u; mine = (j == x) ? c : mine; }
        if (sum == G) break;
        __builtin_amdgcn_s_sleep(1);
        if ((++sp & 255u) == 0u) { if (xb_ld(&bar[XB_TMO])) break; if (sp > XB_SPIN_CAP) { atomicAdd(&bar[XB_TMO], 1u); break; } }
    }
    nloc = mine > 0u ? mine : 1u; nx = cnt > 0u ? cnt : 1u;
}
__device__ __forceinline__ void xcd_barrier(const XcdBarrier& b) {
    asm volatile("s_waitcnt vmcnt(0)" ::: "memory");
    __syncthreads();
    if (threadIdx.x == 0) {
        unsigned* bar = b.bar;
        __builtin_amdgcn_s_waitcnt(0);
        unsigned nloc = b.st[0], nx = b.st[1];
        if (nloc == 0u) { xcd_barrier_complete(bar, b.x, nloc, nx); b.st[0] = nloc; b.st[1] = nx; }
        const unsigned old = xb_add(&bar[XB_XSUB(b.x)], 1u);
        const unsigned gen = old / nloc;
        if (old + 1u == (gen + 1u) * nloc) {
            __builtin_amdgcn_fence(__ATOMIC_RELEASE, "agent");
            asm volatile("s_waitcnt vmcnt(0)" ::: "memory");
            const unsigned og = xb_add(&bar[XB_TOP], 1u);
            const unsigned tg = og / nx;
            if (og + 1u == (tg + 1u) * nx) xb_add(&bar[XB_TOPGEN], 1u);
            else XB_SPIN(xb_ld(&bar[XB_TOPGEN]) == tg, bar);
            __builtin_amdgcn_fence(__ATOMIC_ACQUIRE, "agent");
            xb_add(&bar[XB_XGEN(b.x)], 1u);
            asm volatile("s_waitcnt vmcnt(0)" ::: "memory");
        } else {
            XB_SPIN(xb_ld(&bar[XB_XGEN(b.x)]) == gen, bar);
            __builtin_amdgcn_fence(__ATOMIC_ACQUIRE, "agent");
            asm volatile("s_waitcnt vmcnt(0)" ::: "memory");
        }
    }
    __syncthreads();
}

struct Args { const float* in[19]; float* out; unsigned char* ws; int ph_lo, ph_hi; };
#ifndef PROF_ID
#define PROF_ID 0
#endif
#ifndef PROF_K
#define PROF_K 1
#endif
#define PB(id) do { if (PROF_ID == (id)) { F.pt0 = __builtin_amdgcn_s_memrealtime(); } } while (0)
#define PE(id) do { if (PROF_ID == (id)) { F.pacc += __builtin_amdgcn_s_memrealtime() - F.pt0; } } while (0)
struct Frame {
    unsigned long long pacc, pt0;
    LAS unsigned char* lds;
    int tid, lane, wave, G, bx;
    const Args* ap;
    float* out; unsigned char* ws;
};
__device__ __forceinline__ int row0_of(int bb) { return bb < NBP ? bb * LPR : NPR + (bb - NBP) * LSA; }
__device__ __forceinline__ size_t tb_of(int bb) { return bb < NBP ? (size_t)bb * FW * 2 * LPR : (size_t)NBP * FW * 2 * LPR + (size_t)(bb - NBP) * FW * 2 * LSA; }
__device__ __forceinline__ int cond_of_row(int r) { return r < NPR ? 0 : 1 + (r - NPR) / LSA; }

namespace pg8 {
constexpr int BM = 256, BK = 64, HALF = 128, HTB = HALF * BK * 2, NXCD = 8, WGM = 8;
__host__ __device__ __forceinline__ int lds_byte(int r, int c) { const int st = (r >> 4) * 2 + (c >> 5), rr = r & 15, cc = c & 31, ob = rr * 64 + cc * 2; return st * 1024 + (ob ^ (((ob >> 9) & 1) << 5)); }
__host__ __device__ __forceinline__ void stage_rc(int b, int& R, int& C) { const int st = b / 1024, sb = b % 1024, swz = sb ^ (((sb >> 9) & 1) << 5); R = (st >> 1) * 16 + swz / 64; C = (st & 1) * 32 + (swz % 64) / 2; }
__host__ __device__ __forceinline__ int perm32(int rho) { const int n = rho >> 4, i = rho & 15; return 8 * (i >> 2) + 4 * n + (i & 3); }
struct Unit { const char* a; const char* b; int x0, x1; };
typedef f32x4 Acc[2][2][4][2];

__device__ __forceinline__ bool static_tile(int i, int G, int c, int nM, int nN, int& pm, int& pn) {
    const int nwg = nM * nN; const long L = (long)i * G + c; if (L >= nwg) return false;
    int wgid = (int)L; { const int q = nwg / NXCD, r = nwg % NXCD, xcd = wgid % NXCD, off = wgid / NXCD; wgid = (xcd < r ? xcd * (q + 1) : r * (q + 1) + (xcd - r) * q) + off; }
    const int nig = WGM * nN, gid = wgid / nig, fm = gid * WGM, gsz = (nM - fm) < WGM ? (nM - fm) : WGM;
    pm = fm + ((wgid % nig) % gsz); pn = (wgid % nig) / gsz; return true;
}

template <class Epi, class Sched, bool ALIGN_EPI, bool SP2>
__device__ __forceinline__ void gemm_phase(LAS unsigned char* lds, const int K, const int lda, const int ldb, const Sched& S, const Epi& E) {
    const int tid = threadIdx.x, wid = __builtin_amdgcn_readfirstlane(tid >> 6), lane = tid & 63, wr = wid >> 2, wc = wid & 3, fr = lane & 15, fq = lane >> 4;
    const int nt = K / BK;
    unsigned voffA[2], voffB[2];
#pragma unroll
    for (int i = 0; i < 2; ++i) { int R, C; stage_rc(tid * 16 + i * 8192, R, C); const int Rb = Epi::PERM ? ((R & ~31) + perm32(R & 31)) : R;
        voffA[i] = (unsigned)(R * lda + C) * 2u; voffB[i] = (unsigned)(Rb * ldb + C) * 2u; }
    const size_t kstep = (size_t)(BK * 2);
    const size_t hstepA = (size_t)HALF * lda * 2, hstepB = (size_t)HALF * ldb * 2;
    const unsigned ldsw = (unsigned)wid * 1024u;
    const int aoff = lds_byte(wr * 64 + fr, fq * 8), boff = lds_byte(wc * 32 + fr, fq * 8);
#define PG8_SA(b, h) (((b) * 2 + (h)) * HTB)
#define PG8_SB(b, h) ((4 + (b) * 2 + (h)) * HTB)
#define PG8_STAGE(bufoff, gbase, voff) do { _Pragma("unroll") for (int _i = 0; _i < 2; ++_i) \
        __builtin_amdgcn_global_load_lds((const unsigned*)((const char*)(gbase) + (voff)[_i]), (LAS unsigned*)(lds + (bufoff) + ldsw + _i * 8192), 16, 0, 0); } while (0)
#define PG8_LDA(dst, b, h) do { _Pragma("unroll") for (int m = 0; m < 4; ++m) _Pragma("unroll") for (int k = 0; k < 2; ++k) dst[m][k] = *(const LAS bf16x8*)(lds + PG8_SA(b, h) + aoff + m * 2048 + k * 1024); } while (0)
#define PG8_LDB(dst, b, h) do { _Pragma("unroll") for (int n = 0; n < 2; ++n) _Pragma("unroll") for (int k = 0; k < 2; ++k) dst[n][k] = *(const LAS bf16x8*)(lds + PG8_SB(b, h) + boff + n * 2048 + k * 1024); } while (0)
#define PG8_MMA(ai, bj, At, Bt) do { __builtin_amdgcn_s_setprio(1); _Pragma("unroll") for (int m = 0; m < 4; ++m) _Pragma("unroll") for (int n = 0; n < 2; ++n) _Pragma("unroll") for (int k = 0; k < 2; ++k) \
        acc[ai][bj][m][n] = __builtin_amdgcn_mfma_f32_16x16x32_bf16(Bt[n][k], At[m][k], acc[ai][bj][m][n], 0, 0, 0); __builtin_amdgcn_s_setprio(0); } while (0)
#define PG8_WAIT_V(n) asm volatile("s_waitcnt vmcnt(" #n ")" ::: "memory")
#define PG8_WAIT_L(n) asm volatile("s_waitcnt lgkmcnt(" #n ")" ::: "memory")
#define PG8_BAR __builtin_amdgcn_s_barrier()
#define PG8_SCHED __builtin_amdgcn_sched_barrier(0)
    Unit cur, nxt; int ui = 0;
    if (!S.next(0, cur)) return;
    Acc acc;
#pragma unroll
    for (int a = 0; a < 2; ++a)
#pragma unroll
        for (int b = 0; b < 2; ++b)
#pragma unroll
            for (int m = 0; m < 4; ++m)
#pragma unroll
                for (int n = 0; n < 2; ++n) acc[a][b][m][n] = (f32x4){0.f, 0.f, 0.f, 0.f};
    bf16x8 At[4][2], B0[2][2], B1[2][2];
    const char* cA = cur.a; const char* cB = cur.b;
    if constexpr (SP2) {
        PG8_STAGE(PG8_SB(0, 0), cB, voffB); PG8_STAGE(PG8_SB(0, 1), cB + hstepB, voffB); PG8_STAGE(PG8_SA(0, 0), cA, voffA); PG8_STAGE(PG8_SA(0, 1), cA + hstepA, voffA);
        if (wr == 1) PG8_BAR;
        PG8_WAIT_V(2); PG8_BAR;
        PG8_STAGE(PG8_SB(1, 0), cB + kstep, voffB); PG8_STAGE(PG8_SA(1, 0), cA + kstep, voffA); PG8_STAGE(PG8_SB(1, 1), cB + hstepB + kstep, voffB);
        PG8_WAIT_V(6); PG8_BAR;
    } else {
        PG8_STAGE(PG8_SB(0, 0), cB, voffB); PG8_STAGE(PG8_SA(0, 0), cA, voffA); PG8_STAGE(PG8_SB(0, 1), cB + hstepB, voffB); PG8_STAGE(PG8_SA(0, 1), cA + hstepA, voffA);
        if (wr == 1) PG8_BAR;
        PG8_WAIT_V(4); PG8_BAR;
        PG8_STAGE(PG8_SB(1, 0), cB + kstep, voffB); PG8_STAGE(PG8_SA(1, 0), cA + kstep, voffA); PG8_STAGE(PG8_SB(1, 1), cB + hstepB + kstep, voffB);
        PG8_WAIT_V(6); PG8_BAR;
    }
    for (;;) {
        const bool has_next = S.next(ui + 1, nxt);
        const char* nA = has_next ? nxt.a : cA; const char* nB = has_next ? nxt.b : cB;
#pragma unroll 1
        for (int t = 0; t < nt; t += 2) {
            const bool last = (t == nt - 2);
            const char* a1 = cA + (size_t)(t + 1) * kstep;
            const char* a2 = last ? nA : cA + (size_t)(t + 2) * kstep; const char* b2 = last ? nB : cB + (size_t)(t + 2) * kstep;
            const char* a3 = a2 + kstep; const char* b3 = b2 + kstep;
            if constexpr (SP2) {
            PG8_LDB(B0, 0, 0); PG8_LDB(B1, 0, 1); PG8_SCHED; PG8_LDA(At, 0, 0); PG8_STAGE(PG8_SA(1, 1), a1 + hstepA, voffA);
            PG8_WAIT_V(8); PG8_WAIT_L(0); PG8_BAR; PG8_MMA(0, 0, At, B0); PG8_MMA(0, 1, At, B1); PG8_BAR; PG8_SCHED;
            PG8_LDA(At, 0, 1); PG8_STAGE(PG8_SB(0, 0), b2, voffB); PG8_STAGE(PG8_SB(0, 1), b2 + hstepB, voffB); PG8_STAGE(PG8_SA(0, 0), a2, voffA);
            PG8_WAIT_V(8); PG8_WAIT_L(0); PG8_BAR; PG8_MMA(1, 0, At, B0); PG8_MMA(1, 1, At, B1); PG8_BAR; PG8_SCHED;
            PG8_LDB(B0, 1, 0); PG8_LDB(B1, 1, 1); PG8_SCHED; PG8_LDA(At, 1, 0); PG8_STAGE(PG8_SA(0, 1), a2 + hstepA, voffA);
            PG8_WAIT_V(8); PG8_WAIT_L(0); PG8_BAR; PG8_MMA(0, 0, At, B0); PG8_MMA(0, 1, At, B1); PG8_BAR; PG8_SCHED;
            PG8_LDA(At, 1, 1); PG8_STAGE(PG8_SB(1, 0), b3, voffB); PG8_STAGE(PG8_SB(1, 1), b3 + hstepB, voffB); PG8_STAGE(PG8_SA(1, 0), a3, voffA);
            PG8_WAIT_V(8); PG8_WAIT_L(0); PG8_BAR; PG8_MMA(1, 0, At, B0); PG8_MMA(1, 1, At, B1); PG8_BAR; PG8_SCHED;
            } else {
            PG8_LDB(B0, 0, 0); PG8_SCHED; PG8_LDA(At, 0, 0); PG8_STAGE(PG8_SA(1, 1), a1 + hstepA, voffA);
            PG8_WAIT_L(8); PG8_BAR; PG8_WAIT_L(0); PG8_MMA(0, 0, At, B0); PG8_BAR; PG8_SCHED;
            PG8_LDB(B1, 0, 1); PG8_STAGE(PG8_SB(0, 0), b2, voffB);
            PG8_BAR; PG8_WAIT_L(0); PG8_MMA(0, 1, At, B1); PG8_BAR;
            PG8_LDA(At, 0, 1); PG8_STAGE(PG8_SA(0, 0), a2, voffA);
            PG8_BAR; PG8_WAIT_L(0); PG8_MMA(1, 0, At, B0); PG8_BAR; PG8_SCHED;
            PG8_STAGE(PG8_SB(0, 1), b2 + hstepB, voffB);
            PG8_WAIT_V(6); PG8_BAR; PG8_MMA(1, 1, At, B1); PG8_BAR;
            PG8_LDB(B0, 1, 0); PG8_SCHED; PG8_LDA(At, 1, 0); PG8_STAGE(PG8_SA(0, 1), a2 + hstepA, voffA);
            PG8_WAIT_L(8); PG8_BAR; PG8_WAIT_L(0); PG8_MMA(0, 0, At, B0); PG8_BAR; PG8_SCHED;
            PG8_LDB(B1, 1, 1); PG8_STAGE(PG8_SB(1, 0), b3, voffB);
            PG8_BAR; PG8_WAIT_L(0); PG8_MMA(0, 1, At, B1); PG8_BAR;
            PG8_LDA(At, 1, 1); PG8_STAGE(PG8_SA(1, 0), a3, voffA);
            PG8_BAR; PG8_WAIT_L(0); PG8_MMA(1, 0, At, B0); PG8_BAR; PG8_SCHED;
            PG8_STAGE(PG8_SB(1, 1), b3 + hstepB, voffB);
            PG8_WAIT_V(6); PG8_BAR; PG8_MMA(1, 1, At, B1); PG8_BAR;
            }
        }
        if constexpr (ALIGN_EPI) { if (wr == 0) PG8_BAR; }
        E(acc, cur, wr, wc, fr, fq);
        if (!has_next) break;
#pragma unroll
        for (int a = 0; a < 2; ++a)
#pragma unroll
            for (int b = 0; b < 2; ++b)
#pragma unroll
                for (int m = 0; m < 4; ++m)
#pragma unroll
                    for (int n = 0; n < 2; ++n) acc[a][b][m][n] = (f32x4){0.f, 0.f, 0.f, 0.f};
        cur = nxt; cA = nA; cB = nB; ++ui;
        if constexpr (ALIGN_EPI) { if (wr == 1) PG8_BAR; }
    }
    PG8_WAIT_V(0);
    if constexpr (!ALIGN_EPI) { if (wr == 0) PG8_BAR; }
    PG8_BAR;
#undef PG8_SA
#undef PG8_SB
#undef PG8_STAGE
#undef PG8_LDA
#undef PG8_LDB
#undef PG8_MMA
#undef PG8_WAIT_V
#undef PG8_WAIT_L
#undef PG8_BAR
#undef PG8_SCHED
}
}
using pg8::Unit; using pg8::Acc;
constexpr bool GP_ALIGN = true, GP_SP2 = true;

struct SchedGrid {
    const bf16* A; const bf16* B; int nM, nN, lda, ldb, G, c;
    __device__ __forceinline__ bool next(int i, Unit& u) const { int pm, pn; if (!pg8::static_tile(i, G, c, nM, nN, pm, pn)) return false;
        u.a = (const char*)(A + (size_t)pm * 256 * lda); u.b = (const char*)(B + (size_t)pn * 256 * ldb); u.x0 = pm; u.x1 = pn; return true; }
};
struct SchedOne {
    const bf16* A; const bf16* B; int pm, pn, lda, ldb;
    __device__ __forceinline__ bool next(int i, Unit& u) const { if (i != 0 || pm < 0) return false;
        u.a = (const char*)(A + (size_t)pm * 256 * lda); u.b = (const char*)(B + (size_t)pn * 256 * ldb); u.x0 = pm; u.x1 = pn; return true; }
};
struct EpiUZ { static constexpr bool PERM = true; bf16* U; bf16* Z;
    __device__ __forceinline__ void operator()(const Acc& acc, const Unit& u, int wr, int wc, int fr, int fq) const {
        const int pm = u.x0, pn = u.x1; const bool isz = pn >= 16; bf16* base = isz ? Z : U; const int colt = (isz ? pn - 16 : pn) * 256 + wc * 32 + 8 * fq;
#pragma unroll
        for (int ai = 0; ai < 2; ++ai)
#pragma unroll
            for (int m = 0; m < 4; ++m) { const int r = pm * 256 + ai * 128 + wr * 64 + m * 16 + fr; bf16* rowp = base + (size_t)r * FW + colt;
#pragma unroll
                for (int bj = 0; bj < 2; ++bj) { f32x4 v0 = acc[ai][bj][m][0], v1 = acc[ai][bj][m][1];
                    if (isz) {
#pragma unroll
                        for (int j = 0; j < 4; ++j) { v0[j] = silu_f(v0[j]); v1[j] = silu_f(v1[j]); } }
                    v4u w; w.x = pk2(v0[0], v0[1]); w.y = pk2(v0[2], v0[3]); w.z = pk2(v1[0], v1[1]); w.w = pk2(v1[2], v1[3]);
                    *(v4u*)(rowp + bj * 128) = w; } }
    } };
struct SchedCDFT { const bf16* D; const bf16* U; int G, c;
    __device__ __forceinline__ bool next(int i, Unit& u) const { const long e = (long)i * G + c; if (e >= 2048) return false;
        const int cs = (int)e & 1, q = (int)e >> 1; int bb, g, tn;
        if (q < 512) { bb = q >> 4; g = q & 15; tn = 0; } else { const int q2 = q - 512; bb = NBP + (q2 >> 6); g = (q2 >> 2) & 15; tn = q2 & 3; }
        u.a = (const char*)(D + (size_t)cs * 256 * 256); u.b = (const char*)(U + ((size_t)(row0_of(bb) + tn * 256) * FW + g * 256));
        u.x0 = bb | (g << 8) | (cs << 16) | (tn << 20); u.x1 = 0; return true; } };
struct EpiCDFT { static constexpr bool PERM = true; bf16* T;
    __device__ __forceinline__ void operator()(const Acc& acc, const Unit& u, int wr, int wc, int fr, int fq) const {
        const int bb = u.x0 & 255, g = (u.x0 >> 8) & 255, cs = (u.x0 >> 16) & 15, tn = u.x0 >> 20; const int L = bb < NBP ? LPR : LSA;
        bf16* base = T + tb_of(bb) + (size_t)(g * 256) * (2 * L) + cs * L + tn * 256;
        const unsigned L2 = 2u * (unsigned)L; const unsigned off0 = (unsigned)(wr * 64 + fr) * L2 + (unsigned)(wc * 32 + 8 * fq);
#pragma unroll
        for (int ai = 0; ai < 2; ++ai)
#pragma unroll
            for (int m = 0; m < 4; ++m) { const unsigned off = off0 + (unsigned)(ai * 128 + m * 16) * L2;
#pragma unroll
                for (int bj = 0; bj < 2; ++bj) { const f32x4 v0 = acc[ai][bj][m][0], v1 = acc[ai][bj][m][1];
                    v4u w; w.x = pk2(v0[0], v0[1]); w.y = pk2(v0[2], v0[3]); w.z = pk2(v1[0], v1[1]); w.w = pk2(v1[2], v1[3]);
                    *(v4u*)(base + off + bj * 128) = w; }
                asm volatile("" ::: "memory"); }
    } };
struct SchedLDFT { const bf16* A4; const bf16* T; int sample, G, c;
    __device__ __forceinline__ bool next(int i, Unit& u) const { const long e = (long)i * G + c; if (e >= 512) return false; int bb, pm, pn;
        if (sample) { bb = NBP + ((int)e >> 6); pm = ((int)e >> 4) & 3; pn = (int)e & 15; } else { bb = (int)e >> 4; pm = 0; pn = (int)e & 15; }
        const int L2 = sample ? 2 * LSA : 2 * LPR;
        u.a = (const char*)(A4 + (size_t)pm * 256 * L2); u.b = (const char*)(T + tb_of(bb) + (size_t)pn * 256 * L2);
        u.x0 = row0_of(bb) + pm * 256; u.x1 = pn; return true; } };
struct EpiLDFT { static constexpr bool PERM = true; const bf16* Z; bf16* YG; float sc;
    __device__ __forceinline__ void operator()(const Acc& acc, const Unit& u, int wr, int wc, int fr, int fq) const {
        const int rb = u.x0, pn = u.x1; const int colt = pn * 256 + wc * 32 + 8 * fq;
#pragma unroll
        for (int ai = 0; ai < 2; ++ai)
#pragma unroll
            for (int m = 0; m < 4; ++m) { const size_t off = (size_t)(rb + ai * 128 + wr * 64 + m * 16 + fr) * FW + colt;
#pragma unroll
                for (int bj = 0; bj < 2; ++bj) { const f32x4 v0 = acc[ai][bj][m][0] * sc, v1 = acc[ai][bj][m][1] * sc;
                    const v4u z = *(const v4u*)(Z + off + bj * 128);
                    v4u w; w.x = pk2(v0[0] * bf_lo(z.x), v0[1] * bf_hi(z.x)); w.y = pk2(v0[2] * bf_lo(z.y), v0[3] * bf_hi(z.y));
                    w.z = pk2(v1[0] * bf_lo(z.z), v1[1] * bf_hi(z.z)); w.w = pk2(v1[2] * bf_lo(z.w), v1[3] * bf_hi(z.w));
                    *(v4u*)(YG + off + bj * 128) = w; } }
    } };
struct EpiRes0 { static constexpr bool PERM = false; const float* xp; const float* xs; const float* pos; const float* mod0; float* V;
    __device__ __forceinline__ void operator()(const Acc& acc, const Unit& u, int wr, int wc, int fr, int fq) const {
        const int pm = u.x0, pn = u.x1; const int rt = pm * 256; const bool smp = rt >= NPR;
        const float* gate = mod0 + (size_t)cond_of_row(rt) * 6144 + 4096;
        const int col0 = pn * 256 + wc * 32 + 4 * fq;
        f32x4 gv[2][2];
#pragma unroll
        for (int bj = 0; bj < 2; ++bj)
#pragma unroll
            for (int n = 0; n < 2; ++n) gv[bj][n] = *(const f32x4*)(gate + col0 + bj * 128 + n * 16);
#pragma unroll
        for (int ai = 0; ai < 2; ++ai)
#pragma unroll
            for (int mp = 0; mp < 2; ++mp) { f32x4 x0[2][2][2], pv[2][2][2];
#pragma unroll
                for (int mm = 0; mm < 2; ++mm) { const int r = rt + ai * 128 + wr * 64 + (2 * mp + mm) * 16 + fr;
                    const float* xr = smp ? xs + (size_t)(r - NPR) * DM : xp + (size_t)r * DM; const float* pr = pos + (size_t)((r - NPR) & (LSA - 1)) * DM;
#pragma unroll
                    for (int bj = 0; bj < 2; ++bj)
#pragma unroll
                        for (int n = 0; n < 2; ++n) { const int cc = col0 + bj * 128 + n * 16; x0[mm][bj][n] = *(const f32x4*)(xr + cc); pv[mm][bj][n] = smp ? *(const f32x4*)(pr + cc) : (f32x4){0.f, 0.f, 0.f, 0.f}; } }
#pragma unroll
                for (int mm = 0; mm < 2; ++mm) { const int m = 2 * mp + mm; const int r = rt + ai * 128 + wr * 64 + m * 16 + fr;
#pragma unroll
                    for (int bj = 0; bj < 2; ++bj)
#pragma unroll
                        for (int n = 0; n < 2; ++n) *(f32x4*)(V + (size_t)r * DM + col0 + bj * 128 + n * 16) = (x0[mm][bj][n] + pv[mm][bj][n]) * DN_ALPHA + gv[bj][n] * acc[ai][bj][m][n]; }
                asm volatile("" ::: "memory"); }
    } };
struct EpiProj { static constexpr bool PERM = true; bf16* Z; bf16* XBC; float* DT;
    __device__ __forceinline__ void operator()(const Acc& acc, const Unit& u, int wr, int wc, int fr, int fq) const {
        const int pm = u.x0, pn = u.x1;
#pragma unroll
        for (int ai = 0; ai < 2; ++ai)
#pragma unroll
            for (int m = 0; m < 4; ++m) { const int r = pm * 256 + ai * 128 + wr * 64 + m * 16 + fr;
#pragma unroll
                for (int bj = 0; bj < 2; ++bj) { f32x4 v0 = acc[ai][bj][m][0], v1 = acc[ai][bj][m][1]; const int cl = bj * 128 + wc * 32 + 8 * fq;
                    if (pn < 16) {
#pragma unroll
                        for (int j = 0; j < 4; ++j) { v0[j] = silu_f(v0[j]); v1[j] = silu_f(v1[j]); }
                        v4u w; w.x = pk2(v0[0], v0[1]); w.y = pk2(v0[2], v0[3]); w.z = pk2(v1[0], v1[1]); w.w = pk2(v1[2], v1[3]);
                        *(v4u*)(Z + (size_t)r * FW + pn * 256 + cl) = w;
                    } else if (pn < 40) {
                        v4u w; w.x = pk2(v0[0], v0[1]); w.y = pk2(v0[2], v0[3]); w.z = pk2(v1[0], v1[1]); w.w = pk2(v1[2], v1[3]);
                        *(v4u*)(XBC + (size_t)r * CONVD + (pn - 16) * 256 + cl) = w;
                    } else if (bj == 0) {
                        *(f32x4*)(DT + (size_t)r * 128 + cl) = v0; *(f32x4*)(DT + (size_t)r * 128 + cl + 4) = v1;
                    } } }
    } };
struct EpiRes1 { static constexpr bool PERM = false; const float* mod1; const float* SSQ; float* V;
    __device__ __forceinline__ void operator()(const Acc& acc, const Unit& u, int wr, int wc, int fr, int fq) const {
        const int pm = u.x0, pn = u.x1; const int rt = pm * 256;
        const float* gate = mod1 + (size_t)cond_of_row(rt) * 6144 + 4096;
        const int col0 = pn * 256 + wc * 32 + 4 * fq;
        f32x4 gv[2][2];
#pragma unroll
        for (int bj = 0; bj < 2; ++bj)
#pragma unroll
            for (int n = 0; n < 2; ++n) gv[bj][n] = *(const f32x4*)(gate + col0 + bj * 128 + n * 16);
#pragma unroll
        for (int ai = 0; ai < 2; ++ai)
#pragma unroll
            for (int mp = 0; mp < 2; ++mp) { f32x4 x1[2][2][2]; float ss[2];
#pragma unroll
                for (int mm = 0; mm < 2; ++mm) { const int r = rt + ai * 128 + wr * 64 + (2 * mp + mm) * 16 + fr; ss[mm] = SSQ[r];
#pragma unroll
                    for (int bj = 0; bj < 2; ++bj)
#pragma unroll
                        for (int n = 0; n < 2; ++n) x1[mm][bj][n] = *(const f32x4*)(V + (size_t)r * DM + col0 + bj * 128 + n * 16); }
#pragma unroll
                for (int mm = 0; mm < 2; ++mm) { const int m = 2 * mp + mm; const int r = rt + ai * 128 + wr * 64 + m * 16 + fr; const float rs = 1.0f / sqrtf(ss[mm] * (1.0f / FW) + LN_EPS);
#pragma unroll
                    for (int bj = 0; bj < 2; ++bj)
#pragma unroll
                        for (int n = 0; n < 2; ++n) *(f32x4*)(V + (size_t)r * DM + col0 + bj * 128 + n * 16) = x1[mm][bj][n] * DN_ALPHA + gv[bj][n] * (acc[ai][bj][m][n] * rs); }
                asm volatile("" ::: "memory"); }
    } };

__device__ __forceinline__ void p0_transpose_item(const float* W, int K, int N, bf16* WT, LAS float* scr, int item, int lane) {
    const int nblk = N / 64, kb = item / nblk, nb = item % nblk, k0 = 64 * kb, n0 = 64 * nb;
    const int c4 = (lane & 15) * 4, r4 = lane >> 4;
    f32x4 v[16];
#pragma unroll
    for (int i = 0; i < 16; ++i) v[i] = *(const f32x4*)(W + (size_t)(k0 + r4 + 4 * i) * N + n0 + c4);
#pragma unroll
    for (int i = 0; i < 16; ++i) { LAS float* d = scr + (r4 + 4 * i) * 65 + c4; d[0] = v[i][0]; d[1] = v[i][1]; d[2] = v[i][2]; d[3] = v[i][3]; }
    LDS_WAIT(); asm volatile("" ::: "memory");
    const int c = lane & 7;
#pragma unroll
    for (int j = 0; j < 8; ++j) { const int n = (lane >> 3) + 8 * j; const LAS float* sp = scr + (8 * c) * 65 + n;
        v4u o; o.x = pk2(sp[0 * 65], sp[1 * 65]); o.y = pk2(sp[2 * 65], sp[3 * 65]); o.z = pk2(sp[4 * 65], sp[5 * 65]); o.w = pk2(sp[6 * 65], sp[7 * 65]);
        *(v4u*)(WT + (size_t)(n0 + n) * K + k0 + 8 * c) = o; }
    LDS_WAIT(); asm volatile("" ::: "memory");
}
__device__ __forceinline__ void p0_prologue(Frame& F) {
    const int gw = F.bx * NWAVES + F.wave, NGW = F.G * NWAVES;
    const size_t gt = (size_t)F.bx * NTHR + F.tid, NGT = (size_t)F.G * NTHR;
    LAS float* sc = (LAS float*)F.lds;
    for (int i = F.tid; i < 9 * DM; i += NTHR) { const float v = i < DM ? F.ap->in[4][i] : F.ap->in[3][i - DM]; sc[i] = silu_f(v); }
    __syncthreads();
    float* mod = (float*)(F.ws + WS_MOD);
    LAS float* part = (LAS float*)(F.lds + 9 * DM * 4);
    for (int it = F.bx; it < 2 * 96; it += F.G) {
        const int cb = it % 96, layer = it / 96; const int n = cb * 64 + F.lane; const float* wp = F.ap->in[5] + ((size_t)layer * DM + F.wave * 256) * 6144 + n;
        float a[9];
#pragma unroll
        for (int r = 0; r < 9; ++r) a[r] = 0.f;
#pragma unroll 16
        for (int k = 0; k < 256; ++k) { const float w = wp[(size_t)k * 6144];
#pragma unroll
            for (int r = 0; r < 9; ++r) a[r] += sc[r * DM + F.wave * 256 + k] * w; }
#pragma unroll
        for (int r = 0; r < 9; ++r) part[(F.wave * 9 + r) * 64 + F.lane] = a[r];
        __syncthreads();
        for (int o = F.tid; o < 9 * 64; o += NTHR) { float t = F.ap->in[6][layer * 6144 + cb * 64 + (o & 63)];
#pragma unroll
            for (int w = 0; w < 8; ++w) t += part[w * 576 + o];
            mod[((size_t)layer * 9 + (o >> 6)) * 6144 + cb * 64 + (o & 63)] = t; }
        __syncthreads();
    }
    __syncthreads();
    LAS float* scr = (LAS float*)(F.lds + F.wave * 16896);
    constexpr int I_FI = (DM / 64) * (8192 / 64), I_FO = (FW / 64) * (DM / 64), I_SI = (DM / 64) * (SSD_IN / 64), I_SO = (FW / 64) * (DM / 64);
    for (int it = gw; it < I_FI + I_FO + I_SI + I_SO; it += NGW) {
        int r = it;
        if (r < I_FI) { p0_transpose_item(F.ap->in[9], DM, 8192, (bf16*)(F.ws + WS_WFI), scr, r, F.lane); continue; } r -= I_FI;
        if (r < I_FO) { p0_transpose_item(F.ap->in[10], FW, DM, (bf16*)(F.ws + WS_WFO), scr, r, F.lane); continue; } r -= I_FO;
        if (r < I_SI) { p0_transpose_item(F.ap->in[11], DM, SSD_IN, (bf16*)(F.ws + WS_WSI), scr, r, F.lane); continue; } r -= I_SI;
        p0_transpose_item(F.ap->in[18], FW, DM, (bf16*)(F.ws + WS_WSO), scr, r, F.lane);
    }
    { v4u* zp = (v4u*)((bf16*)(F.ws + WS_WSI) + (size_t)SSD_IN * DM); const size_t nz = (size_t)(SSD_IN_PAD - SSD_IN) * DM / 8;
      for (size_t i = gt; i < nz; i += NGT) zp[i] = (v4u){0u, 0u, 0u, 0u}; }
    { bf16* D = (bf16*)(F.ws + WS_D256);
      for (size_t i = gt; i < 512 * 256; i += NGT) { const int j = (int)(i >> 8), n = (int)i & 255; const int idx = ((j & 255) * n) & 255; float s, c; sincospif((float)idx * (1.0f / 128.0f), &s, &c); D[i] = (bf16)f2bf(j < 256 ? c : s); } }
    { bf16* A = (bf16*)(F.ws + WS_A4P);
      for (size_t i = gt; i < 256 * 512; i += NGT) { const int k = (int)(i >> 9), kk = (int)i & 511; const int idx = (k * (kk & 255)) & 255; float s, c; sincospif((float)idx * (1.0f / 128.0f), &s, &c); A[i] = (bf16)f2bf(kk < 256 ? c : -s); } }
    { bf16* A = (bf16*)(F.ws + WS_A4S);
      for (size_t i = gt; i < (size_t)1024 * 2048; i += NGT) { const int k = (int)(i >> 11), kk = (int)i & 2047; const int idx = (k * (kk & 1023)) & 1023; float s, c; sincospif((float)idx * (1.0f / 512.0f), &s, &c); A[i] = (bf16)f2bf(kk < 1024 ? c : -s); } }
    { float* P = (float*)(F.ws + WS_POS);
      for (size_t i = gt; i < (size_t)LSA * DM; i += NGT) { const int t = (int)(i >> 11), j = (int)i & 2047; const int qd = j >> 9, ii = j & 511; const int p = qd < 2 ? (t >> 6) : (t & 63);
          const float om = expf(-9.210340371976184f * (float)ii * (1.0f / 512.0f)); const float ang = (float)p * om; P[i] = (qd & 1) ? cosf(ang) : sinf(ang); } }
}

__device__ __forceinline__ void row_stats(const f32x4 (&v)[8], float& mean, float& rstd) {
    float s = 0.f;
#pragma unroll
    for (int j = 0; j < 8; ++j) s += (v[j][0] + v[j][1]) + (v[j][2] + v[j][3]);
    mean = wave_sum(s) * (1.f / DM); float s2 = 0.f;
#pragma unroll
    for (int j = 0; j < 8; ++j) { const f32x4 d = v[j] - mean; s2 += (d[0] * d[0] + d[1] * d[1]) + (d[2] * d[2] + d[3] * d[3]); }
    rstd = 1.f / sqrtf(wave_sum(s2) * (1.f / DM) + LN_EPS);
}
__device__ __forceinline__ void modulate_store(const f32x4 (&v)[8], float mean, float rstd, const float* modrow, bf16* hrow, int lane) {
    const f32x4* sh = (const f32x4*)modrow + lane; const f32x4* scp = (const f32x4*)(modrow + DM) + lane; v2u* o = (v2u*)hrow + lane;
#pragma unroll
    for (int j = 0; j < 8; ++j) { const f32x4 y = (v[j] - mean) * rstd * (scp[64 * j] + 1.0f) + sh[64 * j]; v2u w; w.x = pk2(y[0], y[1]); w.y = pk2(y[2], y[3]); o[64 * j] = w; }
}
__device__ __forceinline__ void p1_load(Frame& F, int r, const float* pos, f32x4 (&v)[8], f32x4 (&p)[8]) {
    const bool smp = r >= NPR; const f32x4* xr = (const f32x4*)(smp ? F.ap->in[1] + (size_t)(r - NPR) * DM : F.ap->in[0] + (size_t)r * DM) + F.lane;
    const f32x4* pr = (const f32x4*)(pos + (size_t)((r - NPR) & (LSA - 1)) * DM) + F.lane;
#pragma unroll
    for (int j = 0; j < 8; ++j) { v[j] = xr[64 * j]; p[j] = smp ? pr[64 * j] : (f32x4){0.f, 0.f, 0.f, 0.f}; }
}
__device__ __forceinline__ void p1_ln_mod(Frame& F) {
    const int gw = F.bx * NWAVES + F.wave, NGW = F.G * NWAVES; const float* mod0 = (const float*)(F.ws + WS_MOD); const float* pos = (const float*)(F.ws + WS_POS); bf16* H = (bf16*)(F.ws + WS_H);
    f32x4 v[8], p[8], vn[8], pn[8];
    if (gw < NTOK) p1_load(F, gw, pos, v, p);
    for (int r = gw; r < NTOK; r += NGW) {
        const int rn = r + NGW; if (rn < NTOK) p1_load(F, rn, pos, vn, pn);
#pragma unroll
        for (int j = 0; j < 8; ++j) v[j] = v[j] + p[j];
        float mean, rstd; row_stats(v, mean, rstd);
        modulate_store(v, mean, rstd, mod0 + (size_t)cond_of_row(r) * 6144, H + (size_t)r * DM, F.lane);
#pragma unroll
        for (int j = 0; j < 8; ++j) { v[j] = vn[j]; p[j] = pn[j]; }
    }
}
__device__ __forceinline__ void p6_ln_ln_mod(Frame& F) {
    const int gw = F.bx * NWAVES + F.wave, NGW = F.G * NWAVES; const float* mod1 = (const float*)(F.ws + WS_MOD) + 9 * 6144; float* V = (float*)(F.ws + WS_V); bf16* H = (bf16*)(F.ws + WS_H);
    const f32x4* gp = (const f32x4*)F.ap->in[7] + F.lane; const f32x4* bp = (const f32x4*)F.ap->in[8] + F.lane;
    f32x4 v[8], vn[8];
    if (gw < NTOK) { const f32x4* vr = (const f32x4*)(V + (size_t)gw * DM) + F.lane;
#pragma unroll
        for (int j = 0; j < 8; ++j) v[j] = vr[64 * j]; }
    for (int r = gw; r < NTOK; r += NGW) {
        const int rn = r + NGW; if (rn < NTOK) { const f32x4* vr = (const f32x4*)(V + (size_t)rn * DM) + F.lane;
#pragma unroll
            for (int j = 0; j < 8; ++j) vn[j] = vr[64 * j]; }
        f32x4* vw = (f32x4*)(V + (size_t)r * DM) + F.lane;
        float mean, rstd; row_stats(v, mean, rstd);
#pragma unroll
        for (int j = 0; j < 8; ++j) { v[j] = (v[j] - mean) * rstd * gp[64 * j] + bp[64 * j]; vw[64 * j] = v[j]; }
        row_stats(v, mean, rstd);
        modulate_store(v, mean, rstd, mod1 + (size_t)cond_of_row(r) * 6144, H + (size_t)r * DM, F.lane);
#pragma unroll
        for (int j = 0; j < 8; ++j) v[j] = vn[j];
    }
}
__device__ __forceinline__ void p11_final_ln(Frame& F) {
    const int gw = F.bx * NWAVES + F.wave, NGW = F.G * NWAVES; const float* V = (const float*)(F.ws + WS_V);
    const f32x4* gp = (const f32x4*)(F.ap->in[7] + DM) + F.lane; const f32x4* bp = (const f32x4*)(F.ap->in[8] + DM) + F.lane;
    f32x4 v[8], vn[8];
    if (gw < NTOK) { const f32x4* vr = (const f32x4*)(V + (size_t)gw * DM) + F.lane;
#pragma unroll
        for (int j = 0; j < 8; ++j) v[j] = vr[64 * j]; }
    for (int r = gw; r < NTOK; r += NGW) {
        const int rn = r + NGW; if (rn < NTOK) { const f32x4* vr = (const f32x4*)(V + (size_t)rn * DM) + F.lane;
#pragma unroll
            for (int j = 0; j < 8; ++j) vn[j] = vr[64 * j]; }
        f32x4* o = (f32x4*)(F.out + (size_t)r * DM) + F.lane;
        float mean, rstd; row_stats(v, mean, rstd);
#pragma unroll
        for (int j = 0; j < 8; ++j) o[64 * j] = (v[j] - mean) * rstd * gp[64 * j] + bp[64 * j];
#pragma unroll
        for (int j = 0; j < 8; ++j) v[j] = vn[j];
    }
}
__device__ __forceinline__ void p8_conv(Frame& F) {
    const bf16* XBC = (const bf16*)(F.ws + WS_XBC); bf16* XT = (bf16*)(F.ws + WS_XT); bf16* BN = (bf16*)(F.ws + WS_BN); bf16* CN = (bf16*)(F.ws + WS_CN); bf16* BT = (bf16*)(F.ws + WS_BT);
    LAS bf16* tile = (LAS bf16*)F.lds;
    const int co = F.tid & 31, tr = F.tid >> 5;
    const bool bal = F.G == 256; const int NIT = (NTOK / 64) * 24;
    const int i0 = bal ? (F.bx < 64 ? F.bx : 1024 + (F.bx - 64)) : F.bx, istep = bal ? (F.bx < 64 ? 64 : 192) : F.G, iend = bal && F.bx < 64 ? 1024 : NIT;
    for (int item = i0; item < iend; item += istep) {
        const int tb = item / 24, cb = item % 24; const int t0 = tb * 64;
        const int lo = t0 < NPR ? (t0 & ~(LPR - 1)) : NPR + ((t0 - NPR) & ~(LSA - 1)); const int hi = lo + (t0 < NPR ? LPR : LSA);
        const int ch = cb * 256 + co * 8; const int tq = t0 + 4 * tr;
        float w[5][8], bias[8];
#pragma unroll
        for (int k = 0; k < 5; ++k) { const f32x4 a = *(const f32x4*)(F.ap->in[12] + (size_t)k * CONVD + ch), b = *(const f32x4*)(F.ap->in[12] + (size_t)k * CONVD + ch + 4);
#pragma unroll
            for (int e = 0; e < 4; ++e) { w[k][e] = a[e]; w[k][4 + e] = b[e]; } }
        { const f32x4 a = *(const f32x4*)(F.ap->in[13] + ch), b = *(const f32x4*)(F.ap->in[13] + ch + 4);
#pragma unroll
          for (int e = 0; e < 4; ++e) { bias[e] = a[e]; bias[4 + e] = b[e]; } }
        v4u raw[8];
#pragma unroll
        for (int k = 0; k < 8; ++k) { const int tt = tq + k - 2; raw[k] = (v4u){0u, 0u, 0u, 0u}; if (tt >= lo && tt < hi) raw[k] = *(const v4u*)(XBC + (size_t)tt * CONVD + ch); }
        float o[4][8];
#pragma unroll
        for (int j = 0; j < 4; ++j)
#pragma unroll
            for (int e = 0; e < 8; ++e) o[j][e] = bias[e];
#pragma unroll
        for (int k = 0; k < 8; ++k) { const float rv[8] = {bf_lo(raw[k].x), bf_hi(raw[k].x), bf_lo(raw[k].y), bf_hi(raw[k].y), bf_lo(raw[k].z), bf_hi(raw[k].z), bf_lo(raw[k].w), bf_hi(raw[k].w)};
#pragma unroll
            for (int j = 0; j < 4; ++j) { const int kk = k - j;
                if (kk >= 0 && kk < 5) {
#pragma unroll
                    for (int e = 0; e < 8; ++e) o[j][e] += rv[e] * w[kk][e]; } } }
        unsigned pw[4][4];
#pragma unroll
        for (int j = 0; j < 4; ++j) {
#pragma unroll
            for (int e = 0; e < 8; ++e) o[j][e] = silu_f(o[j][e]);
            pw[j][0] = pk2(o[j][0], o[j][1]); pw[j][1] = pk2(o[j][2], o[j][3]); pw[j][2] = pk2(o[j][4], o[j][5]); pw[j][3] = pk2(o[j][6], o[j][7]); }
        if (cb >= 16) {
            bf16* dst = (cb < 20 ? BN + (cb - 16) * 256 : CN + (cb - 20) * 256) + co * 8;
#pragma unroll
            for (int j = 0; j < 4; ++j) *(v4u*)(dst + (size_t)(tq + j) * 1024) = (v4u){pw[j][0], pw[j][1], pw[j][2], pw[j][3]};
        }
        if (cb < 20) {
            __syncthreads();
#pragma unroll
            for (int e = 0; e < 8; ++e) { const int row = co * 8 + e; LAS bf16* rp = tile + row * 64 + (((tr >> 1) ^ (co & 7)) << 3) + (tr & 1) * 4;
                const unsigned sh = (e & 1) * 16;
                v2u pk; pk.x = ((pw[0][e >> 1] >> sh) & 0xffffu) | (((pw[1][e >> 1] >> sh) & 0xffffu) << 16); pk.y = ((pw[2][e >> 1] >> sh) & 0xffffu) | (((pw[3][e >> 1] >> sh) & 0xffffu) << 16);
                *(LAS v2u*)rp = pk; }
            __syncthreads();
            bf16* dstT = cb < 16 ? XT + (size_t)(cb * 256) * NTOK : BT + (size_t)((cb - 16) * 256) * NTOK;
#pragma unroll
            for (int k = 0; k < 4; ++k) { const int id = F.tid + 512 * k, row = id >> 3, oct = id & 7;
                const v4u v = *(const LAS v4u*)(tile + row * 64 + ((oct ^ ((row >> 3) & 7)) << 3));
                *(v4u*)(dstT + (size_t)row * NTOK + t0 + oct * 8) = v; }
        }
    }
}

namespace scan {
constexpr int CL = 64;
constexpr int P272 = 272, P144 = 144;
constexpr int CM_B = 64 * P272, BMT_B = 128 * P144, XT_B = 64 * P144, SH_B = 64 * P272;
constexpr int CM_OFF = 0, BM_OFF = 2 * CM_B, BMT_OFF = 3 * CM_B, XT_OFF = BMT_OFF + 2 * BMT_B, SH_OFF = XT_OFF + 2 * XT_B, TAB_OFF = SH_OFF + 2 * SH_B;
constexpr int TAB_B = 3 * 1024 + 64;
static_assert(TAB_OFF + 2 * TAB_B <= MISC_OFF, "scan LDS map");
__device__ __forceinline__ float softplus_f(float x) { return x > 20.f ? x : log1pf(expf(x)); }
__device__ __forceinline__ void glds16_asm(const void* gsrc, unsigned lds_dst) {
    unsigned keep;
    asm volatile("s_mov_b32 %0, m0\n\ts_mov_b32 m0, %2\n\ts_nop 0\n\tglobal_load_lds_dwordx4 %1, off\n\ts_mov_b32 m0, %0" : "=&s"(keep) : "v"(gsrc), "s"(lds_dst) : "memory");
}
template <int PITCH>
__device__ __forceinline__ void dma_image(LAS unsigned char* img, const char* src, size_t rstride, int npieces, int wid, int lane) {
    const unsigned base = (unsigned)(size_t)img;
    for (int P = wid; P < npieces; P += 8) { const int x = 1024 * P + 16 * lane; const int row = x / PITCH; int ch = (x - row * PITCH) >> 4; ch = ch == (PITCH / 16 - 1) ? 0 : ch;
        glds16_asm(src + (size_t)row * rstride + ch * 16, (unsigned)__builtin_amdgcn_readfirstlane((int)(base + (unsigned)P * 1024u))); }
}
#define LD16(p) (*(const LAS bf16x8*)(p))
#define LD8(p) (*(const LAS v2u*)(p))

__device__ __forceinline__ void scan_dir(Frame& F, const int bb, const int g, const int hh, const int dir) {
    LAS unsigned char* lds = F.lds;
    const int tid = F.tid, lane = F.lane, wid = F.wave, c16 = lane & 15, q = lane >> 4;
    const bool smp = bb >= NBP; const int L = smp ? LSA : LPR, nc = L / CL, row0 = row0_of(bb);
    const char* BNg = (const char*)(F.ws + WS_BN); const char* CNg = (const char*)(F.ws + WS_CN); const char* BTg = (const char*)(F.ws + WS_BT); const char* XTg = (const char*)(F.ws + WS_XT);
    const bf16* Zg = (const bf16*)(F.ws + WS_Z); const float* DTg = (const float*)(F.ws + WS_DT); bf16* Yg = (bf16*)(F.ws + WS_Y); float* SSQ = (float*)(F.ws + WS_SSQ);
    const float* dt_bias = F.ap->in[14]; const float* a_log = F.ap->in[15];
    const int hbase = g * 8 + hh * 4;
    const int lt = wid & 3, ph = wid >> 2;
    const int lcol = 16 * lt + c16;
    const int nrow = 16 * wid + c16;
    const int aCM = lcol * P272 + 16 * q;
    const int aR272 = c16 * P272 + 16 * q;
    const int aSHw = c16 * P272 + 8 * q + 32 * wid;
    const int aX8 = c16 * P144 + 8 * q;
    const int aX16 = c16 * P144 + 16 * q;
    const int aXe = (4 * q) * P144 + 2 * lcol;
    const int aBT = nrow * P144 + 16 * q;
    const int tdir = dir * 64;
    f32x4 S[4][4];
#pragma unroll
    for (int hd = 0; hd < 4; ++hd)
#pragma unroll
        for (int pt = 0; pt < 4; ++pt) {
            if (smp) S[hd][pt] = *(const f32x4*)(F.ap->in[2] + ((((size_t)(bb - NBP) * 2 + dir) * 64 + hbase + hd) * 64 + 16 * pt + c16) * 128 + 16 * wid + 4 * q);
            else S[hd][pt] = (f32x4){0.f, 0.f, 0.f, 0.f}; }
    auto make_tables = [&](float raw, int tb) {
        if (tid < 256) { const int h = hbase + wid; LAS float* T = (LAS float*)(lds + TAB_OFF + tb * TAB_B);
            const float dtv = softplus_f(raw + dt_bias[tdir + h]); const float da = dtv * (-expf(a_log[tdir + h]));
            float v = da;
#pragma unroll
            for (int o = 1; o < 64; o <<= 1) { const float t = __shfl_up(v, o); if (lane >= o) v += t; }
            const float tot = __shfl(v, 63);
            const float acs = dir == 0 ? v : (tot - v + da);
            T[tid] = __log2f(dtv) - acs * 1.4426950408889634f; T[256 + tid] = acs; T[512 + tid] = expf(tot - acs) * dtv; if (lane == 0) T[768 + wid] = tot; } };
    auto chunk_t0 = [&](int step) { return row0 + (dir == 0 ? step : nc - 1 - step) * CL; };
    PB(8);
    __syncthreads();
    { const int t0 = chunk_t0(0);
      dma_image<P272>(lds + CM_OFF, CNg + ((size_t)t0 * 1024 + g * 128) * 2, 2048, 17, wid, lane);
      dma_image<P272>(lds + BM_OFF, BNg + ((size_t)t0 * 1024 + g * 128) * 2, 2048, 17, wid, lane);
      dma_image<P144>(lds + BMT_OFF, BTg + ((size_t)(g * 128) * NTOK + t0) * 2, (size_t)NTOK * 2, 18, wid, lane);
      dma_image<P144>(lds + XT_OFF, XTg + ((size_t)(hbase * 64) * NTOK + t0) * 2, (size_t)NTOK * 2, 9, wid, lane);
      const float raw = tid < 256 ? DTg[(size_t)(t0 + lane) * 128 + tdir + hbase + wid] : 0.f;
#pragma unroll
      for (int pt = 0; pt < 4; ++pt) { v2u w; w.x = pk2(S[0][pt][0], S[0][pt][1]); w.y = pk2(S[0][pt][2], S[0][pt][3]); *(LAS v2u*)(lds + SH_OFF + aSHw + pt * (16 * P272)) = w; }
      make_tables(raw, 0);
      asm volatile("s_waitcnt vmcnt(0) lgkmcnt(0)" ::: "memory");
      __syncthreads(); }
    PE(8);
#pragma unroll 1
    for (int step = 0; step < nc; ++step) {
        const int b = step & 1; const int t0 = chunk_t0(step); const bool have_next = step + 1 < nc; const int t0n = have_next ? chunk_t0(step + 1) : t0;
        LAS unsigned char* CM = lds + CM_OFF + b * CM_B; LAS unsigned char* BMT = lds + BMT_OFF + b * BMT_B;
        const LAS float* T = (const LAS float*)(lds + TAB_OFF + b * TAB_B);
        const float raw_next = (have_next && tid < 256) ? DTg[(size_t)(t0n + lane) * 128 + tdir + hbase + wid] : 0.f;
        PB(7);
        v2u Gt[4];
        { bf16x8 cf[4], bfr[4][4];
#pragma unroll
          for (int ks = 0; ks < 4; ++ks) cf[ks] = LD16(CM + aCM + 64 * ks);
#pragma unroll
          for (int st = 0; st < 4; ++st)
#pragma unroll
              for (int ks = 0; ks < 4; ++ks) bfr[st][ks] = LD16(lds + BM_OFF + aR272 + st * (16 * P272) + 64 * ks);
          __builtin_amdgcn_sched_barrier(0);
#pragma unroll
          for (int st = 0; st < 4; ++st) { f32x4 a = (f32x4){0.f, 0.f, 0.f, 0.f};
#pragma unroll
              for (int ks = 0; ks < 4; ++ks) a = __builtin_amdgcn_mfma_f32_16x16x32_bf16(bfr[st][ks], cf[ks], a, 0, 0, 0);
              Gt[st].x = pk2(a[0], a[1]); Gt[st].y = pk2(a[2], a[3]); } }
        PE(7);
        float ssq = 0.f;
#pragma unroll 1
        for (int hd = 0; hd < 4; ++hd) {
            const int h = hbase + hd;
            LAS unsigned char* XT = lds + XT_OFF + (hd & 1) * XT_B; LAS unsigned char* SH = lds + SH_OFF + (hd & 1) * SH_B;
            PB(2); PB(9);
            if (hd < 3) dma_image<P144>(lds + XT_OFF + ((hd + 1) & 1) * XT_B, XTg + ((size_t)((h + 1) * 64) * NTOK + t0) * 2, (size_t)NTOK * 2, 9, wid, lane);
            else if (have_next) dma_image<P144>(lds + XT_OFF, XTg + ((size_t)(hbase * 64) * NTOK + t0n) * 2, (size_t)NTOK * 2, 9, wid, lane);
            if (have_next) {
                if (hd == 0) dma_image<P272>(lds + CM_OFF + (b ^ 1) * CM_B, CNg + ((size_t)t0n * 1024 + g * 128) * 2, 2048, 17, wid, lane);
                else if (hd == 1) dma_image<P272>(lds + BM_OFF, BNg + ((size_t)t0n * 1024 + g * 128) * 2, 2048, 17, wid, lane);
                else if (hd == 2) dma_image<P144>(lds + BMT_OFF + (b ^ 1) * BMT_B, BTg + ((size_t)(g * 128) * NTOK + t0n) * 2, (size_t)NTOK * 2, 18, wid, lane); }
            PE(2); PB(3);
            const size_t go = (size_t)(t0 + lcol) * FW + h * 64 + 32 * ph + 4 * q;
            v2u zz[2], yp[2]; f32x4 nwv[2]; const float dsk = F.ap->in[16][h];
#pragma unroll
            for (int p2 = 0; p2 < 2; ++p2) { zz[p2] = (v2u){0u, 0u}; yp[p2] = (v2u){0u, 0u}; nwv[p2] = (f32x4){0.f, 0.f, 0.f, 0.f}; }
            if (dir == 1) {
#pragma unroll
                for (int p2 = 0; p2 < 2; ++p2) { zz[p2] = *(const v2u*)(Zg + go + 16 * p2); yp[p2] = *(const v2u*)(Yg + go + 16 * p2);
                    nwv[p2] = *(const f32x4*)(F.ap->in[17] + h * 64 + 32 * ph + 16 * p2 + 4 * q); } }
#pragma unroll
            for (int pt = 0; pt < 4; ++pt) { v2u w; w.x = pk2(S[1][pt][0], S[1][pt][1]); w.y = pk2(S[1][pt][2], S[1][pt][3]);
                *(LAS v2u*)(lds + SH_OFF + ((hd + 1) & 1) * SH_B + aSHw + pt * (16 * P272)) = w; }
            f32x4 acc[2];
            acc[0] = (f32x4){0.f, 0.f, 0.f, 0.f}; acc[1] = acc[0];
            bf16x8 b5[4], a5[2][4];
#pragma unroll
            for (int ks = 0; ks < 4; ++ks) { b5[ks] = LD16(CM + aCM + 64 * ks);
#pragma unroll
                for (int p2 = 0; p2 < 2; ++p2) a5[p2][ks] = LD16(SH + aR272 + (2 * ph + p2) * (16 * P272) + 64 * ks); }
            const float al = T[256 + hd * 64 + lcol];
            f32x4 la0[2], la1[2]; v2u x30[2][2], x31[2][2];
#pragma unroll
            for (int ks = 0; ks < 2; ++ks) { const int s0 = 32 * ks + 4 * q;
                la0[ks] = *(const LAS f32x4*)(T + hd * 64 + s0); la1[ks] = *(const LAS f32x4*)(T + hd * 64 + s0 + 16);
#pragma unroll
                for (int p2 = 0; p2 < 2; ++p2) { x30[ks][p2] = LD8(XT + aX8 + (2 * ph + p2) * (16 * P144) + 64 * ks); x31[ks][p2] = LD8(XT + aX8 + (2 * ph + p2) * (16 * P144) + 64 * ks + 32); } }
            __builtin_amdgcn_sched_barrier(0);
#pragma unroll
            for (int ks = 0; ks < 4; ++ks)
#pragma unroll
                for (int p2 = 0; p2 < 2; ++p2) acc[p2] = __builtin_amdgcn_mfma_f32_16x16x32_bf16(a5[p2][ks], b5[ks], acc[p2], 0, 0, 0);
            __builtin_amdgcn_sched_barrier(0);
            { int lc = lcol; asm volatile("" : "+v"(lc)); const float e = expf(al); const float al2 = al * 1.4426950408889634f;
              acc[0] = acc[0] * e; acc[1] = acc[1] * e;
#pragma unroll
              for (int ks = 0; ks < 2; ++ks) { const int s0 = 32 * ks + 4 * q;
                  float f[8];
#pragma unroll
                  for (int j = 0; j < 8; ++j) { const int s = s0 + (j & 3) + 16 * (j >> 2); const bool in = dir == 0 ? (s <= lc) : (s >= lc);
                      const float la = j < 4 ? la0[ks][j & 3] : la1[ks][j & 3];
                      const unsigned gw = (j & 2) ? (j < 4 ? Gt[2 * ks].y : Gt[2 * ks + 1].y) : (j < 4 ? Gt[2 * ks].x : Gt[2 * ks + 1].x); const float gv = (j & 1) ? bf_hi(gw) : bf_lo(gw);
                      f[j] = in ? __builtin_amdgcn_exp2f(al2 + la) * gv : 0.f; }
                  v4u bw; bw.x = pk2(f[0], f[1]); bw.y = pk2(f[2], f[3]); bw.z = pk2(f[4], f[5]); bw.w = pk2(f[6], f[7]); const bf16x8 bfr = __builtin_bit_cast(bf16x8, bw);
#pragma unroll
                  for (int p2 = 0; p2 < 2; ++p2) { const v4u aw = (v4u){x30[ks][p2].x, x30[ks][p2].y, x31[ks][p2].x, x31[ks][p2].y};
                      acc[p2] = __builtin_amdgcn_mfma_f32_16x16x32_bf16(__builtin_bit_cast(bf16x8, aw), bfr, acc[p2], 0, 0, 0); } } }
            v4u b8[2]; f32x4 w0[2], w1[2]; bf16x8 x4[2][4];
#pragma unroll
            for (int ks = 0; ks < 2; ++ks) { const int s0 = 32 * ks + 8 * q; b8[ks] = *(const LAS v4u*)(BMT + aBT + 64 * ks);
                w0[ks] = *(const LAS f32x4*)(T + 512 + hd * 64 + s0); w1[ks] = *(const LAS f32x4*)(T + 512 + hd * 64 + s0 + 4);
#pragma unroll
                for (int pt = 0; pt < 4; ++pt) x4[ks][pt] = LD16(XT + aX16 + pt * (16 * P144) + 64 * ks); }
            const float tot_h = T[768 + hd];
            __builtin_amdgcn_sched_barrier(0);
            PE(3); PB(4);
            asm volatile("s_waitcnt vmcnt(0)" ::: "memory");
            PE(4); PB(5);
            if (hd == 3 && have_next) make_tables(raw_next, b ^ 1);
            if (dir == 0) {
#pragma unroll
                for (int p2 = 0; p2 < 2; ++p2) { float y[4];
#pragma unroll
                    for (int r = 0; r < 4; ++r) y[r] = acc[p2][r] + dsk * bf2f(*(const LAS bf16*)(XT + aXe + (16 * (2 * ph + p2) + r) * P144));
                    v2u o; o.x = pk2(y[0], y[1]); o.y = pk2(y[2], y[3]); *(v2u*)(Yg + go + 16 * p2) = o; }
            } else {
#pragma unroll
                for (int p2 = 0; p2 < 2; ++p2) { const f32x4 nw = nwv[p2];
                    const float y0 = (acc[p2][0] + bf_lo(yp[p2].x)) * bf_lo(zz[p2].x), y1 = (acc[p2][1] + bf_hi(yp[p2].x)) * bf_hi(zz[p2].x);
                    const float y2 = (acc[p2][2] + bf_lo(yp[p2].y)) * bf_lo(zz[p2].y), y3 = (acc[p2][3] + bf_hi(yp[p2].y)) * bf_hi(zz[p2].y);
                    ssq += (y0 * y0 + y1 * y1) + (y2 * y2 + y3 * y3);
                    v2u o; o.x = pk2(y0 * nw[0], y1 * nw[1]); o.y = pk2(y2 * nw[2], y3 * nw[3]); *(v2u*)(Yg + go + 16 * p2) = o; }
            }
            asm volatile("" ::: "memory");
            { const float dec = expf(tot_h);
#pragma unroll
              for (int pt = 0; pt < 4; ++pt) S[0][pt] = S[0][pt] * dec;
#pragma unroll
              for (int ks = 0; ks < 2; ++ks) {
                  v4u w; w.x = pk2(bf_lo(b8[ks].x) * w0[ks][0], bf_hi(b8[ks].x) * w0[ks][1]); w.y = pk2(bf_lo(b8[ks].y) * w0[ks][2], bf_hi(b8[ks].y) * w0[ks][3]);
                  w.z = pk2(bf_lo(b8[ks].z) * w1[ks][0], bf_hi(b8[ks].z) * w1[ks][1]); w.w = pk2(bf_lo(b8[ks].w) * w1[ks][2], bf_hi(b8[ks].w) * w1[ks][3]);
                  const bf16x8 a = __builtin_bit_cast(bf16x8, w);
#pragma unroll
                  for (int pt = 0; pt < 4; ++pt) S[0][pt] = __builtin_amdgcn_mfma_f32_16x16x32_bf16(a, x4[ks][pt], S[0][pt], 0, 0, 0); } }
#pragma unroll
            for (int pt = 0; pt < 4; ++pt) { const f32x4 t0v = S[0][pt]; S[0][pt] = S[1][pt]; S[1][pt] = S[2][pt]; S[2][pt] = S[3][pt]; S[3][pt] = t0v; }
            PE(5); PB(6);
            asm volatile("s_waitcnt lgkmcnt(0)" ::: "memory"); __builtin_amdgcn_s_barrier(); asm volatile("" ::: "memory");
            PE(6); PE(9);
        }
        if (dir == 1) { float v = ssq; v += __shfl_xor(v, 16); v += __shfl_xor(v, 32);
            if (q == 0) atomicAdd(SSQ + (t0 + lcol), v); }
    }
    if (!smp) {
        float* so = F.out + (size_t)NTOK * DM;
#pragma unroll
        for (int hd = 0; hd < 4; ++hd)
#pragma unroll
            for (int pt = 0; pt < 4; ++pt) *(f32x4*)(so + ((((size_t)bb * 2 + dir) * 64 + hbase + hd) * 64 + 16 * pt + c16) * 128 + 16 * wid + 4 * q) = S[hd][pt];
    }
}
#undef LD16
#undef LD8
__device__ __forceinline__ void unit(Frame& F, const int bb, const int g, const int hh) {
#pragma unroll 1
    for (int dir = 0; dir < 2; ++dir) scan_dir(F, bb, g, hh, dir);
}
__device__ __forceinline__ void phase(Frame& F) {
    const bool bal = F.G == 256;
    const int nu = bal ? (F.bx < 128 ? 1 : 4) : (640 - F.bx + F.G - 1) / F.G;
#pragma unroll 1
    for (int i = 0; i < nu; ++i) {
        int bb, g, hh;
        if (bal) {
            if (F.bx < 128) { const int u = F.bx; bb = NBP + (u >> 4); g = u & 7; hh = (u >> 3) & 1; }
            else { const int w2 = F.bx - 128, rest = (w2 & 7) | ((w2 >> 4) << 3), idx = rest * 4 + i; hh = (w2 >> 3) & 1; bb = idx >> 3; g = idx & 7; }
        } else { const int u = F.bx + i * F.G; if (u < 128) { bb = NBP + (u >> 4); g = (u >> 1) & 7; hh = u & 1; } else { const int p = u - 128; bb = p >> 4; g = (p >> 1) & 7; hh = p & 1; } }
        unit(F, bb, g, hh);
    }
}
}

__global__ void __launch_bounds__(NTHR, 2) fwd_kernel(Args args) {
    extern __shared__ __attribute__((aligned(16))) unsigned char lds_raw[];
    Frame F;
    F.lds = (LAS unsigned char*)lds_raw; F.pacc = 0; F.pt0 = 0;
    F.tid = threadIdx.x; F.lane = F.tid & 63; F.wave = __builtin_amdgcn_readfirstlane(F.tid >> 6); F.G = gridDim.x; F.bx = blockIdx.x;
    F.ap = &args;
    F.out = args.out; F.ws = args.ws;
    volatile LAS unsigned* MISC = (volatile LAS unsigned*)(F.lds + MISC_OFF);
    if (F.tid < 64) MISC[F.tid] = 0u;
    __syncthreads();
    unsigned* ctl = (unsigned*)(F.ws + WS_CTL);
    const int lo = args.ph_lo, hi = args.ph_hi;
    XcdBarrier bar; bar.bar = ctl + CW_BAR; bar.x = 0; bar.st = nullptr;
    if (hi - lo > 1) bar = xcd_barrier_post(ctl + CW_BAR, MISC + 8);
#ifndef ONLY_PHASE
#define ONLY_PHASE -1
#endif
#define IN(k) ((ONLY_PHASE < 0 || ONLY_PHASE == (k)) && lo <= (k) && (k) < hi)
#define SEAM(k) do { if (IN(k) && IN((k) + 1)) xcd_barrier(bar); } while (0)
#ifndef DUP_MASK
#define DUP_MASK 0
#endif
#define REP(k) for (int _rep = 0; _rep < 1 + ((DUP_MASK >> (k)) & 1); ++_rep, __syncthreads())
    bf16* H = (bf16*)(F.ws + WS_H); bf16* U = (bf16*)(F.ws + WS_U); bf16* Z = (bf16*)(F.ws + WS_Z); bf16* T = (bf16*)(F.ws + WS_T); float* V = (float*)(F.ws + WS_V);
    const float* mod = (const float*)(F.ws + WS_MOD);

    if (IN(0)) REP(0) { PB(20); PB(40); p0_prologue(F); PE(20); } SEAM(0); PE(40);
    if (IN(1)) REP(1) { PB(21); PB(41); p1_ln_mod(F); PE(21); } SEAM(1); PE(41);
    if (IN(2)) REP(2) { PB(22); PB(42); SchedGrid S{H, (const bf16*)(F.ws + WS_WFI), 64, 32, DM, DM, F.G, F.bx}; EpiUZ E{U, Z};
                 pg8::gemm_phase<EpiUZ, SchedGrid, GP_ALIGN, GP_SP2>(F.lds, DM, DM, DM, S, E); PE(22); } SEAM(2); PE(42);
    if (IN(3)) REP(3) { PB(23); PB(43); SchedCDFT S{(const bf16*)(F.ws + WS_D256), U, F.G, F.bx}; EpiCDFT E{T};
                 pg8::gemm_phase<EpiCDFT, SchedCDFT, GP_ALIGN, GP_SP2>(F.lds, 256, 256, FW, S, E); PE(23); } SEAM(3); PE(43);
    if (IN(4)) REP(4) { PB(24); PB(44); { SchedLDFT S{(const bf16*)(F.ws + WS_A4S), T, 1, F.G, F.bx}; EpiLDFT E{Z, U, 1.0f / 512.0f};
                   pg8::gemm_phase<EpiLDFT, SchedLDFT, GP_ALIGN, GP_SP2>(F.lds, 2 * LSA, 2 * LSA, 2 * LSA, S, E); }
                 { SchedLDFT S{(const bf16*)(F.ws + WS_A4P), T, 0, F.G, F.bx}; EpiLDFT E{Z, U, 1.0f / 256.0f};
                   pg8::gemm_phase<EpiLDFT, SchedLDFT, GP_ALIGN, GP_SP2>(F.lds, 2 * LPR, 2 * LPR, 2 * LPR, S, E); } PE(24); } SEAM(4); PE(44);
    if (IN(5)) REP(5) { PB(25); PB(45); SchedGrid S{U, (const bf16*)(F.ws + WS_WFO), 64, 8, FW, FW, F.G, F.bx}; EpiRes0 E{F.ap->in[0], F.ap->in[1], (const float*)(F.ws + WS_POS), mod, V};
                 pg8::gemm_phase<EpiRes0, SchedGrid, GP_ALIGN, GP_SP2>(F.lds, FW, FW, FW, S, E); PE(25); } SEAM(5); PE(45);
    if (IN(6)) REP(6) { PB(26); PB(46); p6_ln_ln_mod(F); PE(26); } SEAM(6); PE(46);
    if (IN(7)) REP(7) { PB(27); PB(47); SchedGrid S{H, (const bf16*)(F.ws + WS_WSI), 64, 40, DM, DM, F.G, F.bx}; EpiProj E{Z, (bf16*)(F.ws + WS_XBC), (float*)(F.ws + WS_DT)};
                 pg8::gemm_phase<EpiProj, SchedGrid, GP_ALIGN, GP_SP2>(F.lds, DM, DM, DM, S, E); PE(27); } SEAM(7); PE(47);
    if (IN(8)) REP(8) { PB(28); PB(48);
        const bool dtw = (F.G == 256) && F.bx < 64;
        if (F.G != 256 || dtw) { SchedOne S{H, (const bf16*)(F.ws + WS_WSI), 0, 40, DM, DM}; EpiProj E{Z, (bf16*)(F.ws + WS_XBC), (float*)(F.ws + WS_DT)};
            if (F.G == 256) { S.pm = F.bx; pg8::gemm_phase<EpiProj, SchedOne, GP_ALIGN, GP_SP2>(F.lds, DM, DM, DM, S, E); }
            else for (int pm = F.bx; pm < 64; pm += F.G) { S.pm = pm; pg8::gemm_phase<EpiProj, SchedOne, GP_ALIGN, GP_SP2>(F.lds, DM, DM, DM, S, E); } }
        p8_conv(F); PE(28); } SEAM(8); PE(48);
    if (IN(9)) REP(9) { PB(29); PB(49); PB(1); scan::phase(F); PE(1); PE(29); } SEAM(9); PE(49);
    if (IN(10)) REP(10) { PB(30); PB(50); SchedGrid S{(const bf16*)(F.ws + WS_Y), (const bf16*)(F.ws + WS_WSO), 64, 8, FW, FW, F.G, F.bx}; EpiRes1 E{mod + 9 * 6144, (const float*)(F.ws + WS_SSQ), V};
                  pg8::gemm_phase<EpiRes1, SchedGrid, GP_ALIGN, GP_SP2>(F.lds, FW, FW, FW, S, E); PE(30); } SEAM(10); PE(50);
    if (IN(11)) REP(11) { PB(31); p11_final_ln(F); PE(31); }
    if (PROF_ID != 0 && F.bx == 0 && F.tid < 64) { const unsigned long long t0 = __builtin_amdgcn_s_memrealtime(), want = F.pacc * PROF_K;
        while (__builtin_amdgcn_s_memrealtime() - t0 < want) __builtin_amdgcn_s_sleep(8); }
#undef IN
#undef SEAM
}


extern "C" void kernel_launch(void* const* d_in, const int* in_sizes, int n_in, void* d_out, int out_size, void* d_ws, size_t ws_size, hipStream_t stream) {
    static int grid = 0;
    if (grid == 0) {
        int dev = 0, cus = 0;
        if (n_in != 19 || ws_size < WS_END || out_size != NTOK * DM + NBP * 2 * 64 * 64 * 128) { fprintf(stderr, "kernel_launch: unexpected shapes (n_in %d, ws %zu, out %d)\n", n_in, ws_size, out_size); grid = -1; return; }
        if (hipGetDevice(&dev) != hipSuccess || hipDeviceGetAttribute(&cus, hipDeviceAttributeMultiprocessorCount, dev) != hipSuccess) { grid = -1; return; }
        if (hipFuncSetAttribute((const void*)fwd_kernel, hipFuncAttributeMaxDynamicSharedMemorySize, LDS_BYTES) != hipSuccess) { fprintf(stderr, "kernel_launch: hipFuncSetAttribute failed\n"); grid = -1; return; }
        grid = cus;
    }
    if (grid < 0) return;
    (void)hipMemsetAsync((char*)d_ws + WS_CTL, 0, CTL_ZERO_BYTES, stream);
    Args a{};
    for (int i = 0; i < 19; ++i) a.in[i] = (const float*)d_in[i];
    a.out = (float*)d_out; a.ws = (unsigned char*)d_ws;
#if MK_PER_PHASE || MK_CHECK
    for (int p = 0; p < NPHASE; ++p) { a.ph_lo = p; a.ph_hi = p + 1; hipLaunchKernelGGL(fwd_kernel, dim3(grid), dim3(NTHR), LDS_BYTES, stream, a);
#if MK_CHECK
        check_after_phase(p, a, stream);
#endif
    }
#if MK_CHECK
    check_report(a, stream);
#endif
#else
    a.ph_lo = 0; a.ph_hi = NPHASE;
    hipLaunchKernelGGL(fwd_kernel, dim3(grid), dim3(NTHR), LDS_BYTES, stream, a);
#endif
}
```

```cpp
#include <hip/hip_runtime.h>
#include <cstdio>
#include <cstdint>

#ifndef MK_PER_PHASE
#define MK_PER_PHASE 0
#endif
#ifndef MK_CHECK
#define MK_CHECK 0
#endif

#define GAS __attribute__((address_space(1)))
#define LAS __attribute__((address_space(3)))
typedef unsigned short bf16;
typedef unsigned v4u __attribute__((ext_vector_type(4)));
typedef unsigned v2u __attribute__((ext_vector_type(2)));
typedef float f32x4 __attribute__((ext_vector_type(4)));
typedef short bf16x8 __attribute__((ext_vector_type(8)));
#define LDS_WAIT() asm volatile("s_waitcnt lgkmcnt(0)" ::: "memory")
#define VM_WAIT() asm volatile("s_waitcnt vmcnt(0)" ::: "memory")

constexpr int NWAVES = 8, NTHR = 512;
constexpr int DM = 2048, NTOK = 16384, NPR = 8192, LPR = 256, LSA = 1024, NBP = 32, NBS = 8;
constexpr int FW = 4096;
constexpr int SSD_IN = 10368, SSD_IN_PAD = 10496, CONVD = 6144;
constexpr float LN_EPS = 1e-5f;
constexpr float DN_ALPHA = 1.41421356237f;
constexpr int NPHASE = 12;

constexpr size_t MiB = 1u << 20;
constexpr size_t WS_CTL = 0, WS_MOD = 1 * MiB, WS_SSQ = 1 * MiB + 512 * 1024, CTL_ZERO_BYTES = 2 * MiB;
constexpr size_t WS_D256 = 2 * MiB, WS_NYQ = 2 * MiB + 512 * 1024, WS_A4P = 3 * MiB, WS_A4S = 4 * MiB, WS_POS = 8 * MiB;
constexpr size_t WS_WFI = 16 * MiB, WS_WFO = 48 * MiB, WS_WSI = 64 * MiB, WS_WSO = 106 * MiB;
constexpr size_t WS_DT = 122 * MiB;
constexpr size_t WS_H = 132 * MiB, WS_U = 196 * MiB, WS_Z = 324 * MiB, WS_T = 452 * MiB, WS_V = 708 * MiB, WS_Y = 836 * MiB, WS_END = 996 * MiB;
constexpr size_t WS_XBC = WS_T, WS_BN = 644 * MiB, WS_CN = 676 * MiB, WS_XT = WS_U, WS_BT = 964 * MiB;
constexpr int CW_BAR = 4096;

constexpr int LDS_BYTES = 163840;
constexpr int MISC_OFF = LDS_BYTES - 256;

__device__ __forceinline__ unsigned f2bf(float f) { unsigned u = __builtin_bit_cast(unsigned, f); return (u + 0x7fffu + ((u >> 16) & 1u)) >> 16; }
typedef __bf16 bf2_t __attribute__((ext_vector_type(2)));
typedef float f32x2_t __attribute__((ext_vector_type(2)));
__device__ __forceinline__ unsigned pk2(float lo, float hi) { const f32x2_t v = {lo, hi}; return __builtin_bit_cast(unsigned, __builtin_convertvector(v, bf2_t)); }
__device__ __forceinline__ float bf_lo(unsigned w) { return __builtin_bit_cast(float, w << 16); }
__device__ __forceinline__ float bf_hi(unsigned w) { return __builtin_bit_cast(float, w & 0xffff0000u); }
__device__ __forceinline__ float bf2f(bf16 b) { return __builtin_bit_cast(float, ((unsigned)b) << 16); }
__device__ __forceinline__ float silu_f(float x) { return x / (1.f + __expf(-x)); }
__device__ __forceinline__ float wave_sum(float v) {
#pragma unroll
    for (int o = 1; o < 64; o <<= 1) v += __shfl_xor(v, o);
    return v;
}

#define XB_TMO      128
#define XB_XCNT(j)  (256  + 64 * (j))
#define XB_XSUB(j)  (1280 + 64 * (j))
#define XB_XGEN(j)  (2304 + 64 * (j))
#define XB_TOP      3328
#define XB_TOPGEN   3392
#define XCD_BAR_WORDS 3456
#define XB_SPIN_CAP (1u << 20)
__device__ __forceinline__ unsigned xb_ld(unsigned* p)              { return __hip_atomic_load(p, __ATOMIC_RELAXED, __HIP_MEMORY_SCOPE_AGENT); }
__device__ __forceinline__ unsigned xb_add(unsigned* p, unsigned v) { return __hip_atomic_fetch_add(p, v, __ATOMIC_RELAXED, __HIP_MEMORY_SCOPE_AGENT); }
__device__ __forceinline__ unsigned xb_xcc_id() { return (unsigned)__builtin_amdgcn_s_getreg((3 << 11) | 20) & 0xFu; }
#define XB_SPIN(cond, bar) do { unsigned _sp = 0; while (cond) { __builtin_amdgcn_s_sleep(1); \
    if ((++_sp & 255u) == 0u) { if (xb_ld(&(bar)[XB_TMO])) break; if (_sp > XB_SPIN_CAP) { atomicAdd(&(bar)[XB_TMO], 1u); break; } } } } while (0)
struct XcdBarrier { unsigned* bar; unsigned x; volatile LAS unsigned* st; };
__device__ __forceinline__ XcdBarrier xcd_barrier_post(unsigned* bar, volatile LAS unsigned* st) {
    XcdBarrier b; b.bar = bar; b.x = xb_xcc_id(); b.st = st;
    if (threadIdx.x == 0) (void)xb_add(&bar[XB_XCNT(b.x)], 1u);
    return b;
}
__device__ __forceinline__ void xcd_barrier_complete(unsigned* bar, unsigned x, unsigned& nloc, unsigned& nx) {
    const unsigned G = gridDim.x * gridDim.y * gridDim.z;
    unsigned sum, cnt, mine, sp = 0u;
    for (;;) {
        sum = 0u; cnt = 0u; mine = 0u;
#pragma unroll
        for (unsigned j = 0; j < 16; ++j) { const unsigned c = xb_ld(&bar[XB_XCNT(j)]); sum += c; cnt += (c > 0u) ? 1u : 0u; mine = (j == x) ? c : mine; }
        if (sum == G) break;
        __builtin_amdgcn_s_sleep(1);
        if ((++sp & 255u) == 0u) { if (xb_ld(&bar[XB_TMO])) break; if (sp > XB_SPIN_CAP) { atomicAdd(&bar[XB_TMO], 1u); break; } }
    }
    nloc = mine > 0u ? mine : 1u; nx = cnt > 0u ? cnt : 1u;
}
__device__ __forceinline__ void xcd_barrier(const XcdBarrier& b) {
    asm volatile("s_waitcnt vmcnt(0)" ::: "memory");
    __syncthreads();
    if (threadIdx.x == 0) {
        unsigned* bar = b.bar;
        __builtin_amdgcn_s_waitcnt(0);
        unsigned nloc = b.st[0], nx = b.st[1];
        if (nloc == 0u) { xcd_barrier_complete(bar, b.x, nloc, nx); b.st[0] = nloc; b.st[1] = nx; }
        const unsigned old = xb_add(&bar[XB_XSUB(b.x)], 1u);
        const unsigned gen = old / nloc;
        if (old + 1u == (gen + 1u) * nloc) {
            __builtin_amdgcn_fence(__ATOMIC_RELEASE, "agent");
            asm volatile("s_waitcnt vmcnt(0)" ::: "memory");
            const unsigned og = xb_add(&bar[XB_TOP], 1u);
            const unsigned tg = og / nx;
            if (og + 1u == (tg + 1u) * nx) xb_add(&bar[XB_TOPGEN], 1u);
            else XB_SPIN(xb_ld(&bar[XB_TOPGEN]) == tg, bar);
            __builtin_amdgcn_fence(__ATOMIC_ACQUIRE, "agent");
            xb_add(&bar[XB_XGEN(b.x)], 1u);
            asm volatile("s_waitcnt vmcnt(0)" ::: "memory");
        } else {
            XB_SPIN(xb_ld(&bar[XB_XGEN(b.x)]) == gen, bar);
            __builtin_amdgcn_fence(__ATOMIC_ACQUIRE, "agent");
            asm volatile("s_waitcnt vmcnt(0)" ::: "memory");
        }
    }
    __syncthreads();
}

struct Args { const float* in[19]; float* out; unsigned char* ws; int ph_lo, ph_hi; };
#ifndef PROF_ID
#define PROF_ID 0
#endif
#ifndef PROF_K
#define PROF_K 1
#endif
#define PB(id) do { if (PROF_ID == (id)) { F.pt0 = __builtin_amdgcn_s_memrealtime(); } } while (0)
#define PE(id) do { if (PROF_ID == (id)) { F.pacc += __builtin_amdgcn_s_memrealtime() - F.pt0; } } while (0)
struct Frame {
    unsigned long long pacc, pt0;
    LAS unsigned char* lds;
    int tid, lane, wave, G, bx;
    const Args* ap;
    float* out; unsigned char* ws;
};
__device__ __forceinline__ int row0_of(int bb) { return bb < NBP ? bb * LPR : NPR + (bb - NBP) * LSA; }
__host__ __device__ __forceinline__ int k2_of_pos(int p) { return p <= 128 ? p : 384 - p; }
__device__ __forceinline__ size_t tb_of(int bb) { return bb < NBP ? (size_t)bb * 2048 * 2 * LPR : (size_t)NBP * 2048 * 2 * LPR + (size_t)(bb - NBP) * 2048 * 2 * LSA; }
__device__ __forceinline__ size_t nyq_of(int bb) { return bb < NBP ? (size_t)bb * 16 * LPR : (size_t)NBP * 16 * LPR + (size_t)(bb - NBP) * 16 * LSA; }
__device__ __forceinline__ int cond_of_row(int r) { return r < NPR ? 0 : 1 + (r - NPR) / LSA; }

namespace pg8 {
constexpr int BM = 256, BK = 64, HALF = 128, HTB = HALF * BK * 2, NXCD = 8, WGM = 8;
__host__ __device__ __forceinline__ int lds_byte(int r, int c) { const int st = (r >> 4) * 2 + (c >> 5), rr = r & 15, cc = c & 31, ob = rr * 64 + cc * 2; return st * 1024 + (ob ^ (((ob >> 9) & 1) << 5)); }
__host__ __device__ __forceinline__ void stage_rc(int b, int& R, int& C) { const int st = b / 1024, sb = b % 1024, swz = sb ^ (((sb >> 9) & 1) << 5); R = (st >> 1) * 16 + swz / 64; C = (st & 1) * 32 + (swz % 64) / 2; }
__host__ __device__ __forceinline__ int perm32(int rho) { const int n = rho >> 4, i = rho & 15; return 8 * (i >> 2) + 4 * n + (i & 3); }
struct Unit { const char* a; const char* b; int x0, x1; };
typedef f32x4 Acc[2][2][4][2];

__device__ __forceinline__ bool static_tile(int i, int G, int c, int nM, int nN, int& pm, int& pn) {
    const int nwg = nM * nN; const long L = (long)i * G + c; if (L >= nwg) return false;
    int wgid = (int)L; { const int q = nwg / NXCD, r = nwg % NXCD, xcd = wgid % NXCD, off = wgid / NXCD; wgid = (xcd < r ? xcd * (q + 1) : r * (q + 1) + (xcd - r) * q) + off; }
    const int nig = WGM * nN, gid = wgid / nig, fm = gid * WGM, gsz = (nM - fm) < WGM ? (nM - fm) : WGM;
    pm = fm + ((wgid % nig) % gsz); pn = (wgid % nig) / gsz; return true;
}

template <class Epi, class Sched, bool ALIGN_EPI, bool SP2>
__device__ __forceinline__ void gemm_phase(LAS unsigned char* lds, const int K, const int lda, const int ldb, const Sched& S, const Epi& E) {
    const int tid = threadIdx.x, wid = __builtin_amdgcn_readfirstlane(tid >> 6), lane = tid & 63, wr = wid >> 2, wc = wid & 3, fr = lane & 15, fq = lane >> 4;
    const int nt = K / BK;
    unsigned voffA[2], voffB[2];
#pragma unroll
    for (int i = 0; i < 2; ++i) { int R, C; stage_rc(tid * 16 + i * 8192, R, C); const int Rb = Epi::PERM ? ((R & ~31) + perm32(R & 31)) : R;
        voffA[i] = (unsigned)(R * lda + C) * 2u; voffB[i] = (unsigned)(Rb * ldb + C) * 2u; }
    const size_t kstep = (size_t)(BK * 2);
    const size_t hstepA = (size_t)HALF * lda * 2, hstepB = (size_t)HALF * ldb * 2;
    const unsigned ldsw = (unsigned)wid * 1024u;
    const int aoff = lds_byte(wr * 64 + fr, fq * 8), boff = lds_byte(wc * 32 + fr, fq * 8);
#define PG8_SA(b, h) (((b) * 2 + (h)) * HTB)
#define PG8_SB(b, h) ((4 + (b) * 2 + (h)) * HTB)
#define PG8_STAGE(bufoff, gbase, voff) do { _Pragma("unroll") for (int _i = 0; _i < 2; ++_i) \
        __builtin_amdgcn_global_load_lds((const unsigned*)((const char*)(gbase) + (voff)[_i]), (LAS unsigned*)(lds + (bufoff) + ldsw + _i * 8192), 16, 0, 0); } while (0)
#define PG8_LDA(dst, b, h) do { _Pragma("unroll") for (int m = 0; m < 4; ++m) _Pragma("unroll") for (int k = 0; k < 2; ++k) dst[m][k] = *(const LAS bf16x8*)(lds + PG8_SA(b, h) + aoff + m * 2048 + k * 1024); } while (0)
#define PG8_LDB(dst, b, h) do { _Pragma("unroll") for (int n = 0; n < 2; ++n) _Pragma("unroll") for (int k = 0; k < 2; ++k) dst[n][k] = *(const LAS bf16x8*)(lds + PG8_SB(b, h) + boff + n * 2048 + k * 1024); } while (0)
#define PG8_MMA(ai, bj, At, Bt) do { __builtin_amdgcn_s_setprio(1); _Pragma("unroll") for (int m = 0; m < 4; ++m) _Pragma("unroll") for (int n = 0; n < 2; ++n) _Pragma("unroll") for (int k = 0; k < 2; ++k) \
        acc[ai][bj][m][n] = __builtin_amdgcn_mfma_f32_16x16x32_bf16(Bt[n][k], At[m][k], acc[ai][bj][m][n], 0, 0, 0); __builtin_amdgcn_s_setprio(0); } while (0)
#define PG8_WAIT_V(n) asm volatile("s_waitcnt vmcnt(" #n ")" ::: "memory")
#define PG8_WAIT_L(n) asm volatile("s_waitcnt lgkmcnt(" #n ")" ::: "memory")
#define PG8_BAR __builtin_amdgcn_s_barrier()
#define PG8_SCHED __builtin_amdgcn_sched_barrier(0)
    Unit cur, nxt; int ui = 0;
    if (!S.next(0, cur)) return;
    Acc acc;
#pragma unroll
    for (int a = 0; a < 2; ++a)
#pragma unroll
        for (int b = 0; b < 2; ++b)
#pragma unroll
            for (int m = 0; m < 4; ++m)
#pragma unroll
                for (int n = 0; n < 2; ++n) acc[a][b][m][n] = (f32x4){0.f, 0.f, 0.f, 0.f};
    bf16x8 At[4][2], B0[2][2], B1[2][2];
    const char* cA = cur.a; const char* cB = cur.b;
    if constexpr (SP2) {
        PG8_STAGE(PG8_SB(0, 0), cB, voffB); PG8_STAGE(PG8_SB(0, 1), cB + hstepB, voffB); PG8_STAGE(PG8_SA(0, 0), cA, voffA); PG8_STAGE(PG8_SA(0, 1), cA + hstepA, voffA);
        if (wr == 1) PG8_BAR;
        PG8_WAIT_V(2); PG8_BAR;
        PG8_STAGE(PG8_SB(1, 0), cB + kstep, voffB); PG8_STAGE(PG8_SA(1, 0), cA + kstep, voffA); PG8_STAGE(PG8_SB(1, 1), cB + hstepB + kstep, voffB);
        PG8_WAIT_V(6); PG8_BAR;
    } else {
        PG8_STAGE(PG8_SB(0, 0), cB, voffB); PG8_STAGE(PG8_SA(0, 0), cA, voffA); PG8_STAGE(PG8_SB(0, 1), cB + hstepB, voffB); PG8_STAGE(PG8_SA(0, 1), cA + hstepA, voffA);
        if (wr == 1) PG8_BAR;
        PG8_WAIT_V(4); PG8_BAR;
        PG8_STAGE(PG8_SB(1, 0), cB + kstep, voffB); PG8_STAGE(PG8_SA(1, 0), cA + kstep, voffA); PG8_STAGE(PG8_SB(1, 1), cB + hstepB + kstep, voffB);
        PG8_WAIT_V(6); PG8_BAR;
    }
    for (;;) {
        const bool has_next = S.next(ui + 1, nxt);
        const char* nA = has_next ? nxt.a : cA; const char* nB = has_next ? nxt.b : cB;
#pragma unroll 1
        for (int t = 0; t < nt; t += 2) {
            const bool last = (t == nt - 2);
            const char* a1 = cA + (size_t)(t + 1) * kstep;
            const char* a2 = last ? nA : cA + (size_t)(t + 2) * kstep; const char* b2 = last ? nB : cB + (size_t)(t + 2) * kstep;
            const char* a3 = a2 + kstep; const char* b3 = b2 + kstep;
            if constexpr (SP2) {
            PG8_LDB(B0, 0, 0); PG8_LDB(B1, 0, 1); PG8_SCHED; PG8_LDA(At, 0, 0); PG8_STAGE(PG8_SA(1, 1), a1 + hstepA, voffA);
            PG8_WAIT_V(8); PG8_WAIT_L(0); PG8_BAR; PG8_MMA(0, 0, At, B0); PG8_MMA(0, 1, At, B1); PG8_BAR; PG8_SCHED;
            PG8_LDA(At, 0, 1); PG8_STAGE(PG8_SB(0, 0), b2, voffB); PG8_STAGE(PG8_SB(0, 1), b2 + hstepB, voffB); PG8_STAGE(PG8_SA(0, 0), a2, voffA);
            PG8_WAIT_V(8); PG8_WAIT_L(0); PG8_BAR; PG8_MMA(1, 0, At, B0); PG8_MMA(1, 1, At, B1); PG8_BAR; PG8_SCHED;
            PG8_LDB(B0, 1, 0); PG8_LDB(B1, 1, 1); PG8_SCHED; PG8_LDA(At, 1, 0); PG8_STAGE(PG8_SA(0, 1), a2 + hstepA, voffA);
            PG8_WAIT_V(8); PG8_WAIT_L(0); PG8_BAR; PG8_MMA(0, 0, At, B0); PG8_MMA(0, 1, At, B1); PG8_BAR; PG8_SCHED;
            PG8_LDA(At, 1, 1); PG8_STAGE(PG8_SB(1, 0), b3, voffB); PG8_STAGE(PG8_SB(1, 1), b3 + hstepB, voffB); PG8_STAGE(PG8_SA(1, 0), a3, voffA);
            PG8_WAIT_V(8); PG8_WAIT_L(0); PG8_BAR; PG8_MMA(1, 0, At, B0); PG8_MMA(1, 1, At, B1); PG8_BAR; PG8_SCHED;
            } else {
            PG8_LDB(B0, 0, 0); PG8_SCHED; PG8_LDA(At, 0, 0); PG8_STAGE(PG8_SA(1, 1), a1 + hstepA, voffA);
            PG8_WAIT_L(8); PG8_BAR; PG8_WAIT_L(0); PG8_MMA(0, 0, At, B0); PG8_BAR; PG8_SCHED;
            PG8_LDB(B1, 0, 1); PG8_STAGE(PG8_SB(0, 0), b2, voffB);
            PG8_BAR; PG8_WAIT_L(0); PG8_MMA(0, 1, At, B1); PG8_BAR;
            PG8_LDA(At, 0, 1); PG8_STAGE(PG8_SA(0, 0), a2, voffA);
            PG8_BAR; PG8_WAIT_L(0); PG8_MMA(1, 0, At, B0); PG8_BAR; PG8_SCHED;
            PG8_STAGE(PG8_SB(0, 1), b2 + hstepB, voffB);
            PG8_WAIT_V(6); PG8_BAR; PG8_MMA(1, 1, At, B1); PG8_BAR;
            PG8_LDB(B0, 1, 0); PG8_SCHED; PG8_LDA(At, 1, 0); PG8_STAGE(PG8_SA(0, 1), a2 + hstepA, voffA);
            PG8_WAIT_L(8); PG8_BAR; PG8_WAIT_L(0); PG8_MMA(0, 0, At, B0); PG8_BAR; PG8_SCHED;
            PG8_LDB(B1, 1, 1); PG8_STAGE(PG8_SB(1, 0), b3, voffB);
            PG8_BAR; PG8_WAIT_L(0); PG8_MMA(0, 1, At, B1); PG8_BAR;
            PG8_LDA(At, 1, 1); PG8_STAGE(PG8_SA(1, 0), a3, voffA);
            PG8_BAR; PG8_WAIT_L(0); PG8_MMA(1, 0, At, B0); PG8_BAR; PG8_SCHED;
            PG8_STAGE(PG8_SB(1, 1), b3 + hstepB, voffB);
            PG8_WAIT_V(6); PG8_BAR; PG8_MMA(1, 1, At, B1); PG8_BAR;
            }
        }
        if constexpr (ALIGN_EPI) { if (wr == 0) PG8_BAR; }
        E(acc, cur, wr, wc, fr, fq);
        if (!has_next) break;
#pragma unroll
        for (int a = 0; a < 2; ++a)
#pragma unroll
            for (int b = 0; b < 2; ++b)
#pragma unroll
                for (int m = 0; m < 4; ++m)
#pragma unroll
                    for (int n = 0; n < 2; ++n) acc[a][b][m][n] = (f32x4){0.f, 0.f, 0.f, 0.f};
        cur = nxt; cA = nA; cB = nB; ++ui;
        if constexpr (ALIGN_EPI) { if (wr == 1) PG8_BAR; }
    }
    PG8_WAIT_V(0);
    if constexpr (!ALIGN_EPI) { if (wr == 0) PG8_BAR; }
    PG8_BAR;
#undef PG8_SA
#undef PG8_SB
#undef PG8_STAGE
#undef PG8_LDA
#undef PG8_LDB
#undef PG8_MMA
#undef PG8_WAIT_V
#undef PG8_WAIT_L
#undef PG8_BAR
#undef PG8_SCHED
}
}
using pg8::Unit; using pg8::Acc;
constexpr bool GP_ALIGN = true, GP_SP2 = true;

struct SchedGrid {
    const bf16* A; const bf16* B; int nM, nN, lda, ldb, G, c;
    __device__ __forceinline__ bool next(int i, Unit& u) const { int pm, pn; if (!pg8::static_tile(i, G, c, nM, nN, pm, pn)) return false;
        u.a = (const char*)(A + (size_t)pm * 256 * lda); u.b = (const char*)(B + (size_t)pn * 256 * ldb); u.x0 = pm; u.x1 = pn; return true; }
};
struct SchedOne {
    const bf16* A; const bf16* B; int pm, pn, lda, ldb;
    __device__ __forceinline__ bool next(int i, Unit& u) const { if (i != 0 || pm < 0) return false;
        u.a = (const char*)(A + (size_t)pm * 256 * lda); u.b = (const char*)(B + (size_t)pn * 256 * ldb); u.x0 = pm; u.x1 = pn; return true; }
};
struct EpiUZ { static constexpr bool PERM = true; bf16* U; bf16* Z;
    __device__ __forceinline__ void operator()(const Acc& acc, const Unit& u, int wr, int wc, int fr, int fq) const {
        const int pm = u.x0, pn = u.x1; const bool isz = pn >= 16; bf16* base = isz ? Z : U; const int colt = (isz ? pn - 16 : pn) * 256 + wc * 32 + 8 * fq;
#pragma unroll
        for (int ai = 0; ai < 2; ++ai)
#pragma unroll
            for (int m = 0; m < 4; ++m) { const int r = pm * 256 + ai * 128 + wr * 64 + m * 16 + fr; bf16* rowp = base + (size_t)r * FW + colt;
#pragma unroll
                for (int bj = 0; bj < 2; ++bj) { f32x4 v0 = acc[ai][bj][m][0], v1 = acc[ai][bj][m][1];
                    if (isz) {
#pragma unroll
                        for (int j = 0; j < 4; ++j) { v0[j] = silu_f(v0[j]); v1[j] = silu_f(v1[j]); } }
                    v4u w; w.x = pk2(v0[0], v0[1]); w.y = pk2(v0[2], v0[3]); w.z = pk2(v1[0], v1[1]); w.w = pk2(v1[2], v1[3]);
                    *(v4u*)(rowp + bj * 128) = w; } }
    } };
struct SchedCDFT { const bf16* D; const bf16* U; int G, c;
    __device__ __forceinline__ bool next(int i, Unit& u) const { const long e = (long)i * G + c; if (e >= 1024) return false;
        const int q = (int)e; int bb, g, tn;
        if (q < 512) { bb = q >> 4; g = q & 15; tn = 0; } else { const int q2 = q - 512; bb = NBP + (q2 >> 6); g = (q2 >> 2) & 15; tn = q2 & 3; }
        u.a = (const char*)D; u.b = (const char*)(U + ((size_t)(row0_of(bb) + tn * 256) * FW + g * 256));
        u.x0 = bb | (g << 8) | (tn << 20); u.x1 = 0; return true; } };
struct EpiCDFT { static constexpr bool PERM = true; bf16* T; bf16* NYQ;
    __device__ __forceinline__ void operator()(const Acc& acc, const Unit& u, int wr, int wc, int fr, int fq) const {
        const int bb = u.x0 & 255, g = (u.x0 >> 8) & 255, tn = u.x0 >> 20; const int L = bb < NBP ? LPR : LSA;
        bf16* base = T + tb_of(bb) + (size_t)(g * 128) * (2 * L) + tn * 256;
        bf16* nq = NYQ + nyq_of(bb) + (size_t)g * L + tn * 256;
        const unsigned L2 = 2u * (unsigned)L; const unsigned coff = (unsigned)(wc * 32 + 8 * fq);
#pragma unroll
        for (int ai = 0; ai < 2; ++ai)
#pragma unroll
            for (int m = 0; m < 4; ++m) { const int k2 = wr * 64 + m * 16 + fr;
                const unsigned off = (unsigned)k2 * L2 + (unsigned)(ai * L) + coff; const bool nyq = (ai == 1) && (k2 == 0);
#pragma unroll
                for (int bj = 0; bj < 2; ++bj) { const f32x4 v0 = acc[ai][bj][m][0], v1 = acc[ai][bj][m][1];
                    v4u w; w.x = pk2(v0[0], v0[1]); w.y = pk2(v0[2], v0[3]); w.z = pk2(v1[0], v1[1]); w.w = pk2(v1[2], v1[3]);
                    if (nyq) { *(v4u*)(nq + coff + bj * 128) = w; w = (v4u){0u, 0u, 0u, 0u}; }
                    *(v4u*)(base + off + bj * 128) = w; }
                asm volatile("" ::: "memory"); }
    } };
struct SchedLDFT { const bf16* A4; const bf16* T; int sample, G, c;
    __device__ __forceinline__ bool next(int i, Unit& u) const { const long e = (long)i * G + c; if (e >= 256) return false; int bb, pm, pn;
        if (sample) { bb = NBP + ((int)e >> 5); pm = ((int)e >> 3) & 3; pn = (int)e & 7; } else { bb = (int)e >> 3; pm = 0; pn = (int)e & 7; }
        const int L2 = sample ? 2 * LSA : 2 * LPR;
        u.a = (const char*)(A4 + (size_t)pm * 256 * L2); u.b = (const char*)(T + tb_of(bb) + (size_t)pn * 256 * L2);
        u.x0 = bb | (pm << 8); u.x1 = pn; return true; } };
struct EpiLDFT { static constexpr bool PERM = true; const bf16* Z; bf16* YG; float sc;
    __device__ __forceinline__ void operator()(const Acc& acc, const Unit& u, int wr, int wc, int fr, int fq) const {
        const int bb = u.x0 & 255, pm = u.x0 >> 8, pn = u.x1; const int L = bb < NBP ? LPR : LSA, r0 = row0_of(bb);
        const int k2 = wc * 32 + 8 * fq;
#pragma unroll
        for (int ai = 0; ai < 2; ++ai)
#pragma unroll
            for (int m = 0; m < 4; ++m) { const int k1 = pm * 256 + ai * 128 + wr * 64 + m * 16 + fr; const int k1m = (L - k1) & (L - 1);
                const size_t od = (size_t)(r0 + k1) * FW + k2, om = (size_t)(r0 + k1m) * FW + 128 + k2;
#pragma unroll
                for (int bj = 0; bj < 2; ++bj) { const f32x4 v0 = acc[ai][bj][m][0] * sc, v1 = acc[ai][bj][m][1] * sc; const int gc = (2 * pn + bj) * 256;
                    { const v4u z = *(const v4u*)(Z + od + gc);
                      v4u w; w.x = pk2(v0[0] * bf_lo(z.x), v0[1] * bf_hi(z.x)); w.y = pk2(v0[2] * bf_lo(z.y), v0[3] * bf_hi(z.y));
                      w.z = pk2(v1[0] * bf_lo(z.z), v1[1] * bf_hi(z.z)); w.w = pk2(v1[2] * bf_lo(z.w), v1[3] * bf_hi(z.w));
                      *(v4u*)(YG + od + gc) = w; }
                    { const v4u z = *(const v4u*)(Z + om + gc);
                      v4u w; w.x = pk2(v0[0] * bf_lo(z.x), v0[1] * bf_hi(z.x)); w.y = pk2(v0[2] * bf_lo(z.y), v0[3] * bf_hi(z.y));
                      w.z = pk2(v1[0] * bf_lo(z.z), v1[1] * bf_hi(z.z)); w.w = pk2(v1[2] * bf_lo(z.w), v1[3] * bf_hi(z.w));
                      bf16* d = YG + om + gc;
                      if (k2 != 0) *(v4u*)d = w;
                      else { d[1] = (bf16)(w.x >> 16); *(unsigned*)(d + 2) = w.y; *(v2u*)(d + 4) = (v2u){w.z, w.w}; } }
                }
                asm volatile("" ::: "memory"); }
    } };
struct EpiRes0 { static constexpr bool PERM = false; const float* xp; const float* xs; const float* pos; const float* mod0; float* V;
    __device__ __forceinline__ void operator()(const Acc& acc, const Unit& u, int wr, int wc, int fr, int fq) const {
        const int pm = u.x0, pn = u.x1; const int rt = pm * 256; const bool smp = rt >= NPR;
        const float* gate = mod0 + (size_t)cond_of_row(rt) * 6144 + 4096;
        const int col0 = pn * 256 + wc * 32 + 4 * fq;
        f32x4 gv[2][2];
#pragma unroll
        for (int bj = 0; bj < 2; ++bj)
#pragma unroll
            for (int n = 0; n < 2; ++n) gv[bj][n] = *(const f32x4*)(gate + col0 + bj * 128 + n * 16);
#pragma unroll
        for (int ai = 0; ai < 2; ++ai)
#pragma unroll
            for (int mp = 0; mp < 2; ++mp) { f32x4 x0[2][2][2], pv[2][2][2];
#pragma unroll
                for (int mm = 0; mm < 2; ++mm) { const int r = rt + ai * 128 + wr * 64 + (2 * mp + mm) * 16 + fr;
                    const float* xr = smp ? xs + (size_t)(r - NPR) * DM : xp + (size_t)r * DM; const float* pr = pos + (size_t)((r - NPR) & (LSA - 1)) * DM;
#pragma unroll
                    for (int bj = 0; bj < 2; ++bj)
#pragma unroll
                        for (int n = 0; n < 2; ++n) { const int cc = col0 + bj * 128 + n * 16; x0[mm][bj][n] = *(const f32x4*)(xr + cc); pv[mm][bj][n] = smp ? *(const f32x4*)(pr + cc) : (f32x4){0.f, 0.f, 0.f, 0.f}; } }
#pragma unroll
                for (int mm = 0; mm < 2; ++mm) { const int m = 2 * mp + mm; const int r = rt + ai * 128 + wr * 64 + m * 16 + fr;
#pragma unroll
                    for (int bj = 0; bj < 2; ++bj)
#pragma unroll
                        for (int n = 0; n < 2; ++n) *(f32x4*)(V + (size_t)r * DM + col0 + bj * 128 + n * 16) = (x0[mm][bj][n] + pv[mm][bj][n]) * DN_ALPHA + gv[bj][n] * acc[ai][bj][m][n]; }
                asm volatile("" ::: "memory"); }
    } };
struct EpiProj { static constexpr bool PERM = true; bf16* Z; bf16* XBC; float* DT;
    __device__ __forceinline__ void operator()(const Acc& acc, const Unit& u, int wr, int wc, int fr, int fq) const {
        const int pm = u.x0, pn = u.x1;
#pragma unroll
        for (int ai = 0; ai < 2; ++ai)
#pragma unroll
            for (int m = 0; m < 4; ++m) { const int r = pm * 256 + ai * 128 + wr * 64 + m * 16 + fr;
#pragma unroll
                for (int bj = 0; bj < 2; ++bj) { f32x4 v0 = acc[ai][bj][m][0], v1 = acc[ai][bj][m][1]; const int cl = bj * 128 + wc * 32 + 8 * fq;
                    if (pn < 16) {
#pragma unroll
                        for (int j = 0; j < 4; ++j) { v0[j] = silu_f(v0[j]); v1[j] = silu_f(v1[j]); }
                        v4u w; w.x = pk2(v0[0], v0[1]); w.y = pk2(v0[2], v0[3]); w.z = pk2(v1[0], v1[1]); w.w = pk2(v1[2], v1[3]);
                        *(v4u*)(Z + (size_t)r * FW + pn * 256 + cl) = w;
                    } else if (pn < 40) {
                        v4u w; w.x = pk2(v0[0], v0[1]); w.y = pk2(v0[2], v0[3]); w.z = pk2(v1[0], v1[1]); w.w = pk2(v1[2], v1[3]);
                        *(v4u*)(XBC + (size_t)r * CONVD + (pn - 16) * 256 + cl) = w;
                    } else if (bj == 0) {
                        *(f32x4*)(DT + (size_t)r * 128 + cl) = v0; *(f32x4*)(DT + (size_t)r * 128 + cl + 4) = v1;
                    } } }
    } };
struct EpiRes1 { static constexpr bool PERM = false; const float* mod1; const float* SSQ; float* V;
    __device__ __forceinline__ void operator()(const Acc& acc, const Unit& u, int wr, int wc, int fr, int fq) const {
        const int pm = u.x0, pn = u.x1; const int rt = pm * 256;
        const float* gate = mod1 + (size_t)cond_of_row(rt) * 6144 + 4096;
        const int col0 = pn * 256 + wc * 32 + 4 * fq;
        f32x4 gv[2][2];
#pragma unroll
        for (int bj = 0; bj < 2; ++bj)
#pragma unroll
            for (int n = 0; n < 2; ++n) gv[bj][n] = *(const f32x4*)(gate + col0 + bj * 128 + n * 16);
#pragma unroll
        for (int ai = 0; ai < 2; ++ai)
#pragma unroll
            for (int mp = 0; mp < 2; ++mp) { f32x4 x1[2][2][2]; float ss[2];
#pragma unroll
                for (int mm = 0; mm < 2; ++mm) { const int r = rt + ai * 128 + wr * 64 + (2 * mp + mm) * 16 + fr; ss[mm] = SSQ[r];
#pragma unroll
                    for (int bj = 0; bj < 2; ++bj)
#pragma unroll
                        for (int n = 0; n < 2; ++n) x1[mm][bj][n] = *(const f32x4*)(V + (size_t)r * DM + col0 + bj * 128 + n * 16); }
#pragma unroll
                for (int mm = 0; mm < 2; ++mm) { const int m = 2 * mp + mm; const int r = rt + ai * 128 + wr * 64 + m * 16 + fr; const float rs = 1.0f / sqrtf(ss[mm] * (1.0f / FW) + LN_EPS);
#pragma unroll
                    for (int bj = 0; bj < 2; ++bj)
#pragma unroll
                        for (int n = 0; n < 2; ++n) *(f32x4*)(V + (size_t)r * DM + col0 + bj * 128 + n * 16) = x1[mm][bj][n] * DN_ALPHA + gv[bj][n] * (acc[ai][bj][m][n] * rs); }
                asm volatile("" ::: "memory"); }
    } };

template <int MODE>
__device__ __forceinline__ void p0_transpose_item(const float* W, int K, int N, bf16* WT, LAS float* scr, int item, int lane) {
    const int nblk = N / 64, kb = item / nblk, nb = item % nblk, k0 = 64 * kb, n0 = 64 * nb;
    const int c4 = (lane & 15) * 4, r4 = lane >> 4;
    f32x4 v[16];
#pragma unroll
    for (int i = 0; i < 16; ++i) { int kr = k0 + r4 + 4 * i; if (MODE == 2) kr = (kr & ~255) + k2_of_pos(kr & 255);
        v[i] = *(const f32x4*)(W + (size_t)kr * N + n0 + c4); }
#pragma unroll
    for (int i = 0; i < 16; ++i) { LAS float* d = scr + (r4 + 4 * i) * 65 + c4; d[0] = v[i][0]; d[1] = v[i][1]; d[2] = v[i][2]; d[3] = v[i][3]; }
    LDS_WAIT(); asm volatile("" ::: "memory");
    const int c = lane & 7;
#pragma unroll
    for (int j = 0; j < 8; ++j) { const int n = (lane >> 3) + 8 * j; const LAS float* sp = scr + (8 * c) * 65 + n;
        v4u o; o.x = pk2(sp[0 * 65], sp[1 * 65]); o.y = pk2(sp[2 * 65], sp[3 * 65]); o.z = pk2(sp[4 * 65], sp[5 * 65]); o.w = pk2(sp[6 * 65], sp[7 * 65]);
        int nr = n0 + n; if (MODE == 1 && nr >= FW) nr = (nr & ~255) + k2_of_pos(nr & 255);
        *(v4u*)(WT + (size_t)nr * K + k0 + 8 * c) = o; }
    LDS_WAIT(); asm volatile("" ::: "memory");
}
__device__ __forceinline__ void p0_prologue(Frame& F) {
    const int gw = F.bx * NWAVES + F.wave, NGW = F.G * NWAVES;
    const size_t gt = (size_t)F.bx * NTHR + F.tid, NGT = (size_t)F.G * NTHR;
    LAS float* sc = (LAS float*)F.lds;
    for (int i = F.tid; i < 9 * DM; i += NTHR) { const float v = i < DM ? F.ap->in[4][i] : F.ap->in[3][i - DM]; sc[i] = silu_f(v); }
    __syncthreads();
    float* mod = (float*)(F.ws + WS_MOD);
    LAS float* part = (LAS float*)(F.lds + 9 * DM * 4);
    for (int it = F.bx; it < 2 * 96; it += F.G) {
        const int cb = it % 96, layer = it / 96; const int n = cb * 64 + F.lane; const float* wp = F.ap->in[5] + ((size_t)layer * DM + F.wave * 256) * 6144 + n;
        float a[9];
#pragma unroll
        for (int r = 0; r < 9; ++r) a[r] = 0.f;
#pragma unroll 16
        for (int k = 0; k < 256; ++k) { const float w = wp[(size_t)k * 6144];
#pragma unroll
            for (int r = 0; r < 9; ++r) a[r] += sc[r * DM + F.wave * 256 + k] * w; }
#pragma unroll
        for (int r = 0; r < 9; ++r) part[(F.wave * 9 + r) * 64 + F.lane] = a[r];
        __syncthreads();
        for (int o = F.tid; o < 9 * 64; o += NTHR) { float t = F.ap->in[6][layer * 6144 + cb * 64 + (o & 63)];
#pragma unroll
            for (int w = 0; w < 8; ++w) t += part[w * 576 + o];
            mod[((size_t)layer * 9 + (o >> 6)) * 6144 + cb * 64 + (o & 63)] = t; }
        __syncthreads();
    }
    __syncthreads();
    LAS float* scr = (LAS float*)(F.lds + F.wave * 16896);
    constexpr int I_FI = (DM / 64) * (8192 / 64), I_FO = (FW / 64) * (DM / 64), I_SI = (DM / 64) * (SSD_IN / 64), I_SO = (FW / 64) * (DM / 64);
    for (int it = gw; it < I_FI + I_FO + I_SI + I_SO; it += NGW) {
        int r = it;
        if (r < I_FI) { p0_transpose_item<1>(F.ap->in[9], DM, 8192, (bf16*)(F.ws + WS_WFI), scr, r, F.lane); continue; } r -= I_FI;
        if (r < I_FO) { p0_transpose_item<2>(F.ap->in[10], FW, DM, (bf16*)(F.ws + WS_WFO), scr, r, F.lane); continue; } r -= I_FO;
        if (r < I_SI) { p0_transpose_item<0>(F.ap->in[11], DM, SSD_IN, (bf16*)(F.ws + WS_WSI), scr, r, F.lane); continue; } r -= I_SI;
        p0_transpose_item<0>(F.ap->in[18], FW, DM, (bf16*)(F.ws + WS_WSO), scr, r, F.lane);
    }
    { v4u* zp = (v4u*)((bf16*)(F.ws + WS_WSI) + (size_t)SSD_IN * DM); const size_t nz = (size_t)(SSD_IN_PAD - SSD_IN) * DM / 8;
      for (size_t i = gt; i < nz; i += NGT) zp[i] = (v4u){0u, 0u, 0u, 0u}; }
    { bf16* D = (bf16*)(F.ws + WS_D256);
      for (size_t i = gt; i < 256 * 256; i += NGT) { const int j = (int)(i >> 8), n = (int)i & 255; const int idx = ((j & 127) * n) & 255; float sn, cs; sincospif((float)idx * (1.0f / 128.0f), &sn, &cs);
          D[i] = (bf16)f2bf(j < 128 ? cs : (j == 128 ? ((n & 1) ? -1.0f : 1.0f) : sn)); } }
    { bf16* A = (bf16*)(F.ws + WS_A4P);
      for (size_t i = gt; i < 256 * 512; i += NGT) { const int k = (int)(i >> 9), kk = (int)i & 511; const int idx = (k * (kk & 255)) & 255; float s, c; sincospif((float)idx * (1.0f / 128.0f), &s, &c); A[i] = (bf16)f2bf(kk < 256 ? c : -s); } }
    { bf16* A = (bf16*)(F.ws + WS_A4S);
      for (size_t i = gt; i < (size_t)1024 * 2048; i += NGT) { const int k = (int)(i >> 11), kk = (int)i & 2047; const int idx = (k * (kk & 1023)) & 1023; float s, c; sincospif((float)idx * (1.0f / 512.0f), &s, &c); A[i] = (bf16)f2bf(kk < 1024 ? c : -s); } }
    { float* P = (float*)(F.ws + WS_POS);
      for (size_t i = gt; i < (size_t)LSA * DM; i += NGT) { const int t = (int)(i >> 11), j = (int)i & 2047; const int qd = j >> 9, ii = j & 511; const int p = qd < 2 ? (t >> 6) : (t & 63);
          const float om = expf(-9.210340371976184f * (float)ii * (1.0f / 512.0f)); const float ang = (float)p * om; P[i] = (qd & 1) ? cosf(ang) : sinf(ang); } }
}

__device__ __forceinline__ void p4_nyquist(Frame& F) {
    const bf16* NYQ = (const bf16*)(F.ws + WS_NYQ); const bf16* Z = (const bf16*)(F.ws + WS_Z); bf16* YG = (bf16*)(F.ws + WS_U);
    LAS bf16* nl = (LAS bf16*)F.lds;
    for (int item = F.bx; item < 256; item += F.G) {
        int bb, kb; if (item < 128) { bb = NBP + (item >> 4); kb = item & 15; } else { bb = (item - 128) >> 2; kb = (item - 128) & 3; }
        const int L = bb < NBP ? LPR : LSA; const float sc = bb < NBP ? 1.0f / 256.0f : 1.0f / 512.0f;
        const bf16* A4 = (const bf16*)(F.ws + (bb < NBP ? WS_A4P : WS_A4S));
        __syncthreads();
        for (int i = F.tid; i < 16 * L / 8; i += NTHR) *(LAS v4u*)(nl + 8 * i) = *(const v4u*)(NYQ + nyq_of(bb) + 8 * i);
        __syncthreads();
        const int k1 = kb * 64 + (F.tid >> 3), g0 = (F.tid & 7) * 2; const bf16* ar = A4 + (size_t)k1 * (2 * L);
        float a0 = 0.f, a1 = 0.f;
        for (int n = 0; n < L; n += 8) { const v4u c = *(const v4u*)(ar + n); const v4u x0 = *(const LAS v4u*)(nl + g0 * L + n), x1 = *(const LAS v4u*)(nl + (g0 + 1) * L + n);
            a0 += bf_lo(c.x) * bf_lo(x0.x) + bf_hi(c.x) * bf_hi(x0.x) + bf_lo(c.y) * bf_lo(x0.y) + bf_hi(c.y) * bf_hi(x0.y) + bf_lo(c.z) * bf_lo(x0.z) + bf_hi(c.z) * bf_hi(x0.z) + bf_lo(c.w) * bf_lo(x0.w) + bf_hi(c.w) * bf_hi(x0.w);
            a1 += bf_lo(c.x) * bf_lo(x1.x) + bf_hi(c.x) * bf_hi(x1.x) + bf_lo(c.y) * bf_lo(x1.y) + bf_hi(c.y) * bf_hi(x1.y) + bf_lo(c.z) * bf_lo(x1.z) + bf_hi(c.z) * bf_hi(x1.z) + bf_lo(c.w) * bf_lo(x1.w) + bf_hi(c.w) * bf_hi(x1.w); }
        const size_t o = (size_t)(row0_of(bb) + k1) * FW + g0 * 256 + 128;
        YG[o] = (bf16)f2bf(a0 * sc * bf2f(Z[o])); YG[o + 256] = (bf16)f2bf(a1 * sc * bf2f(Z[o + 256]));
    }
    __syncthreads();
}

__device__ __forceinline__ void row_stats(const f32x4 (&v)[8], float& mean, float& rstd) {
    float s = 0.f;
#pragma unroll
    for (int j = 0; j < 8; ++j) s += (v[j][0] + v[j][1]) + (v[j][2] + v[j][3]);
    mean = wave_sum(s) * (1.f / DM); float s2 = 0.f;
#pragma unroll
    for (int j = 0; j < 8; ++j) { const f32x4 d = v[j] - mean; s2 += (d[0] * d[0] + d[1] * d[1]) + (d[2] * d[2] + d[3] * d[3]); }
    rstd = 1.f / sqrtf(wave_sum(s2) * (1.f / DM) + LN_EPS);
}
__device__ __forceinline__ void modulate_store(const f32x4 (&v)[8], float mean, float rstd, const float* modrow, bf16* hrow, int lane) {
    const f32x4* sh = (const f32x4*)modrow + lane; const f32x4* scp = (const f32x4*)(modrow + DM) + lane; v2u* o = (v2u*)hrow + lane;
#pragma unroll
    for (int j = 0; j < 8; ++j) { const f32x4 y = (v[j] - mean) * rstd * (scp[64 * j] + 1.0f) + sh[64 * j]; v2u w; w.x = pk2(y[0], y[1]); w.y = pk2(y[2], y[3]); o[64 * j] = w; }
}
__device__ __forceinline__ void p1_load(Frame& F, int r, const float* pos, f32x4 (&v)[8], f32x4 (&p)[8]) {
    const bool smp = r >= NPR; const f32x4* xr = (const f32x4*)(smp ? F.ap->in[1] + (size_t)(r - NPR) * DM : F.ap->in[0] + (size_t)r * DM) + F.lane;
    const f32x4* pr = (const f32x4*)(pos + (size_t)((r - NPR) & (LSA - 1)) * DM) + F.lane;
#pragma unroll
    for (int j = 0; j < 8; ++j) { v[j] = xr[64 * j]; p[j] = smp ? pr[64 * j] : (f32x4){0.f, 0.f, 0.f, 0.f}; }
}
__device__ __forceinline__ void p1_ln_mod(Frame& F) {
    const int gw = F.bx * NWAVES + F.wave, NGW = F.G * NWAVES; const float* mod0 = (const float*)(F.ws + WS_MOD); const float* pos = (const float*)(F.ws + WS_POS); bf16* H = (bf16*)(F.ws + WS_H);
    f32x4 v[8], p[8], vn[8], pn[8];
    if (gw < NTOK) p1_load(F, gw, pos, v, p);
    for (int r = gw; r < NTOK; r += NGW) {
        const int rn = r + NGW; if (rn < NTOK) p1_load(F, rn, pos, vn, pn);
#pragma unroll
        for (int j = 0; j < 8; ++j) v[j] = v[j] + p[j];
        float mean, rstd; row_stats(v, mean, rstd);
        modulate_store(v, mean, rstd, mod0 + (size_t)cond_of_row(r) * 6144, H + (size_t)r * DM, F.lane);
#pragma unroll
        for (int j = 0; j < 8; ++j) { v[j] = vn[j]; p[j] = pn[j]; }
    }
}
__device__ __forceinline__ void p6_ln_ln_mod(Frame& F) {
    const int gw = F.bx * NWAVES + F.wave, NGW = F.G * NWAVES; const float* mod1 = (const float*)(F.ws + WS_MOD) + 9 * 6144; float* V = (float*)(F.ws + WS_V); bf16* H = (bf16*)(F.ws + WS_H);
    const f32x4* gp = (const f32x4*)F.ap->in[7] + F.lane; const f32x4* bp = (const f32x4*)F.ap->in[8] + F.lane;
    f32x4 v[8], vn[8];
    if (gw < NTOK) { const f32x4* vr = (const f32x4*)(V + (size_t)gw * DM) + F.lane;
#pragma unroll
        for (int j = 0; j < 8; ++j) v[j] = vr[64 * j]; }
    for (int r = gw; r < NTOK; r += NGW) {
        const int rn = r + NGW; if (rn < NTOK) { const f32x4* vr = (const f32x4*)(V + (size_t)rn * DM) + F.lane;
#pragma unroll
            for (int j = 0; j < 8; ++j) vn[j] = vr[64 * j]; }
        f32x4* vw = (f32x4*)(V + (size_t)r * DM) + F.lane;
        float mean, rstd; row_stats(v, mean, rstd);
#pragma unroll
        for (int j = 0; j < 8; ++j) { v[j] = (v[j] - mean) * rstd * gp[64 * j] + bp[64 * j]; vw[64 * j] = v[j]; }
        row_stats(v, mean, rstd);
        modulate_store(v, mean, rstd, mod1 + (size_t)cond_of_row(r) * 6144, H + (size_t)r * DM, F.lane);
#pragma unroll
        for (int j = 0; j < 8; ++j) v[j] = vn[j];
    }
}
__device__ __forceinline__ void p11_final_ln(Frame& F) {
    const int gw = F.bx * NWAVES + F.wave, NGW = F.G * NWAVES; const float* V = (const float*)(F.ws + WS_V);
    const f32x4* gp = (const f32x4*)(F.ap->in[7] + DM) + F.lane; const f32x4* bp = (const f32x4*)(F.ap->in[8] + DM) + F.lane;
    f32x4 v[8], vn[8];
    if (gw < NTOK) { const f32x4* vr = (const f32x4*)(V + (size_t)gw * DM) + F.lane;
#pragma unroll
        for (int j = 0; j < 8; ++j) v[j] = vr[64 * j]; }
    for (int r = gw; r < NTOK; r += NGW) {
        const int rn = r + NGW; if (rn < NTOK) { const f32x4* vr = (const f32x4*)(V + (size_t)rn * DM) + F.lane;
#pragma unroll
            for (int j = 0; j < 8; ++j) vn[j] = vr[64 * j]; }
        f32x4* o = (f32x4*)(F.out + (size_t)r * DM) + F.lane;
        float mean, rstd; row_stats(v, mean, rstd);
#pragma unroll
        for (int j = 0; j < 8; ++j) o[64 * j] = (v[j] - mean) * rstd * gp[64 * j] + bp[64 * j];
#pragma unroll
        for (int j = 0; j < 8; ++j) v[j] = vn[j];
    }
}
__device__ __forceinline__ void p8_conv(Frame& F) {
    const bf16* XBC = (const bf16*)(F.ws + WS_XBC); bf16* XT = (bf16*)(F.ws + WS_XT); bf16* BN = (bf16*)(F.ws + WS_BN); bf16* CN = (bf16*)(F.ws + WS_CN); bf16* BT = (bf16*)(F.ws + WS_BT);
    LAS bf16* tile = (LAS bf16*)F.lds;
    const int co = F.tid & 31, tr = F.tid >> 5;
    const bool bal = F.G == 256; const int NIT = (NTOK / 64) * 24;
    const int i0 = bal ? (F.bx < 64 ? F.bx : 1024 + (F.bx - 64)) : F.bx, istep = bal ? (F.bx < 64 ? 64 : 192) : F.G, iend = bal && F.bx < 64 ? 1024 : NIT;
    for (int item = i0; item < iend; item += istep) {
        const int tb = item / 24, cb = item % 24; const int t0 = tb * 64;
        const int lo = t0 < NPR ? (t0 & ~(LPR - 1)) : NPR + ((t0 - NPR) & ~(LSA - 1)); const int hi = lo + (t0 < NPR ? LPR : LSA);
        const int ch = cb * 256 + co * 8; const int tq = t0 + 4 * tr;
        float w[5][8], bias[8];
#pragma unroll
        for (int k = 0; k < 5; ++k) { const f32x4 a = *(const f32x4*)(F.ap->in[12] + (size_t)k * CONVD + ch), b = *(const f32x4*)(F.ap->in[12] + (size_t)k * CONVD + ch + 4);
#pragma unroll
            for (int e = 0; e < 4; ++e) { w[k][e] = a[e]; w[k][4 + e] = b[e]; } }
        { const f32x4 a = *(const f32x4*)(F.ap->in[13] + ch), b = *(const f32x4*)(F.ap->in[13] + ch + 4);
#pragma unroll
          for (int e = 0; e < 4; ++e) { bias[e] = a[e]; bias[4 + e] = b[e]; } }
        v4u raw[8];
#pragma unroll
        for (int k = 0; k < 8; ++k) { const int tt = tq + k - 2; raw[k] = (v4u){0u, 0u, 0u, 0u}; if (tt >= lo && tt < hi) raw[k] = *(const v4u*)(XBC + (size_t)tt * CONVD + ch); }
        float o[4][8];
#pragma unroll
        for (int j = 0; j < 4; ++j)
#pragma unroll
            for (int e = 0; e < 8; ++e) o[j][e] = bias[e];
#pragma unroll
        for (int k = 0; k < 8; ++k) { const float rv[8] = {bf_lo(raw[k].x), bf_hi(raw[k].x), bf_lo(raw[k].y), bf_hi(raw[k].y), bf_lo(raw[k].z), bf_hi(raw[k].z), bf_lo(raw[k].w), bf_hi(raw[k].w)};
#pragma unroll
            for (int j = 0; j < 4; ++j) { const int kk = k - j;
                if (kk >= 0 && kk < 5) {
#pragma unroll
                    for (int e = 0; e < 8; ++e) o[j][e] += rv[e] * w[kk][e]; } } }
        unsigned pw[4][4];
#pragma unroll
        for (int j = 0; j < 4; ++j) {
#pragma unroll
            for (int e = 0; e < 8; ++e) o[j][e] = silu_f(o[j][e]);
            pw[j][0] = pk2(o[j][0], o[j][1]); pw[j][1] = pk2(o[j][2], o[j][3]); pw[j][2] = pk2(o[j][4], o[j][5]); pw[j][3] = pk2(o[j][6], o[j][7]); }
        if (cb >= 16) {
            bf16* dst = (cb < 20 ? BN + (cb - 16) * 256 : CN + (cb - 20) * 256) + co * 8;
#pragma unroll
            for (int j = 0; j < 4; ++j) *(v4u*)(dst + (size_t)(tq + j) * 1024) = (v4u){pw[j][0], pw[j][1], pw[j][2], pw[j][3]};
        }
        if (cb < 20) {
            __syncthreads();
#pragma unroll
            for (int e = 0; e < 8; ++e) { const int row = co * 8 + e; LAS bf16* rp = tile + row * 64 + (((tr >> 1) ^ (co & 7)) << 3) + (tr & 1) * 4;
                const unsigned sh = (e & 1) * 16;
                v2u pk; pk.x = ((pw[0][e >> 1] >> sh) & 0xffffu) | (((pw[1][e >> 1] >> sh) & 0xffffu) << 16); pk.y = ((pw[2][e >> 1] >> sh) & 0xffffu) | (((pw[3][e >> 1] >> sh) & 0xffffu) << 16);
                *(LAS v2u*)rp = pk; }
            __syncthreads();
            bf16* dstT = cb < 16 ? XT + (size_t)(cb * 256) * NTOK : BT + (size_t)((cb - 16) * 256) * NTOK;
#pragma unroll
            for (int k = 0; k < 4; ++k) { const int id = F.tid + 512 * k, row = id >> 3, oct = id & 7;
                const v4u v = *(const LAS v4u*)(tile + row * 64 + ((oct ^ ((row >> 3) & 7)) << 3));
                *(v4u*)(dstT + (size_t)row * NTOK + t0 + oct * 8) = v; }
        }
    }
}

namespace scan {
constexpr int CL = 64;
constexpr int P272 = 272, P144 = 144;
constexpr int CM_B = 64 * P272, BMT_B = 128 * P144, XT_B = 64 * P144, SH_B = 64 * P272;
constexpr int CM_OFF = 0, BM_OFF = 2 * CM_B, BMT_OFF = 3 * CM_B, XT_OFF = BMT_OFF + 2 * BMT_B, SH_OFF = XT_OFF + 2 * XT_B, TAB_OFF = SH_OFF + 2 * SH_B;
constexpr int TAB_B = 3 * 1024 + 64;
static_assert(TAB_OFF + 2 * TAB_B <= MISC_OFF, "scan LDS map");
__device__ __forceinline__ float softplus_f(float x) { return x > 20.f ? x : log1pf(expf(x)); }
__device__ __forceinline__ void glds16_asm(const char* sbase, unsigned voff, unsigned lds_dst) {
    unsigned keep;
    asm volatile("s_mov_b32 %0, m0\n\ts_mov_b32 m0, %3\n\ts_nop 0\n\tglobal_load_lds_dwordx4 %1, %2\n\ts_mov_b32 m0, %0" : "=&s"(keep) : "v"(voff), "s"(sbase), "s"(lds_dst) : "memory");
}
template <int PITCH>
__device__ __forceinline__ unsigned dma_off(int P, int lane, unsigned rstride) { const int x = 1024 * P + 16 * lane; const int row = x / PITCH; int ch = (x - row * PITCH) >> 4; ch = ch == (PITCH / 16 - 1) ? 0 : ch;
    return (unsigned)row * rstride + (unsigned)ch * 16u; }
template <int NP>
__device__ __forceinline__ void dma_image(LAS unsigned char* img, const char* src, const unsigned (&off)[3], int wid) {
    const unsigned base = (unsigned)(size_t)img;
#pragma unroll
    for (int i = 0; i < 3; ++i) { const int P = wid + 8 * i; if (P < NP) glds16_asm(src, off[i], (unsigned)__builtin_amdgcn_readfirstlane((int)(base + (unsigned)P * 1024u))); }
}
#define LD16(p) (*(const LAS bf16x8*)(p))
#define LD8(p) (*(const LAS v2u*)(p))

__device__ __forceinline__ void scan_dir(Frame& F, const int bb, const int g, const int hh, const int dir) {
    LAS unsigned char* lds = F.lds;
    const int tid = F.tid, lane = F.lane, wid = F.wave, c16 = lane & 15, q = lane >> 4;
    const bool smp = bb >= NBP; const int L = smp ? LSA : LPR, nc = L / CL, row0 = row0_of(bb);
    const char* BNg = (const char*)(F.ws + WS_BN); const char* CNg = (const char*)(F.ws + WS_CN); const char* BTg = (const char*)(F.ws + WS_BT); const char* XTg = (const char*)(F.ws + WS_XT);
    const bf16* Zg = (const bf16*)(F.ws + WS_Z); const float* DTg = (const float*)(F.ws + WS_DT); bf16* Yg = (bf16*)(F.ws + WS_Y); float* SSQ = (float*)(F.ws + WS_SSQ);
    const float* dt_bias = F.ap->in[14]; const float* a_log = F.ap->in[15];
    const int hbase = g * 8 + hh * 4;
    const int lt = wid & 3, ph = wid >> 2;
    const int lcol = 16 * lt + c16;
    const int nrow = 16 * wid + c16;
    const int aCM = lcol * P272 + 16 * q;
    const int aR272 = c16 * P272 + 16 * q;
    const int aSHw = c16 * P272 + 8 * q + 32 * wid;
    const int aX8 = c16 * P144 + 8 * q;
    const int aX16 = c16 * P144 + 16 * q;
    const int aXe = (4 * q) * P144 + 2 * lcol;
    const int aBT = nrow * P144 + 16 * q;
    const int tdir = dir * 64;
    unsigned oN[3], oT[3], oX[3];
#pragma unroll
    for (int i = 0; i < 3; ++i) { oN[i] = dma_off<P272>(wid + 8 * i, lane, 2048u); oT[i] = dma_off<P144>(wid + 8 * i, lane, (unsigned)NTOK * 2u); oX[i] = oT[i]; }
    f32x4 S[4][4];
#pragma unroll
    for (int hd = 0; hd < 4; ++hd)
#pragma unroll
        for (int pt = 0; pt < 4; ++pt) {
            if (smp) S[hd][pt] = *(const f32x4*)(F.ap->in[2] + ((((size_t)(bb - NBP) * 2 + dir) * 64 + hbase + hd) * 64 + 16 * pt + c16) * 128 + 16 * wid + 4 * q);
            else S[hd][pt] = (f32x4){0.f, 0.f, 0.f, 0.f}; }
    auto make_tables = [&](float raw, int tb) {
        if (tid < 256) { const int h = hbase + wid; LAS float* T = (LAS float*)(lds + TAB_OFF + tb * TAB_B);
            const float dtv = softplus_f(raw + dt_bias[tdir + h]); const float da = dtv * (-expf(a_log[tdir + h]));
            float v = da;
#pragma unroll
            for (int o = 1; o < 64; o <<= 1) { const float t = __shfl_up(v, o); if (lane >= o) v += t; }
            const float tot = __shfl(v, 63);
            const float acs = dir == 0 ? v : (tot - v + da);
            T[tid] = __log2f(dtv) - acs * 1.4426950408889634f; T[256 + tid] = acs; T[512 + tid] = expf(tot - acs) * dtv; if (lane == 0) T[768 + wid] = tot; } };
    auto chunk_t0 = [&](int step) { return row0 + (dir == 0 ? step : nc - 1 - step) * CL; };
    PB(8);
    __syncthreads();
    { const int t0 = chunk_t0(0);
      dma_image<17>(lds + CM_OFF, CNg + ((size_t)t0 * 1024 + g * 128) * 2, oN, wid);
      dma_image<17>(lds + BM_OFF, BNg + ((size_t)t0 * 1024 + g * 128) * 2, oN, wid);
      dma_image<18>(lds + BMT_OFF, BTg + ((size_t)(g * 128) * NTOK + t0) * 2, oT, wid);
      dma_image<9>(lds + XT_OFF, XTg + ((size_t)(hbase * 64) * NTOK + t0) * 2, oX, wid);
      const float raw = tid < 256 ? DTg[(size_t)(t0 + lane) * 128 + tdir + hbase + wid] : 0.f;
#pragma unroll
      for (int pt = 0; pt < 4; ++pt) { v2u w; w.x = pk2(S[0][pt][0], S[0][pt][1]); w.y = pk2(S[0][pt][2], S[0][pt][3]); *(LAS v2u*)(lds + SH_OFF + aSHw + pt * (16 * P272)) = w; }
      make_tables(raw, 0);
      asm volatile("s_waitcnt vmcnt(0) lgkmcnt(0)" ::: "memory");
      __syncthreads(); }
    PE(8);
#pragma unroll 1
    for (int step = 0; step < nc; ++step) {
        const int b = step & 1; const int t0 = chunk_t0(step); const bool have_next = step + 1 < nc; const int t0n = have_next ? chunk_t0(step + 1) : t0;
        LAS unsigned char* CM = lds + CM_OFF + b * CM_B; LAS unsigned char* BMT = lds + BMT_OFF + b * BMT_B;
        const LAS float* T = (const LAS float*)(lds + TAB_OFF + b * TAB_B);
        const float raw_next = (have_next && tid < 256) ? DTg[(size_t)(t0n + lane) * 128 + tdir + hbase + wid] : 0.f;
        PB(7);
        v2u Gt[4];
        { bf16x8 cf[4], bfr[4][4];
#pragma unroll
          for (int ks = 0; ks < 4; ++ks) cf[ks] = LD16(CM + aCM + 64 * ks);
#pragma unroll
          for (int st = 0; st < 4; ++st)
#pragma unroll
              for (int ks = 0; ks < 4; ++ks) bfr[st][ks] = LD16(lds + BM_OFF + aR272 + st * (16 * P272) + 64 * ks);
          __builtin_amdgcn_sched_barrier(0);
#pragma unroll
          for (int st = 0; st < 4; ++st) { f32x4 a = (f32x4){0.f, 0.f, 0.f, 0.f};
#pragma unroll
              for (int ks = 0; ks < 4; ++ks) a = __builtin_amdgcn_mfma_f32_16x16x32_bf16(bfr[st][ks], cf[ks], a, 0, 0, 0);
              Gt[st].x = pk2(a[0], a[1]); Gt[st].y = pk2(a[2], a[3]); } }
        PE(7);
        float ssq = 0.f;
#pragma unroll 1
        for (int hp = 0; hp < 2; ++hp) {
#pragma unroll
        for (int h2 = 0; h2 < 2; ++h2) {
            const int hd = 2 * hp + h2; const int h = hbase + hd;
            LAS unsigned char* XT = lds + XT_OFF + (hd & 1) * XT_B; LAS unsigned char* SH = lds + SH_OFF + (hd & 1) * SH_B;
            PB(2); PB(9);
            if (hd < 3) dma_image<9>(lds + XT_OFF + ((hd + 1) & 1) * XT_B, XTg + ((size_t)((h + 1) * 64) * NTOK + t0) * 2, oX, wid);
            else if (have_next) dma_image<9>(lds + XT_OFF, XTg + ((size_t)(hbase * 64) * NTOK + t0n) * 2, oX, wid);
            if (have_next) {
                if (hd == 0) dma_image<17>(lds + CM_OFF + (b ^ 1) * CM_B, CNg + ((size_t)t0n * 1024 + g * 128) * 2, oN, wid);
                else if (hd == 1) dma_image<17>(lds + BM_OFF, BNg + ((size_t)t0n * 1024 + g * 128) * 2, oN, wid);
                else if (hd == 2) dma_image<18>(lds + BMT_OFF + (b ^ 1) * BMT_B, BTg + ((size_t)(g * 128) * NTOK + t0n) * 2, oT, wid); }
            PE(2); PB(3);
            const size_t go = (size_t)(t0 + lcol) * FW + h * 64 + 32 * ph + 4 * q;
            v2u zz[2], yp[2]; f32x4 nwv[2]; const float dsk = F.ap->in[16][h];
#pragma unroll
            for (int p2 = 0; p2 < 2; ++p2) { zz[p2] = (v2u){0u, 0u}; yp[p2] = (v2u){0u, 0u}; nwv[p2] = (f32x4){0.f, 0.f, 0.f, 0.f}; }
            if (dir == 1) {
#pragma unroll
                for (int p2 = 0; p2 < 2; ++p2) { zz[p2] = *(const v2u*)(Zg + go + 16 * p2); yp[p2] = *(const v2u*)(Yg + go + 16 * p2);
                    nwv[p2] = *(const f32x4*)(F.ap->in[17] + h * 64 + 32 * ph + 16 * p2 + 4 * q); } }
#pragma unroll
            for (int pt = 0; pt < 4; ++pt) { v2u w; w.x = pk2(S[h2 + 1][pt][0], S[h2 + 1][pt][1]); w.y = pk2(S[h2 + 1][pt][2], S[h2 + 1][pt][3]);
                *(LAS v2u*)(lds + SH_OFF + ((hd + 1) & 1) * SH_B + aSHw + pt * (16 * P272)) = w; }
            f32x4 acc[2];
            acc[0] = (f32x4){0.f, 0.f, 0.f, 0.f}; acc[1] = acc[0];
            bf16x8 b5[4], a5[2][4];
#pragma unroll
            for (int ks = 0; ks < 4; ++ks) { b5[ks] = LD16(CM + aCM + 64 * ks);
#pragma unroll
                for (int p2 = 0; p2 < 2; ++p2) a5[p2][ks] = LD16(SH + aR272 + (2 * ph + p2) * (16 * P272) + 64 * ks); }
            const float al = T[256 + hd * 64 + lcol];
            f32x4 la0[2], la1[2]; v2u x30[2][2], x31[2][2];
#pragma unroll
            for (int ks = 0; ks < 2; ++ks) { const int s0 = 32 * ks + 4 * q;
                la0[ks] = *(const LAS f32x4*)(T + hd * 64 + s0); la1[ks] = *(const LAS f32x4*)(T + hd * 64 + s0 + 16);
#pragma unroll
                for (int p2 = 0; p2 < 2; ++p2) { x30[ks][p2] = LD8(XT + aX8 + (2 * ph + p2) * (16 * P144) + 64 * ks); x31[ks][p2] = LD8(XT + aX8 + (2 * ph + p2) * (16 * P144) + 64 * ks + 32); } }
            __builtin_amdgcn_sched_barrier(0);
#pragma unroll
            for (int ks = 0; ks < 4; ++ks)
#pragma unroll
                for (int p2 = 0; p2 < 2; ++p2) acc[p2] = __builtin_amdgcn_mfma_f32_16x16x32_bf16(a5[p2][ks], b5[ks], acc[p2], 0, 0, 0);
            __builtin_amdgcn_sched_barrier(0);
            { int lc = lcol; asm volatile("" : "+v"(lc)); const float e = __expf(al); const float al2 = al * 1.4426950408889634f;
              acc[0] = acc[0] * e; acc[1] = acc[1] * e;
#pragma unroll
              for (int ks = 0; ks < 2; ++ks) { const int s0 = 32 * ks + 4 * q;
                  float f[8];
#pragma unroll
                  for (int j = 0; j < 8; ++j) { const int s = s0 + (j & 3) + 16 * (j >> 2); const bool in = dir == 0 ? (s <= lc) : (s >= lc);
                      const float la = j < 4 ? la0[ks][j & 3] : la1[ks][j & 3];
                      const unsigned gw = (j & 2) ? (j < 4 ? Gt[2 * ks].y : Gt[2 * ks + 1].y) : (j < 4 ? Gt[2 * ks].x : Gt[2 * ks + 1].x); const float gv = (j & 1) ? bf_hi(gw) : bf_lo(gw);
                      f[j] = in ? __builtin_amdgcn_exp2f(al2 + la) * gv : 0.f; }
                  v4u bw; bw.x = pk2(f[0], f[1]); bw.y = pk2(f[2], f[3]); bw.z = pk2(f[4], f[5]); bw.w = pk2(f[6], f[7]); const bf16x8 bfr = __builtin_bit_cast(bf16x8, bw);
#pragma unroll
                  for (int p2 = 0; p2 < 2; ++p2) { const v4u aw = (v4u){x30[ks][p2].x, x30[ks][p2].y, x31[ks][p2].x, x31[ks][p2].y};
                      acc[p2] = __builtin_amdgcn_mfma_f32_16x16x32_bf16(__builtin_bit_cast(bf16x8, aw), bfr, acc[p2], 0, 0, 0); } } }
            v4u b8[2]; f32x4 w0[2], w1[2]; bf16x8 x4[2][4];
#pragma unroll
            for (int ks = 0; ks < 2; ++ks) { const int s0 = 32 * ks + 8 * q; b8[ks] = *(const LAS v4u*)(BMT + aBT + 64 * ks);
                w0[ks] = *(const LAS f32x4*)(T + 512 + hd * 64 + s0); w1[ks] = *(const LAS f32x4*)(T + 512 + hd * 64 + s0 + 4);
#pragma unroll
                for (int pt = 0; pt < 4; ++pt) x4[ks][pt] = LD16(XT + aX16 + pt * (16 * P144) + 64 * ks); }
            const float tot_h = T[768 + hd];
            __builtin_amdgcn_sched_barrier(0);
            PE(3); PB(4);
            asm volatile("s_waitcnt vmcnt(0)" ::: "memory");
            PE(4); PB(5);
            if (hd == 3 && have_next) make_tables(raw_next, b ^ 1);
            if (dir == 0) {
#pragma unroll
                for (int p2 = 0; p2 < 2; ++p2) { float y[4];
#pragma unroll
                    for (int r = 0; r < 4; ++r) y[r] = acc[p2][r] + dsk * bf2f(*(const LAS bf16*)(XT + aXe + (16 * (2 * ph + p2) + r) * P144));
                    v2u o; o.x = pk2(y[0], y[1]); o.y = pk2(y[2], y[3]); *(v2u*)(Yg + go + 16 * p2) = o; }
            } else {
#pragma unroll
                for (int p2 = 0; p2 < 2; ++p2) { const f32x4 nw = nwv[p2];
                    const float y0 = (acc[p2][0] + bf_lo(yp[p2].x)) * bf_lo(zz[p2].x), y1 = (acc[p2][1] + bf_hi(yp[p2].x)) * bf_hi(zz[p2].x);
                    const float y2 = (acc[p2][2] + bf_lo(yp[p2].y)) * bf_lo(zz[p2].y), y3 = (acc[p2][3] + bf_hi(yp[p2].y)) * bf_hi(zz[p2].y);
                    ssq += (y0 * y0 + y1 * y1) + (y2 * y2 + y3 * y3);
                    v2u o; o.x = pk2(y0 * nw[0], y1 * nw[1]); o.y = pk2(y2 * nw[2], y3 * nw[3]); *(v2u*)(Yg + go + 16 * p2) = o; }
            }
            asm volatile("" ::: "memory");
            { const float dec = __expf(tot_h);
#pragma unroll
              for (int pt = 0; pt < 4; ++pt) S[h2][pt] = S[h2][pt] * dec;
#pragma unroll
              for (int ks = 0; ks < 2; ++ks) {
                  v4u w; w.x = pk2(bf_lo(b8[ks].x) * w0[ks][0], bf_hi(b8[ks].x) * w0[ks][1]); w.y = pk2(bf_lo(b8[ks].y) * w0[ks][2], bf_hi(b8[ks].y) * w0[ks][3]);
                  w.z = pk2(bf_lo(b8[ks].z) * w1[ks][0], bf_hi(b8[ks].z) * w1[ks][1]); w.w = pk2(bf_lo(b8[ks].w) * w1[ks][2], bf_hi(b8[ks].w) * w1[ks][3]);
                  const bf16x8 a = __builtin_bit_cast(bf16x8, w);
#pragma unroll
                  for (int pt = 0; pt < 4; ++pt) S[h2][pt] = __builtin_amdgcn_mfma_f32_16x16x32_bf16(a, x4[ks][pt], S[h2][pt], 0, 0, 0); } }
            PE(5); PB(6);
            asm volatile("s_waitcnt lgkmcnt(0)" ::: "memory"); __builtin_amdgcn_s_barrier(); asm volatile("" ::: "memory");
            PE(6); PE(9);
        }
#pragma unroll
        for (int pt = 0; pt < 4; ++pt) { const f32x4 ta = S[0][pt], tb = S[1][pt]; S[0][pt] = S[2][pt]; S[1][pt] = S[3][pt]; S[2][pt] = ta; S[3][pt] = tb; }
        }
        if (dir == 1) { float v = ssq; v += __shfl_xor(v, 16); v += __shfl_xor(v, 32);
            if (q == 0) atomicAdd(SSQ + (t0 + lcol), v); }
    }
    if (!smp) {
        float* so = F.out + (size_t)NTOK * DM;
#pragma unroll
        for (int hd = 0; hd < 4; ++hd)
#pragma unroll
            for (int pt = 0; pt < 4; ++pt) *(f32x4*)(so + ((((size_t)bb * 2 + dir) * 64 + hbase + hd) * 64 + 16 * pt + c16) * 128 + 16 * wid + 4 * q) = S[hd][pt];
    }
}
#undef LD16
#undef LD8
__device__ __forceinline__ void unit(Frame& F, const int bb, const int g, const int hh) {
#pragma unroll 1
    for (int dir = 0; dir < 2; ++dir) scan_dir(F, bb, g, hh, dir);
}
__device__ __forceinline__ void phase(Frame& F) {
    const bool bal = F.G == 256;
    const int nu = bal ? (F.bx < 128 ? 1 : 4) : (640 - F.bx + F.G - 1) / F.G;
#pragma unroll 1
    for (int i = 0; i < nu; ++i) {
        int bb, g, hh;
        if (bal) {
            if (F.bx < 128) { const int u = F.bx; bb = NBP + (u >> 4); g = u & 7; hh = (u >> 3) & 1; }
            else { const int w2 = F.bx - 128, rest = (w2 & 7) | ((w2 >> 4) << 3), idx = rest * 4 + i; hh = (w2 >> 3) & 1; bb = idx >> 3; g = idx & 7; }
        } else { const int u = F.bx + i * F.G; if (u < 128) { bb = NBP + (u >> 4); g = (u >> 1) & 7; hh = u & 1; } else { const int p = u - 128; bb = p >> 4; g = (p >> 1) & 7; hh = p & 1; } }
        unit(F, bb, g, hh);
    }
}
}

__global__ void __launch_bounds__(NTHR, 2) fwd_kernel(Args args) {
    extern __shared__ __attribute__((aligned(16))) unsigned char lds_raw[];
    Frame F;
    F.lds = (LAS unsigned char*)lds_raw; F.pacc = 0; F.pt0 = 0;
    F.tid = threadIdx.x; F.lane = F.tid & 63; F.wave = __builtin_amdgcn_readfirstlane(F.tid >> 6); F.G = gridDim.x; F.bx = blockIdx.x;
    F.ap = &args;
    F.out = args.out; F.ws = args.ws;
    volatile LAS unsigned* MISC = (volatile LAS unsigned*)(F.lds + MISC_OFF);
    if (F.tid < 64) MISC[F.tid] = 0u;
    __syncthreads();
    unsigned* ctl = (unsigned*)(F.ws + WS_CTL);
    const int lo = args.ph_lo, hi = args.ph_hi;
    XcdBarrier bar; bar.bar = ctl + CW_BAR; bar.x = 0; bar.st = nullptr;
    if (hi - lo > 1) bar = xcd_barrier_post(ctl + CW_BAR, MISC + 8);
#ifndef ONLY_PHASE
#define ONLY_PHASE -1
#endif
#define IN(k) ((ONLY_PHASE < 0 || ONLY_PHASE == (k)) && lo <= (k) && (k) < hi)
#define SEAM(k) do { if (IN(k) && IN((k) + 1)) xcd_barrier(bar); } while (0)
#ifndef DUP_MASK
#define DUP_MASK 0
#endif
#define REP(k) for (int _rep = 0; _rep < 1 + ((DUP_MASK >> (k)) & 1); ++_rep, __syncthreads())
    bf16* H = (bf16*)(F.ws + WS_H); bf16* U = (bf16*)(F.ws + WS_U); bf16* Z = (bf16*)(F.ws + WS_Z); bf16* T = (bf16*)(F.ws + WS_T); float* V = (float*)(F.ws + WS_V);
    const float* mod = (const float*)(F.ws + WS_MOD);

    if (IN(0)) REP(0) { PB(20); PB(40); p0_prologue(F); PE(20); } SEAM(0); PE(40);
    if (IN(1)) REP(1) { PB(21); PB(41); p1_ln_mod(F); PE(21); } SEAM(1); PE(41);
    if (IN(2)) REP(2) { PB(22); PB(42); SchedGrid S{H, (const bf16*)(F.ws + WS_WFI), 64, 32, DM, DM, F.G, F.bx}; EpiUZ E{U, Z};
                 pg8::gemm_phase<EpiUZ, SchedGrid, GP_ALIGN, GP_SP2>(F.lds, DM, DM, DM, S, E); PE(22); } SEAM(2); PE(42);
    if (IN(3)) REP(3) { PB(23); PB(43); SchedCDFT S{(const bf16*)(F.ws + WS_D256), U, F.G, F.bx}; EpiCDFT E{T, (bf16*)(F.ws + WS_NYQ)};
                 pg8::gemm_phase<EpiCDFT, SchedCDFT, GP_ALIGN, GP_SP2>(F.lds, 256, 256, FW, S, E); PE(23); } SEAM(3); PE(43);
    if (IN(4)) REP(4) { PB(24); PB(44); p4_nyquist(F);
                 { SchedLDFT S{(const bf16*)(F.ws + WS_A4S), T, 1, F.G, F.bx}; EpiLDFT E{Z, U, 1.0f / 512.0f};
                   pg8::gemm_phase<EpiLDFT, SchedLDFT, GP_ALIGN, GP_SP2>(F.lds, 2 * LSA, 2 * LSA, 2 * LSA, S, E); }
                 { SchedLDFT S{(const bf16*)(F.ws + WS_A4P), T, 0, F.G, F.bx}; EpiLDFT E{Z, U, 1.0f / 256.0f};
                   pg8::gemm_phase<EpiLDFT, SchedLDFT, GP_ALIGN, GP_SP2>(F.lds, 2 * LPR, 2 * LPR, 2 * LPR, S, E); } PE(24); } SEAM(4); PE(44);
    if (IN(5)) REP(5) { PB(25); PB(45); SchedGrid S{U, (const bf16*)(F.ws + WS_WFO), 64, 8, FW, FW, F.G, F.bx}; EpiRes0 E{F.ap->in[0], F.ap->in[1], (const float*)(F.ws + WS_POS), mod, V};
                 pg8::gemm_phase<EpiRes0, SchedGrid, GP_ALIGN, GP_SP2>(F.lds, FW, FW, FW, S, E); PE(25); } SEAM(5); PE(45);
    if (IN(6)) REP(6) { PB(26); PB(46); p6_ln_ln_mod(F); PE(26); } SEAM(6); PE(46);
    if (IN(7)) REP(7) { PB(27); PB(47); SchedGrid S{H, (const bf16*)(F.ws + WS_WSI), 64, 40, DM, DM, F.G, F.bx}; EpiProj E{Z, (bf16*)(F.ws + WS_XBC), (float*)(F.ws + WS_DT)};
                 pg8::gemm_phase<EpiProj, SchedGrid, GP_ALIGN, GP_SP2>(F.lds, DM, DM, DM, S, E); PE(27); } SEAM(7); PE(47);
    if (IN(8)) REP(8) { PB(28); PB(48);
        const bool dtw = (F.G == 256) && F.bx < 64;
        if (F.G != 256 || dtw) { SchedOne S{H, (const bf16*)(F.ws + WS_WSI), 0, 40, DM, DM}; EpiProj E{Z, (bf16*)(F.ws + WS_XBC), (float*)(F.ws + WS_DT)};
            if (F.G == 256) { S.pm = F.bx; pg8::gemm_phase<EpiProj, SchedOne, GP_ALIGN, GP_SP2>(F.lds, DM, DM, DM, S, E); }
            else for (int pm = F.bx; pm < 64; pm += F.G) { S.pm = pm; pg8::gemm_phase<EpiProj, SchedOne, GP_ALIGN, GP_SP2>(F.lds, DM, DM, DM, S, E); } }
        p8_conv(F); PE(28); } SEAM(8); PE(48);
    if (IN(9)) REP(9) { PB(29); PB(49); PB(1); scan::phase(F); PE(1); PE(29); } SEAM(9); PE(49);
    if (IN(10)) REP(10) { PB(30); PB(50); SchedGrid S{(const bf16*)(F.ws + WS_Y), (const bf16*)(F.ws + WS_WSO), 64, 8, FW, FW, F.G, F.bx}; EpiRes1 E{mod + 9 * 6144, (const float*)(F.ws + WS_SSQ), V};
                  pg8::gemm_phase<EpiRes1, SchedGrid, GP_ALIGN, GP_SP2>(F.lds, FW, FW, FW, S, E); PE(30); } SEAM(10); PE(50);
    if (IN(11)) REP(11) { PB(31); p11_final_ln(F); PE(31); }
    if (PROF_ID != 0 && F.bx == 0 && F.tid < 64) { const unsigned long long t0 = __builtin_amdgcn_s_memrealtime(), want = F.pacc * PROF_K;
        while (__builtin_amdgcn_s_memrealtime() - t0 < want) __builtin_amdgcn_s_sleep(8); }
#undef IN
#undef SEAM
}


extern "C" void kernel_launch(void* const* d_in, const int* in_sizes, int n_in, void* d_out, int out_size, void* d_ws, size_t ws_size, hipStream_t stream) {
    static int grid = 0;
    if (grid == 0) {
        int dev = 0, cus = 0;
        if (n_in != 19 || ws_size < WS_END || out_size != NTOK * DM + NBP * 2 * 64 * 64 * 128) { fprintf(stderr, "kernel_launch: unexpected shapes (n_in %d, ws %zu, out %d)\n", n_in, ws_size, out_size); grid = -1; return; }
        if (hipGetDevice(&dev) != hipSuccess || hipDeviceGetAttribute(&cus, hipDeviceAttributeMultiprocessorCount, dev) != hipSuccess) { grid = -1; return; }
        if (hipFuncSetAttribute((const void*)fwd_kernel, hipFuncAttributeMaxDynamicSharedMemorySize, LDS_BYTES) != hipSuccess) { fprintf(stderr, "kernel_launch: hipFuncSetAttribute failed\n"); grid = -1; return; }
        grid = cus;
    }
    if (grid < 0) return;
    (void)hipMemsetAsync((char*)d_ws + WS_CTL, 0, CTL_ZERO_BYTES, stream);
    Args a{};
    for (int i = 0; i < 19; ++i) a.in[i] = (const float*)d_in[i];
    a.out = (float*)d_out; a.ws = (unsigned char*)d_ws;
#if MK_PER_PHASE || MK_CHECK
    for (int p = 0; p < NPHASE; ++p) { a.ph_lo = p; a.ph_hi = p + 1; hipLaunchKernelGGL(fwd_kernel, dim3(grid), dim3(NTHR), LDS_BYTES, stream, a);
#if MK_CHECK
        check_after_phase(p, a, stream);
#endif
    }
#if MK_CHECK
    check_report(a, stream);
#endif
#else
    a.ph_lo = 0; a.ph_hi = NPHASE;
    hipLaunchKernelGGL(fwd_kernel, dim3(grid), dim3(NTHR), LDS_BYTES, stream, a);
#endif
}
```

```cpp
#include <hip/hip_runtime.h>
#include <cstdio>
#include <cstdint>

#ifndef MK_PER_PHASE
#define MK_PER_PHASE 0
#endif
#ifndef MK_CHECK
#define MK_CHECK 0
#endif

#define GAS __attribute__((address_space(1)))
#define LAS __attribute__((address_space(3)))
typedef unsigned short bf16;
typedef unsigned v4u __attribute__((ext_vector_type(4)));
typedef unsigned v2u __attribute__((ext_vector_type(2)));
typedef float f32x4 __attribute__((ext_vector_type(4)));
typedef short bf16x8 __attribute__((ext_vector_type(8)));
#define LDS_WAIT() asm volatile("s_waitcnt lgkmcnt(0)" ::: "memory")
#define VM_WAIT() asm volatile("s_waitcnt vmcnt(0)" ::: "memory")

constexpr int NWAVES = 8, NTHR = 512;
constexpr int DM = 2048, NTOK = 16384, NPR = 8192, LPR = 256, LSA = 1024, NBP = 32, NBS = 8;
constexpr int FW = 4096;
constexpr int SSD_IN = 10368, SSD_IN_PAD = 10496, CONVD = 6144;
constexpr float LN_EPS = 1e-5f;
constexpr float DN_ALPHA = 1.41421356237f;
constexpr int NPHASE = 12;

constexpr size_t MiB = 1u << 20;
constexpr size_t WS_CTL = 0, WS_MOD = 1 * MiB, WS_SSQ = 1 * MiB + 512 * 1024, CTL_ZERO_BYTES = 2 * MiB;
constexpr size_t WS_D256 = 2 * MiB, WS_NYQ = 2 * MiB + 512 * 1024, WS_A4P = 3 * MiB, WS_A4S = 4 * MiB, WS_POS = 8 * MiB;
constexpr size_t WS_WFI = 16 * MiB, WS_WFO = 48 * MiB, WS_WSI = 64 * MiB, WS_WSO = 106 * MiB;
constexpr size_t WS_DT = 122 * MiB;
constexpr size_t WS_H = 132 * MiB, WS_U = 196 * MiB, WS_Z = 324 * MiB, WS_T = 452 * MiB, WS_V = 708 * MiB, WS_Y = 836 * MiB, WS_END = 996 * MiB;
constexpr size_t WS_XBC = WS_T, WS_BN = 644 * MiB, WS_CN = 676 * MiB, WS_XT = WS_U, WS_BT = 964 * MiB;
constexpr int CW_BAR = 4096;

constexpr int LDS_BYTES = 163840;
constexpr int MISC_OFF = LDS_BYTES - 256;

__device__ __forceinline__ unsigned f2bf(float f) { unsigned u = __builtin_bit_cast(unsigned, f); return (u + 0x7fffu + ((u >> 16) & 1u)) >> 16; }
typedef __bf16 bf2_t __attribute__((ext_vector_type(2)));
typedef float f32x2_t __attribute__((ext_vector_type(2)));
__device__ __forceinline__ unsigned pk2(float lo, float hi) { const f32x2_t v = {lo, hi}; return __builtin_bit_cast(unsigned, __builtin_convertvector(v, bf2_t)); }
__device__ __forceinline__ float bf_lo(unsigned w) { return __builtin_bit_cast(float, w << 16); }
__device__ __forceinline__ float bf_hi(unsigned w) { return __builtin_bit_cast(float, w & 0xffff0000u); }
__device__ __forceinline__ float bf2f(bf16 b) { return __builtin_bit_cast(float, ((unsigned)b) << 16); }
__device__ __forceinline__ float silu_f(float x) { return x / (1.f + __expf(-x)); }
__device__ __forceinline__ float wave_sum(float v) {
#pragma unroll
    for (int o = 1; o < 64; o <<= 1) v += __shfl_xor(v, o);
    return v;
}

#define XB_TMO      128
#define XB_XCNT(j)  (256  + 64 * (j))
#define XB_XSUB(j)  (1280 + 64 * (j))
#define XB_XGEN(j)  (2304 + 64 * (j))
#define XB_TOP      3328
#define XB_TOPGEN   3392
#define XCD_BAR_WORDS 3456
#define XB_SPIN_CAP (1u << 20)
__device__ __forceinline__ unsigned xb_ld(unsigned* p)              { return __hip_atomic_load(p, __ATOMIC_RELAXED, __HIP_MEMORY_SCOPE_AGENT); }
__device__ __forceinline__ unsigned xb_add(unsigned* p, unsigned v) { return __hip_atomic_fetch_add(p, v, __ATOMIC_RELAXED, __HIP_MEMORY_SCOPE_AGENT); }
__device__ __forceinline__ unsigned xb_xcc_id() { return (unsigned)__builtin_amdgcn_s_getreg((3 << 11) | 20) & 0xFu; }
#define XB_SPIN(cond, bar) do { unsigned _sp = 0; while (cond) { __builtin_amdgcn_s_sleep(1); \
    if ((++_sp & 255u) == 0u) { if (xb_ld(&(bar)[XB_TMO])) break; if (_sp > XB_SPIN_CAP) { atomicAdd(&(bar)[XB_TMO], 1u); break; } } } } while (0)
struct XcdBarrier { unsigned* bar; unsigned x; volatile LAS unsigned* st; };
__device__ __forceinline__ XcdBarrier xcd_barrier_post(unsigned* bar, volatile LAS unsigned* st) {
    XcdBarrier b; b.bar = bar; b.x = xb_xcc_id(); b.st = st;
    if (threadIdx.x == 0) (void)xb_add(&bar[XB_XCNT(b.x)], 1u);
    return b;
}
__device__ __forceinline__ void xcd_barrier_complete(unsigned* bar, unsigned x, unsigned& nloc, unsigned& nx) {
    const unsigned G = gridDim.x * gridDim.y * gridDim.z;
    unsigned sum, cnt, mine, sp = 0u;
    for (;;) {
        sum = 0u; cnt = 0u; mine = 0u;
#pragma unroll
        for (unsigned j = 0; j < 16; ++j) { const unsigned c = xb_ld(&bar[XB_XCNT(j)]); sum += c; cnt += (c > 0u) ? 1u : 0u; mine = (j == x) ? c : mine; }
        if (sum == G) break;
        __builtin_amdgcn_s_sleep(1);
        if ((++sp & 255u) == 0u) { if (xb_ld(&bar[XB_TMO])) break; if (sp > XB_SPIN_CAP) { atomicAdd(&bar[XB_TMO], 1u); break; } }
    }
    nloc = mine > 0u ? mine : 1u; nx = cnt > 0u ? cnt : 1u;
}
__device__ __forceinline__ void xcd_barrier(const XcdBarrier& b) {
    asm volatile("s_waitcnt vmcnt(0)" ::: "memory");
    __syncthreads();
    if (threadIdx.x == 0) {
        unsigned* bar = b.bar;
        __builtin_amdgcn_s_waitcnt(0);
        unsigned nloc = b.st[0], nx = b.st[1];
        if (nloc == 0u) { xcd_barrier_complete(bar, b.x, nloc, nx); b.st[0] = nloc; b.st[1] = nx; }
        const unsigned old = xb_add(&bar[XB_XSUB(b.x)], 1u);
        const unsigned gen = old / nloc;
        if (old + 1u == (gen + 1u) * nloc) {
            __builtin_amdgcn_fence(__ATOMIC_RELEASE, "agent");
            asm volatile("s_waitcnt vmcnt(0)" ::: "memory");
            const unsigned og = xb_add(&bar[XB_TOP], 1u);
            const unsigned tg = og / nx;
            if (og + 1u == (tg + 1u) * nx) xb_add(&bar[XB_TOPGEN], 1u);
            else XB_SPIN(xb_ld(&bar[XB_TOPGEN]) == tg, bar);
            __builtin_amdgcn_fence(__ATOMIC_ACQUIRE, "agent");
            xb_add(&bar[XB_XGEN(b.x)], 1u);
            asm volatile("s_waitcnt vmcnt(0)" ::: "memory");
        } else {
            XB_SPIN(xb_ld(&bar[XB_XGEN(b.x)]) == gen, bar);
            __builtin_amdgcn_fence(__ATOMIC_ACQUIRE, "agent");
            asm volatile("s_waitcnt vmcnt(0)" ::: "memory");
        }
    }
    __syncthreads();
}

struct Args { const float* in[19]; float* out; unsigned char* ws; int ph_lo, ph_hi; };
#ifndef PROF_ID
#define PROF_ID 0
#endif
#ifndef PROF_K
#define PROF_K 1
#endif
#define PB(id) do { if (PROF_ID == (id)) { F.pt0 = __builtin_amdgcn_s_memrealtime(); } } while (0)
#define PE(id) do { if (PROF_ID == (id)) { F.pacc += __builtin_amdgcn_s_memrealtime() - F.pt0; } } while (0)
#ifndef ABL
#define ABL 0
#endif
struct Frame {
    unsigned long long pacc, pt0; int abl;
    LAS unsigned char* lds;
    int tid, lane, wave, G, bx;
    const Args* ap;
    float* out; unsigned char* ws;
};
__device__ __forceinline__ int row0_of(int bb) { return bb < NBP ? bb * LPR : NPR + (bb - NBP) * LSA; }
__host__ __device__ __forceinline__ int k2_of_pos(int p) { return p <= 128 ? p : 384 - p; }
__device__ __forceinline__ size_t tb_of(int bb) { return bb < NBP ? (size_t)bb * 2048 * 2 * LPR : (size_t)NBP * 2048 * 2 * LPR + (size_t)(bb - NBP) * 2048 * 2 * LSA; }
__device__ __forceinline__ size_t nyq_of(int bb) { return bb < NBP ? (size_t)bb * 16 * LPR : (size_t)NBP * 16 * LPR + (size_t)(bb - NBP) * 16 * LSA; }
__device__ __forceinline__ int cond_of_row(int r) { return r < NPR ? 0 : 1 + (r - NPR) / LSA; }

namespace pg8 {
constexpr int BM = 256, BK = 64, HALF = 128, HTB = HALF * BK * 2, NXCD = 8, WGM = 8;
__host__ __device__ __forceinline__ int lds_byte(int r, int c) { const int st = (r >> 4) * 2 + (c >> 5), rr = r & 15, cc = c & 31, ob = rr * 64 + cc * 2; return st * 1024 + (ob ^ (((ob >> 9) & 1) << 5)); }
__host__ __device__ __forceinline__ void stage_rc(int b, int& R, int& C) { const int st = b / 1024, sb = b % 1024, swz = sb ^ (((sb >> 9) & 1) << 5); R = (st >> 1) * 16 + swz / 64; C = (st & 1) * 32 + (swz % 64) / 2; }
__host__ __device__ __forceinline__ int perm32(int rho) { const int n = rho >> 4, i = rho & 15; return 8 * (i >> 2) + 4 * n + (i & 3); }
struct Unit { const char* a; const char* b; int x0, x1; };
typedef f32x4 Acc[2][2][4][2];

__device__ __forceinline__ bool static_tile(int i, int G, int c, int nM, int nN, int& pm, int& pn) {
    const int nwg = nM * nN; const long L = (long)i * G + c; if (L >= nwg) return false;
    int wgid = (int)L; { const int q = nwg / NXCD, r = nwg % NXCD, xcd = wgid % NXCD, off = wgid / NXCD; wgid = (xcd < r ? xcd * (q + 1) : r * (q + 1) + (xcd - r) * q) + off; }
    const int nig = WGM * nN, gid = wgid / nig, fm = gid * WGM, gsz = (nM - fm) < WGM ? (nM - fm) : WGM;
    pm = fm + ((wgid % nig) % gsz); pn = (wgid % nig) / gsz; return true;
}

template <class Epi, class Sched, bool ALIGN_EPI, bool SP2>
__device__ __forceinline__ void gemm_phase(LAS unsigned char* lds, const int K, const int lda, const int ldb, const Sched& S, const Epi& E) {
    const int tid = threadIdx.x, wid = __builtin_amdgcn_readfirstlane(tid >> 6), lane = tid & 63, wr = wid >> 2, wc = wid & 3, fr = lane & 15, fq = lane >> 4;
    const int nt = K / BK;
    unsigned voffA[2], voffB[2];
#pragma unroll
    for (int i = 0; i < 2; ++i) { int R, C; stage_rc(tid * 16 + i * 8192, R, C); const int Rb = Epi::PERM ? ((R & ~31) + perm32(R & 31)) : R;
        voffA[i] = (unsigned)(R * lda + C) * 2u; voffB[i] = (unsigned)(Rb * ldb + C) * 2u; }
    const size_t kstep = (size_t)(BK * 2);
    const size_t hstepA = (size_t)HALF * lda * 2, hstepB = (size_t)HALF * ldb * 2;
    const unsigned ldsw = (unsigned)wid * 1024u;
    const int aoff = lds_byte(wr * 64 + fr, fq * 8), boff = lds_byte(wc * 32 + fr, fq * 8);
#define PG8_SA(b, h) (((b) * 2 + (h)) * HTB)
#define PG8_SB(b, h) ((4 + (b) * 2 + (h)) * HTB)
#define PG8_STAGE(bufoff, gbase, voff) do { _Pragma("unroll") for (int _i = 0; _i < 2; ++_i) \
        __builtin_amdgcn_global_load_lds((const unsigned*)((const char*)(gbase) + (voff)[_i]), (LAS unsigned*)(lds + (bufoff) + ldsw + _i * 8192), 16, 0, 0); } while (0)
#define PG8_LDA(dst, b, h) do { _Pragma("unroll") for (int m = 0; m < 4; ++m) _Pragma("unroll") for (int k = 0; k < 2; ++k) dst[m][k] = *(const LAS bf16x8*)(lds + PG8_SA(b, h) + aoff + m * 2048 + k * 1024); } while (0)
#define PG8_LDB(dst, b, h) do { _Pragma("unroll") for (int n = 0; n < 2; ++n) _Pragma("unroll") for (int k = 0; k < 2; ++k) dst[n][k] = *(const LAS bf16x8*)(lds + PG8_SB(b, h) + boff + n * 2048 + k * 1024); } while (0)
#define PG8_MMA(ai, bj, At, Bt) do { __builtin_amdgcn_s_setprio(1); _Pragma("unroll") for (int m = 0; m < 4; ++m) _Pragma("unroll") for (int n = 0; n < 2; ++n) _Pragma("unroll") for (int k = 0; k < 2; ++k) \
        acc[ai][bj][m][n] = __builtin_amdgcn_mfma_f32_16x16x32_bf16(Bt[n][k], At[m][k], acc[ai][bj][m][n], 0, 0, 0); __builtin_amdgcn_s_setprio(0); } while (0)
#define PG8_WAIT_V(n) asm volatile("s_waitcnt vmcnt(" #n ")" ::: "memory")
#define PG8_WAIT_L(n) asm volatile("s_waitcnt lgkmcnt(" #n ")" ::: "memory")
#define PG8_BAR __builtin_amdgcn_s_barrier()
#define PG8_SCHED __builtin_amdgcn_sched_barrier(0)
    Unit cur, nxt; int ui = 0;
    if (!S.next(0, cur)) return;
    Acc acc;
#pragma unroll
    for (int a = 0; a < 2; ++a)
#pragma unroll
        for (int b = 0; b < 2; ++b)
#pragma unroll
            for (int m = 0; m < 4; ++m)
#pragma unroll
                for (int n = 0; n < 2; ++n) acc[a][b][m][n] = (f32x4){0.f, 0.f, 0.f, 0.f};
    bf16x8 At[4][2], B0[2][2], B1[2][2];
    const char* cA = cur.a; const char* cB = cur.b;
    if constexpr (SP2) {
        PG8_STAGE(PG8_SB(0, 0), cB, voffB); PG8_STAGE(PG8_SB(0, 1), cB + hstepB, voffB); PG8_STAGE(PG8_SA(0, 0), cA, voffA); PG8_STAGE(PG8_SA(0, 1), cA + hstepA, voffA);
        if (wr == 1) PG8_BAR;
        PG8_WAIT_V(2); PG8_BAR;
        PG8_STAGE(PG8_SB(1, 0), cB + kstep, voffB); PG8_STAGE(PG8_SA(1, 0), cA + kstep, voffA); PG8_STAGE(PG8_SB(1, 1), cB + hstepB + kstep, voffB);
        PG8_WAIT_V(6); PG8_BAR;
    } else {
        PG8_STAGE(PG8_SB(0, 0), cB, voffB); PG8_STAGE(PG8_SA(0, 0), cA, voffA); PG8_STAGE(PG8_SB(0, 1), cB + hstepB, voffB); PG8_STAGE(PG8_SA(0, 1), cA + hstepA, voffA);
        if (wr == 1) PG8_BAR;
        PG8_WAIT_V(4); PG8_BAR;
        PG8_STAGE(PG8_SB(1, 0), cB + kstep, voffB); PG8_STAGE(PG8_SA(1, 0), cA + kstep, voffA); PG8_STAGE(PG8_SB(1, 1), cB + hstepB + kstep, voffB);
        PG8_WAIT_V(6); PG8_BAR;
    }
    for (;;) {
        const bool has_next = S.next(ui + 1, nxt);
        const char* nA = has_next ? nxt.a : cA; const char* nB = has_next ? nxt.b : cB;
#pragma unroll 1
        for (int t = 0; t < nt; t += 2) {
            const bool last = (t == nt - 2);
            const char* a1 = cA + (size_t)(t + 1) * kstep;
            const char* a2 = last ? nA : cA + (size_t)(t + 2) * kstep; const char* b2 = last ? nB : cB + (size_t)(t + 2) * kstep;
            const char* a3 = a2 + kstep; const char* b3 = b2 + kstep;
            if constexpr (SP2) {
            PG8_LDB(B0, 0, 0); PG8_LDB(B1, 0, 1); PG8_SCHED; PG8_LDA(At, 0, 0); PG8_STAGE(PG8_SA(1, 1), a1 + hstepA, voffA);
            PG8_WAIT_V(8); PG8_WAIT_L(0); PG8_BAR; PG8_MMA(0, 0, At, B0); PG8_MMA(0, 1, At, B1); PG8_BAR; PG8_SCHED;
            PG8_LDA(At, 0, 1); PG8_STAGE(PG8_SB(0, 0), b2, voffB); PG8_STAGE(PG8_SB(0, 1), b2 + hstepB, voffB); PG8_STAGE(PG8_SA(0, 0), a2, voffA);
            PG8_WAIT_V(8); PG8_WAIT_L(0); PG8_BAR; PG8_MMA(1, 0, At, B0); PG8_MMA(1, 1, At, B1); PG8_BAR; PG8_SCHED;
            PG8_LDB(B0, 1, 0); PG8_LDB(B1, 1, 1); PG8_SCHED; PG8_LDA(At, 1, 0); PG8_STAGE(PG8_SA(0, 1), a2 + hstepA, voffA);
            PG8_WAIT_V(8); PG8_WAIT_L(0); PG8_BAR; PG8_MMA(0, 0, At, B0); PG8_MMA(0, 1, At, B1); PG8_BAR; PG8_SCHED;
            PG8_LDA(At, 1, 1); PG8_STAGE(PG8_SB(1, 0), b3, voffB); PG8_STAGE(PG8_SB(1, 1), b3 + hstepB, voffB); PG8_STAGE(PG8_SA(1, 0), a3, voffA);
            PG8_WAIT_V(8); PG8_WAIT_L(0); PG8_BAR; PG8_MMA(1, 0, At, B0); PG8_MMA(1, 1, At, B1); PG8_BAR; PG8_SCHED;
            } else {
            PG8_LDB(B0, 0, 0); PG8_SCHED; PG8_LDA(At, 0, 0); PG8_STAGE(PG8_SA(1, 1), a1 + hstepA, voffA);
            PG8_WAIT_L(8); PG8_BAR; PG8_WAIT_L(0); PG8_MMA(0, 0, At, B0); PG8_BAR; PG8_SCHED;
            PG8_LDB(B1, 0, 1); PG8_STAGE(PG8_SB(0, 0), b2, voffB);
            PG8_BAR; PG8_WAIT_L(0); PG8_MMA(0, 1, At, B1); PG8_BAR;
            PG8_LDA(At, 0, 1); PG8_STAGE(PG8_SA(0, 0), a2, voffA);
            PG8_BAR; PG8_WAIT_L(0); PG8_MMA(1, 0, At, B0); PG8_BAR; PG8_SCHED;
            PG8_STAGE(PG8_SB(0, 1), b2 + hstepB, voffB);
            PG8_WAIT_V(6); PG8_BAR; PG8_MMA(1, 1, At, B1); PG8_BAR;
            PG8_LDB(B0, 1, 0); PG8_SCHED; PG8_LDA(At, 1, 0); PG8_STAGE(PG8_SA(0, 1), a2 + hstepA, voffA);
            PG8_WAIT_L(8); PG8_BAR; PG8_WAIT_L(0); PG8_MMA(0, 0, At, B0); PG8_BAR; PG8_SCHED;
            PG8_LDB(B1, 1, 1); PG8_STAGE(PG8_SB(1, 0), b3, voffB);
            PG8_BAR; PG8_WAIT_L(0); PG8_MMA(0, 1, At, B1); PG8_BAR;
            PG8_LDA(At, 1, 1); PG8_STAGE(PG8_SA(1, 0), a3, voffA);
            PG8_BAR; PG8_WAIT_L(0); PG8_MMA(1, 0, At, B0); PG8_BAR; PG8_SCHED;
            PG8_STAGE(PG8_SB(1, 1), b3 + hstepB, voffB);
            PG8_WAIT_V(6); PG8_BAR; PG8_MMA(1, 1, At, B1); PG8_BAR;
            }
        }
        if constexpr (ALIGN_EPI) { if (wr == 0) PG8_BAR; }
        E(acc, cur, wr, wc, fr, fq);
        if (!has_next) break;
#pragma unroll
        for (int a = 0; a < 2; ++a)
#pragma unroll
            for (int b = 0; b < 2; ++b)
#pragma unroll
                for (int m = 0; m < 4; ++m)
#pragma unroll
                    for (int n = 0; n < 2; ++n) acc[a][b][m][n] = (f32x4){0.f, 0.f, 0.f, 0.f};
        cur = nxt; cA = nA; cB = nB; ++ui;
        if constexpr (ALIGN_EPI) { if (wr == 1) PG8_BAR; }
    }
    PG8_WAIT_V(0);
    if constexpr (!ALIGN_EPI) { if (wr == 0) PG8_BAR; }
    PG8_BAR;
#undef PG8_SA
#undef PG8_SB
#undef PG8_STAGE
#undef PG8_LDA
#undef PG8_LDB
#undef PG8_MMA
#undef PG8_WAIT_V
#undef PG8_WAIT_L
#undef PG8_BAR
#undef PG8_SCHED
}
}
using pg8::Unit; using pg8::Acc;
constexpr bool GP_ALIGN = true, GP_SP2 = true;

struct SchedGrid {
    const bf16* A; const bf16* B; int nM, nN, lda, ldb, G, c;
    __device__ __forceinline__ bool next(int i, Unit& u) const { int pm, pn; if (!pg8::static_tile(i, G, c, nM, nN, pm, pn)) return false;
        u.a = (const char*)(A + (size_t)pm * 256 * lda); u.b = (const char*)(B + (size_t)pn * 256 * ldb); u.x0 = pm; u.x1 = pn; return true; }
};
struct SchedOne {
    const bf16* A; const bf16* B; int pm, pn, lda, ldb;
    __device__ __forceinline__ bool next(int i, Unit& u) const { if (i != 0 || pm < 0) return false;
        u.a = (const char*)(A + (size_t)pm * 256 * lda); u.b = (const char*)(B + (size_t)pn * 256 * ldb); u.x0 = pm; u.x1 = pn; return true; }
};
struct EpiUZ { static constexpr bool PERM = true; bf16* U; bf16* Z;
    __device__ __forceinline__ void operator()(const Acc& acc, const Unit& u, int wr, int wc, int fr, int fq) const {
        const int pm = u.x0, pn = u.x1; const bool isz = pn >= 16; bf16* base = isz ? Z : U; const int colt = (isz ? pn - 16 : pn) * 256 + wc * 32 + 8 * fq;
#pragma unroll
        for (int ai = 0; ai < 2; ++ai)
#pragma unroll
            for (int m = 0; m < 4; ++m) { const int r = pm * 256 + ai * 128 + wr * 64 + m * 16 + fr; bf16* rowp = base + (size_t)r * FW + colt;
#pragma unroll
                for (int bj = 0; bj < 2; ++bj) { f32x4 v0 = acc[ai][bj][m][0], v1 = acc[ai][bj][m][1];
                    if (isz) {
#pragma unroll
                        for (int j = 0; j < 4; ++j) { v0[j] = silu_f(v0[j]); v1[j] = silu_f(v1[j]); } }
                    v4u w; w.x = pk2(v0[0], v0[1]); w.y = pk2(v0[2], v0[3]); w.z = pk2(v1[0], v1[1]); w.w = pk2(v1[2], v1[3]);
                    *(v4u*)(rowp + bj * 128) = w; } }
    } };
struct SchedCDFT { const bf16* D; const bf16* U; int G, c;
    __device__ __forceinline__ bool next(int i, Unit& u) const { const long e = (long)i * G + c; if (e >= 1024) return false;
        const int q = (int)e; int bb, g, tn;
        if (q < 512) { bb = q >> 4; g = q & 15; tn = 0; } else { const int q2 = q - 512; bb = NBP + (q2 >> 6); g = (q2 >> 2) & 15; tn = q2 & 3; }
        u.a = (const char*)D; u.b = (const char*)(U + ((size_t)(row0_of(bb) + tn * 256) * FW + g * 256));
        u.x0 = bb | (g << 8) | (tn << 20); u.x1 = 0; return true; } };
struct EpiCDFT { static constexpr bool PERM = true; bf16* T; bf16* NYQ;
    __device__ __forceinline__ void operator()(const Acc& acc, const Unit& u, int wr, int wc, int fr, int fq) const {
        const int bb = u.x0 & 255, g = (u.x0 >> 8) & 255, tn = u.x0 >> 20; const int L = bb < NBP ? LPR : LSA;
        bf16* base = T + tb_of(bb) + (size_t)(g * 128) * (2 * L) + tn * 256;
        bf16* nq = NYQ + nyq_of(bb) + (size_t)g * L + tn * 256;
        const unsigned L2 = 2u * (unsigned)L; const unsigned coff = (unsigned)(wc * 32 + 8 * fq);
#pragma unroll
        for (int ai = 0; ai < 2; ++ai)
#pragma unroll
            for (int m = 0; m < 4; ++m) { const int k2 = wr * 64 + m * 16 + fr;
                const unsigned off = (unsigned)k2 * L2 + (unsigned)(ai * L) + coff; const bool nyq = (ai == 1) && (k2 == 0);
#pragma unroll
                for (int bj = 0; bj < 2; ++bj) { const f32x4 v0 = acc[ai][bj][m][0], v1 = acc[ai][bj][m][1];
                    v4u w; w.x = pk2(v0[0], v0[1]); w.y = pk2(v0[2], v0[3]); w.z = pk2(v1[0], v1[1]); w.w = pk2(v1[2], v1[3]);
                    if (nyq) { *(v4u*)(nq + coff + bj * 128) = w; w = (v4u){0u, 0u, 0u, 0u}; }
                    *(v4u*)(base + off + bj * 128) = w; }
                asm volatile("" ::: "memory"); }
    } };
struct SchedLDFT { const bf16* A4; const bf16* T; int sample, G, c;
    __device__ __forceinline__ bool next(int i, Unit& u) const { const long e = (long)i * G + c; if (e >= 256) return false; int bb, pm, pn;
        if (sample) { bb = NBP + ((int)e >> 5); pm = ((int)e >> 3) & 3; pn = (int)e & 7; } else { bb = (int)e >> 3; pm = 0; pn = (int)e & 7; }
        const int L2 = sample ? 2 * LSA : 2 * LPR;
        u.a = (const char*)(A4 + (size_t)pm * 256 * L2); u.b = (const char*)(T + tb_of(bb) + (size_t)pn * 256 * L2);
        u.x0 = bb | (pm << 8); u.x1 = pn; return true; } };
struct EpiLDFT { static constexpr bool PERM = true; const bf16* Z; bf16* YG; float sc;
    __device__ __forceinline__ void operator()(const Acc& acc, const Unit& u, int wr, int wc, int fr, int fq) const {
        const int bb = u.x0 & 255, pm = u.x0 >> 8, pn = u.x1; const int L = bb < NBP ? LPR : LSA, r0 = row0_of(bb);
        const int k2 = wc * 32 + 8 * fq;
#pragma unroll
        for (int ai = 0; ai < 2; ++ai)
#pragma unroll
            for (int m = 0; m < 4; ++m) { const int k1 = pm * 256 + ai * 128 + wr * 64 + m * 16 + fr; const int k1m = (L - k1) & (L - 1);
                const size_t od = (size_t)(r0 + k1) * FW + k2, om = (size_t)(r0 + k1m) * FW + 128 + k2;
#pragma unroll
                for (int bj = 0; bj < 2; ++bj) { const f32x4 v0 = acc[ai][bj][m][0] * sc, v1 = acc[ai][bj][m][1] * sc; const int gc = (2 * pn + bj) * 256;
                    { const v4u z = *(const v4u*)(Z + od + gc);
                      v4u w; w.x = pk2(v0[0] * bf_lo(z.x), v0[1] * bf_hi(z.x)); w.y = pk2(v0[2] * bf_lo(z.y), v0[3] * bf_hi(z.y));
                      w.z = pk2(v1[0] * bf_lo(z.z), v1[1] * bf_hi(z.z)); w.w = pk2(v1[2] * bf_lo(z.w), v1[3] * bf_hi(z.w));
                      *(v4u*)(YG + od + gc) = w; }
                    { const v4u z = *(const v4u*)(Z + om + gc);
                      v4u w; w.x = pk2(v0[0] * bf_lo(z.x), v0[1] * bf_hi(z.x)); w.y = pk2(v0[2] * bf_lo(z.y), v0[3] * bf_hi(z.y));
                      w.z = pk2(v1[0] * bf_lo(z.z), v1[1] * bf_hi(z.z)); w.w = pk2(v1[2] * bf_lo(z.w), v1[3] * bf_hi(z.w));
                      bf16* d = YG + om + gc;
                      if (k2 != 0) *(v4u*)d = w;
                      else { d[1] = (bf16)(w.x >> 16); *(unsigned*)(d + 2) = w.y; *(v2u*)(d + 4) = (v2u){w.z, w.w}; } }
                }
                asm volatile("" ::: "memory"); }
    } };
struct EpiRes0 { static constexpr bool PERM = true; const float* xp; const float* xs; const float* pos; const float* mod0; bf16* V;
    __device__ __forceinline__ void operator()(const Acc& acc, const Unit& u, int wr, int wc, int fr, int fq) const {
        const int pm = u.x0, pn = u.x1; const int rt = pm * 256; const bool smp = rt >= NPR;
        const float* gate = mod0 + (size_t)cond_of_row(rt) * 6144 + 4096;
        const int col0 = pn * 256 + wc * 32 + 8 * fq;
        f32x4 gv[2][2];
#pragma unroll
        for (int bj = 0; bj < 2; ++bj)
#pragma unroll
            for (int n = 0; n < 2; ++n) gv[bj][n] = *(const f32x4*)(gate + col0 + bj * 128 + n * 4);
#pragma unroll
        for (int ai = 0; ai < 2; ++ai)
#pragma unroll
            for (int mp = 0; mp < 2; ++mp) { f32x4 x0[2][2][2], pv[2][2][2];
#pragma unroll
                for (int mm = 0; mm < 2; ++mm) { const int r = rt + ai * 128 + wr * 64 + (2 * mp + mm) * 16 + fr;
                    const float* xr = smp ? xs + (size_t)(r - NPR) * DM : xp + (size_t)r * DM; const float* pr = pos + (size_t)((r - NPR) & (LSA - 1)) * DM;
#pragma unroll
                    for (int bj = 0; bj < 2; ++bj)
#pragma unroll
                        for (int n = 0; n < 2; ++n) { const int cc = col0 + bj * 128 + n * 4; x0[mm][bj][n] = *(const f32x4*)(xr + cc); pv[mm][bj][n] = smp ? *(const f32x4*)(pr + cc) : (f32x4){0.f, 0.f, 0.f, 0.f}; } }
#pragma unroll
                for (int mm = 0; mm < 2; ++mm) { const int m = 2 * mp + mm; const int r = rt + ai * 128 + wr * 64 + m * 16 + fr;
#pragma unroll
                    for (int bj = 0; bj < 2; ++bj) { const f32x4 v0 = (x0[mm][bj][0] + pv[mm][bj][0]) * DN_ALPHA + gv[bj][0] * acc[ai][bj][m][0], v1 = (x0[mm][bj][1] + pv[mm][bj][1]) * DN_ALPHA + gv[bj][1] * acc[ai][bj][m][1];
                        v4u w; w.x = pk2(v0[0], v0[1]); w.y = pk2(v0[2], v0[3]); w.z = pk2(v1[0], v1[1]); w.w = pk2(v1[2], v1[3]);
                        *(v4u*)(V + (size_t)r * DM + col0 + bj * 128) = w; } }
                asm volatile("" ::: "memory"); }
    } };
struct EpiProj { static constexpr bool PERM = true; bf16* Z; bf16* XBC; float* DT;
    __device__ __forceinline__ void operator()(const Acc& acc, const Unit& u, int wr, int wc, int fr, int fq) const {
        const int pm = u.x0, pn = u.x1;
#pragma unroll
        for (int ai = 0; ai < 2; ++ai)
#pragma unroll
            for (int m = 0; m < 4; ++m) { const int r = pm * 256 + ai * 128 + wr * 64 + m * 16 + fr;
#pragma unroll
                for (int bj = 0; bj < 2; ++bj) { f32x4 v0 = acc[ai][bj][m][0], v1 = acc[ai][bj][m][1]; const int cl = bj * 128 + wc * 32 + 8 * fq;
                    if (pn < 16) {
#pragma unroll
                        for (int j = 0; j < 4; ++j) { v0[j] = silu_f(v0[j]); v1[j] = silu_f(v1[j]); }
                        v4u w; w.x = pk2(v0[0], v0[1]); w.y = pk2(v0[2], v0[3]); w.z = pk2(v1[0], v1[1]); w.w = pk2(v1[2], v1[3]);
                        *(v4u*)(Z + (size_t)r * FW + pn * 256 + cl) = w;
                    } else if (pn < 40) {
                        v4u w; w.x = pk2(v0[0], v0[1]); w.y = pk2(v0[2], v0[3]); w.z = pk2(v1[0], v1[1]); w.w = pk2(v1[2], v1[3]);
                        *(v4u*)(XBC + (size_t)r * CONVD + (pn - 16) * 256 + cl) = w;
                    } else if (bj == 0) {
                        *(f32x4*)(DT + (size_t)r * 128 + cl) = v0; *(f32x4*)(DT + (size_t)r * 128 + cl + 4) = v1;
                    } } }
    } };
struct EpiRes1 { static constexpr bool PERM = true; const float* mod1; const float* SSQ; bf16* V;
    __device__ __forceinline__ void operator()(const Acc& acc, const Unit& u, int wr, int wc, int fr, int fq) const {
        const int pm = u.x0, pn = u.x1; const int rt = pm * 256;
        const float* gate = mod1 + (size_t)cond_of_row(rt) * 6144 + 4096;
        const int col0 = pn * 256 + wc * 32 + 8 * fq;
        f32x4 gv[2][2];
#pragma unroll
        for (int bj = 0; bj < 2; ++bj)
#pragma unroll
            for (int n = 0; n < 2; ++n) gv[bj][n] = *(const f32x4*)(gate + col0 + bj * 128 + n * 4);
#pragma unroll
        for (int ai = 0; ai < 2; ++ai) { v4u x1[4][2]; float ss[4];
#pragma unroll
            for (int m = 0; m < 4; ++m) { const int r = rt + ai * 128 + wr * 64 + m * 16 + fr; ss[m] = SSQ[r];
#pragma unroll
                for (int bj = 0; bj < 2; ++bj) x1[m][bj] = *(const v4u*)(V + (size_t)r * DM + col0 + bj * 128); }
#pragma unroll
            for (int m = 0; m < 4; ++m) { const int r = rt + ai * 128 + wr * 64 + m * 16 + fr; const float rs = 1.0f / sqrtf(ss[m] * (1.0f / FW) + LN_EPS);
#pragma unroll
                for (int bj = 0; bj < 2; ++bj) { const v4u xw = x1[m][bj]; const f32x4 a0 = acc[ai][bj][m][0] * rs, a1 = acc[ai][bj][m][1] * rs;
                    v4u w; w.x = pk2(bf_lo(xw.x) * DN_ALPHA + gv[bj][0][0] * a0[0], bf_hi(xw.x) * DN_ALPHA + gv[bj][0][1] * a0[1]);
                    w.y = pk2(bf_lo(xw.y) * DN_ALPHA + gv[bj][0][2] * a0[2], bf_hi(xw.y) * DN_ALPHA + gv[bj][0][3] * a0[3]);
                    w.z = pk2(bf_lo(xw.z) * DN_ALPHA + gv[bj][1][0] * a1[0], bf_hi(xw.z) * DN_ALPHA + gv[bj][1][1] * a1[1]);
                    w.w = pk2(bf_lo(xw.w) * DN_ALPHA + gv[bj][1][2] * a1[2], bf_hi(xw.w) * DN_ALPHA + gv[bj][1][3] * a1[3]);
                    *(v4u*)(V + (size_t)r * DM + col0 + bj * 128) = w; } }
            asm volatile("" ::: "memory"); }
    } };

template <int MODE>
__device__ __forceinline__ void p0_transpose_item(const float* W, int K, int N, bf16* WT, LAS float* scr, int item, int lane) {
    const int nblk = N / 64, kb = item / nblk, nb = item % nblk, k0 = 64 * kb, n0 = 64 * nb;
    const int c4 = (lane & 15) * 4, r4 = lane >> 4;
    f32x4 v[16];
#pragma unroll
    for (int i = 0; i < 16; ++i) { int kr = k0 + r4 + 4 * i; if (MODE == 2) kr = (kr & ~255) + k2_of_pos(kr & 255);
        v[i] = *(const f32x4*)(W + (size_t)kr * N + n0 + c4); }
#pragma unroll
    for (int i = 0; i < 16; ++i) { LAS float* d = scr + (r4 + 4 * i) * 65 + c4; d[0] = v[i][0]; d[1] = v[i][1]; d[2] = v[i][2]; d[3] = v[i][3]; }
    LDS_WAIT(); asm volatile("" ::: "memory");
    const int c = lane & 7;
#pragma unroll
    for (int j = 0; j < 8; ++j) { const int n = (lane >> 3) + 8 * j; const LAS float* sp = scr + (8 * c) * 65 + n;
        v4u o; o.x = pk2(sp[0 * 65], sp[1 * 65]); o.y = pk2(sp[2 * 65], sp[3 * 65]); o.z = pk2(sp[4 * 65], sp[5 * 65]); o.w = pk2(sp[6 * 65], sp[7 * 65]);
        int nr = n0 + n; if (MODE == 1 && nr >= FW) nr = (nr & ~255) + k2_of_pos(nr & 255);
        *(v4u*)(WT + (size_t)nr * K + k0 + 8 * c) = o; }
    LDS_WAIT(); asm volatile("" ::: "memory");
}
__device__ __forceinline__ void p0_prologue(Frame& F) {
    const int gw = F.bx * NWAVES + F.wave, NGW = F.G * NWAVES;
    const size_t gt = (size_t)F.bx * NTHR + F.tid, NGT = (size_t)F.G * NTHR;
    LAS float* sc = (LAS float*)F.lds;
    for (int i = F.tid; i < 9 * DM; i += NTHR) { const float v = i < DM ? F.ap->in[4][i] : F.ap->in[3][i - DM]; sc[i] = silu_f(v); }
    __syncthreads();
    float* mod = (float*)(F.ws + WS_MOD);
    LAS float* part = (LAS float*)(F.lds + 9 * DM * 4);
    for (int it = F.bx; it < 2 * 96; it += F.G) {
        const int cb = it % 96, layer = it / 96; const int n = cb * 64 + F.lane; const float* wp = F.ap->in[5] + ((size_t)layer * DM + F.wave * 256) * 6144 + n;
        float a[9];
#pragma unroll
        for (int r = 0; r < 9; ++r) a[r] = 0.f;
#pragma unroll 16
        for (int k = 0; k < 256; ++k) { const float w = wp[(size_t)k * 6144];
#pragma unroll
            for (int r = 0; r < 9; ++r) a[r] += sc[r * DM + F.wave * 256 + k] * w; }
#pragma unroll
        for (int r = 0; r < 9; ++r) part[(F.wave * 9 + r) * 64 + F.lane] = a[r];
        __syncthreads();
        for (int o = F.tid; o < 9 * 64; o += NTHR) { float t = F.ap->in[6][layer * 6144 + cb * 64 + (o & 63)];
#pragma unroll
            for (int w = 0; w < 8; ++w) t += part[w * 576 + o];
            mod[((size_t)layer * 9 + (o >> 6)) * 6144 + cb * 64 + (o & 63)] = t; }
        __syncthreads();
    }
    __syncthreads();
    LAS float* scr = (LAS float*)(F.lds + F.wave * 16896);
    constexpr int I_FI = (DM / 64) * (8192 / 64), I_FO = (FW / 64) * (DM / 64), I_SI = (DM / 64) * (SSD_IN / 64), I_SO = (FW / 64) * (DM / 64);
    for (int it = gw; it < I_FI + I_FO + I_SI + I_SO; it += NGW) {
        int r = it;
        if (r < I_FI) { p0_transpose_item<1>(F.ap->in[9], DM, 8192, (bf16*)(F.ws + WS_WFI), scr, r, F.lane); continue; } r -= I_FI;
        if (r < I_FO) { p0_transpose_item<2>(F.ap->in[10], FW, DM, (bf16*)(F.ws + WS_WFO), scr, r, F.lane); continue; } r -= I_FO;
        if (r < I_SI) { p0_transpose_item<0>(F.ap->in[11], DM, SSD_IN, (bf16*)(F.ws + WS_WSI), scr, r, F.lane); continue; } r -= I_SI;
        p0_transpose_item<0>(F.ap->in[18], FW, DM, (bf16*)(F.ws + WS_WSO), scr, r, F.lane);
    }
    { v4u* zp = (v4u*)((bf16*)(F.ws + WS_WSI) + (size_t)SSD_IN * DM); const size_t nz = (size_t)(SSD_IN_PAD - SSD_IN) * DM / 8;
      for (size_t i = gt; i < nz; i += NGT) zp[i] = (v4u){0u, 0u, 0u, 0u}; }
    { bf16* D = (bf16*)(F.ws + WS_D256);
      for (size_t i = gt; i < 256 * 256; i += NGT) { const int j = (int)(i >> 8), n = (int)i & 255; const int idx = ((j & 127) * n) & 255; float sn, cs; sincospif((float)idx * (1.0f / 128.0f), &sn, &cs);
          D[i] = (bf16)f2bf(j < 128 ? cs : (j == 128 ? ((n & 1) ? -1.0f : 1.0f) : sn)); } }
    { bf16* A = (bf16*)(F.ws + WS_A4P);
      for (size_t i = gt; i < 256 * 512; i += NGT) { const int k = (int)(i >> 9), kk = (int)i & 511; const int idx = (k * (kk & 255)) & 255; float s, c; sincospif((float)idx * (1.0f / 128.0f), &s, &c); A[i] = (bf16)f2bf(kk < 256 ? c : -s); } }
    { bf16* A = (bf16*)(F.ws + WS_A4S);
      for (size_t i = gt; i < (size_t)1024 * 2048; i += NGT) { const int k = (int)(i >> 11), kk = (int)i & 2047; const int idx = (k * (kk & 1023)) & 1023; float s, c; sincospif((float)idx * (1.0f / 512.0f), &s, &c); A[i] = (bf16)f2bf(kk < 1024 ? c : -s); } }
    { float* P = (float*)(F.ws + WS_POS);
      for (size_t i = gt; i < (size_t)LSA * DM; i += NGT) { const int t = (int)(i >> 11), j = (int)i & 2047; const int qd = j >> 9, ii = j & 511; const int p = qd < 2 ? (t >> 6) : (t & 63);
          const float om = expf(-9.210340371976184f * (float)ii * (1.0f / 512.0f)); const float ang = (float)p * om; P[i] = (qd & 1) ? cosf(ang) : sinf(ang); } }
}

__device__ __forceinline__ void p4_nyquist(Frame& F) {
    const bf16* NYQ = (const bf16*)(F.ws + WS_NYQ); const bf16* Z = (const bf16*)(F.ws + WS_Z); bf16* YG = (bf16*)(F.ws + WS_U);
    LAS bf16* nl = (LAS bf16*)F.lds;
    for (int item = F.bx; item < 256; item += F.G) {
        int bb, kb; if (item < 128) { bb = NBP + (item >> 4); kb = item & 15; } else { bb = (item - 128) >> 2; kb = (item - 128) & 3; }
        const int L = bb < NBP ? LPR : LSA; const float sc = bb < NBP ? 1.0f / 256.0f : 1.0f / 512.0f;
        const bf16* A4 = (const bf16*)(F.ws + (bb < NBP ? WS_A4P : WS_A4S));
        __syncthreads();
        for (int i = F.tid; i < 16 * L / 8; i += NTHR) *(LAS v4u*)(nl + 8 * i) = *(const v4u*)(NYQ + nyq_of(bb) + 8 * i);
        __syncthreads();
        const int k1 = kb * 64 + (F.tid >> 3), g0 = (F.tid & 7) * 2; const bf16* ar = A4 + (size_t)k1 * (2 * L);
        float a0 = 0.f, a1 = 0.f;
        for (int n = 0; n < L; n += 8) { const v4u c = *(const v4u*)(ar + n); const v4u x0 = *(const LAS v4u*)(nl + g0 * L + n), x1 = *(const LAS v4u*)(nl + (g0 + 1) * L + n);
            a0 += bf_lo(c.x) * bf_lo(x0.x) + bf_hi(c.x) * bf_hi(x0.x) + bf_lo(c.y) * bf_lo(x0.y) + bf_hi(c.y) * bf_hi(x0.y) + bf_lo(c.z) * bf_lo(x0.z) + bf_hi(c.z) * bf_hi(x0.z) + bf_lo(c.w) * bf_lo(x0.w) + bf_hi(c.w) * bf_hi(x0.w);
            a1 += bf_lo(c.x) * bf_lo(x1.x) + bf_hi(c.x) * bf_hi(x1.x) + bf_lo(c.y) * bf_lo(x1.y) + bf_hi(c.y) * bf_hi(x1.y) + bf_lo(c.z) * bf_lo(x1.z) + bf_hi(c.z) * bf_hi(x1.z) + bf_lo(c.w) * bf_lo(x1.w) + bf_hi(c.w) * bf_hi(x1.w); }
        const size_t o = (size_t)(row0_of(bb) + k1) * FW + g0 * 256 + 128;
        YG[o] = (bf16)f2bf(a0 * sc * bf2f(Z[o])); YG[o + 256] = (bf16)f2bf(a1 * sc * bf2f(Z[o + 256]));
    }
    __syncthreads();
}

__device__ __forceinline__ void row_stats(const f32x4 (&v)[8], float& mean, float& rstd) {
    float s = 0.f;
#pragma unroll
    for (int j = 0; j < 8; ++j) s += (v[j][0] + v[j][1]) + (v[j][2] + v[j][3]);
    mean = wave_sum(s) * (1.f / DM); float s2 = 0.f;
#pragma unroll
    for (int j = 0; j < 8; ++j) { const f32x4 d = v[j] - mean; s2 += (d[0] * d[0] + d[1] * d[1]) + (d[2] * d[2] + d[3] * d[3]); }
    rstd = 1.f / sqrtf(wave_sum(s2) * (1.f / DM) + LN_EPS);
}
__device__ __forceinline__ void modulate_store(const f32x4 (&v)[8], float mean, float rstd, const float* modrow, bf16* hrow, int lane) {
    const f32x4* sh = (const f32x4*)modrow + lane; const f32x4* scp = (const f32x4*)(modrow + DM) + lane; v2u* o = (v2u*)hrow + lane;
#pragma unroll
    for (int j = 0; j < 8; ++j) { const f32x4 y = (v[j] - mean) * rstd * (scp[64 * j] + 1.0f) + sh[64 * j]; v2u w; w.x = pk2(y[0], y[1]); w.y = pk2(y[2], y[3]); o[64 * j] = w; }
}
__device__ __forceinline__ void p1_load(Frame& F, int r, const float* pos, f32x4 (&v)[8], f32x4 (&p)[8]) {
    const bool smp = r >= NPR; const f32x4* xr = (const f32x4*)(smp ? F.ap->in[1] + (size_t)(r - NPR) * DM : F.ap->in[0] + (size_t)r * DM) + F.lane;
    const f32x4* pr = (const f32x4*)(pos + (size_t)((r - NPR) & (LSA - 1)) * DM) + F.lane;
#pragma unroll
    for (int j = 0; j < 8; ++j) { v[j] = xr[64 * j]; p[j] = smp ? pr[64 * j] : (f32x4){0.f, 0.f, 0.f, 0.f}; }
}
__device__ __forceinline__ void p1_ln_mod(Frame& F) {
    const int gw = F.bx * NWAVES + F.wave, NGW = F.G * NWAVES; const float* mod0 = (const float*)(F.ws + WS_MOD); const float* pos = (const float*)(F.ws + WS_POS); bf16* H = (bf16*)(F.ws + WS_H);
    f32x4 v[8], p[8], vn[8], pn[8];
    if (gw < NTOK) p1_load(F, gw, pos, v, p);
    for (int r = gw; r < NTOK; r += NGW) {
        const int rn = r + NGW; if (rn < NTOK) p1_load(F, rn, pos, vn, pn);
#pragma unroll
        for (int j = 0; j < 8; ++j) v[j] = v[j] + p[j];
        float mean, rstd; row_stats(v, mean, rstd);
        modulate_store(v, mean, rstd, mod0 + (size_t)cond_of_row(r) * 6144, H + (size_t)r * DM, F.lane);
#pragma unroll
        for (int j = 0; j < 8; ++j) { v[j] = vn[j]; p[j] = pn[j]; }
    }
}
__device__ __forceinline__ void v_unpack(const v2u (&w)[8], f32x4 (&v)[8]) {
#pragma unroll
    for (int j = 0; j < 8; ++j) v[j] = (f32x4){bf_lo(w[j].x), bf_hi(w[j].x), bf_lo(w[j].y), bf_hi(w[j].y)};
}
__device__ __forceinline__ void p6_ln_ln_mod(Frame& F) {
    const int gw = F.bx * NWAVES + F.wave, NGW = F.G * NWAVES; const float* mod1 = (const float*)(F.ws + WS_MOD) + 9 * 6144; bf16* V = (bf16*)(F.ws + WS_V); bf16* H = (bf16*)(F.ws + WS_H);
    const f32x4* gp = (const f32x4*)F.ap->in[7] + F.lane; const f32x4* bp = (const f32x4*)F.ap->in[8] + F.lane;
    v2u w[8], wn[8]; f32x4 v[8];
    if (gw < NTOK) { const v2u* vr = (const v2u*)(V + (size_t)gw * DM) + F.lane;
#pragma unroll
        for (int j = 0; j < 8; ++j) w[j] = vr[64 * j]; }
    for (int r = gw; r < NTOK; r += NGW) {
        const int rn = r + NGW; if (rn < NTOK) { const v2u* vr = (const v2u*)(V + (size_t)rn * DM) + F.lane;
#pragma unroll
            for (int j = 0; j < 8; ++j) wn[j] = vr[64 * j]; }
        v2u* vw = (v2u*)(V + (size_t)r * DM) + F.lane;
        v_unpack(w, v);
        float mean, rstd; row_stats(v, mean, rstd);
#pragma unroll
        for (int j = 0; j < 8; ++j) { v[j] = (v[j] - mean) * rstd * gp[64 * j] + bp[64 * j]; v2u o; o.x = pk2(v[j][0], v[j][1]); o.y = pk2(v[j][2], v[j][3]); vw[64 * j] = o; }
        row_stats(v, mean, rstd);
        modulate_store(v, mean, rstd, mod1 + (size_t)cond_of_row(r) * 6144, H + (size_t)r * DM, F.lane);
#pragma unroll
        for (int j = 0; j < 8; ++j) w[j] = wn[j];
    }
}
__device__ __forceinline__ void p11_final_ln(Frame& F) {
    const int gw = F.bx * NWAVES + F.wave, NGW = F.G * NWAVES; const bf16* V = (const bf16*)(F.ws + WS_V);
    const f32x4* gp = (const f32x4*)(F.ap->in[7] + DM) + F.lane; const f32x4* bp = (const f32x4*)(F.ap->in[8] + DM) + F.lane;
    v2u w[8], wn[8]; f32x4 v[8];
    if (gw < NTOK) { const v2u* vr = (const v2u*)(V + (size_t)gw * DM) + F.lane;
#pragma unroll
        for (int j = 0; j < 8; ++j) w[j] = vr[64 * j]; }
    for (int r = gw; r < NTOK; r += NGW) {
        const int rn = r + NGW; if (rn < NTOK) { const v2u* vr = (const v2u*)(V + (size_t)rn * DM) + F.lane;
#pragma unroll
            for (int j = 0; j < 8; ++j) wn[j] = vr[64 * j]; }
        f32x4* o = (f32x4*)(F.out + (size_t)r * DM) + F.lane;
        v_unpack(w, v);
        float mean, rstd; row_stats(v, mean, rstd);
#pragma unroll
        for (int j = 0; j < 8; ++j) o[64 * j] = (v[j] - mean) * rstd * gp[64 * j] + bp[64 * j];
#pragma unroll
        for (int j = 0; j < 8; ++j) w[j] = wn[j];
    }
}
__device__ __forceinline__ void p8_conv(Frame& F) {
    const bf16* XBC = (const bf16*)(F.ws + WS_XBC); bf16* XT = (bf16*)(F.ws + WS_XT); bf16* BN = (bf16*)(F.ws + WS_BN); bf16* CN = (bf16*)(F.ws + WS_CN); bf16* BT = (bf16*)(F.ws + WS_BT);
    LAS bf16* tile = (LAS bf16*)F.lds;
    const int co = F.tid & 31, tr = F.tid >> 5;
    const bool bal = F.G == 256; const int NIT = (NTOK / 64) * 24;
    const int i0 = bal ? (F.bx < 64 ? F.bx : 1024 + (F.bx - 64)) : F.bx, istep = bal ? (F.bx < 64 ? 64 : 192) : F.G, iend = bal && F.bx < 64 ? 1024 : NIT;
    for (int item = i0; item < iend; item += istep) {
        const int tb = item / 24, cb = item % 24; const int t0 = tb * 64;
        const int lo = t0 < NPR ? (t0 & ~(LPR - 1)) : NPR + ((t0 - NPR) & ~(LSA - 1)); const int hi = lo + (t0 < NPR ? LPR : LSA);
        const int ch = cb * 256 + co * 8; const int tq = t0 + 4 * tr;
        float w[5][8], bias[8];
#pragma unroll
        for (int k = 0; k < 5; ++k) { const f32x4 a = *(const f32x4*)(F.ap->in[12] + (size_t)k * CONVD + ch), b = *(const f32x4*)(F.ap->in[12] + (size_t)k * CONVD + ch + 4);
#pragma unroll
            for (int e = 0; e < 4; ++e) { w[k][e] = a[e]; w[k][4 + e] = b[e]; } }
        { const f32x4 a = *(const f32x4*)(F.ap->in[13] + ch), b = *(const f32x4*)(F.ap->in[13] + ch + 4);
#pragma unroll
          for (int e = 0; e < 4; ++e) { bias[e] = a[e]; bias[4 + e] = b[e]; } }
        v4u raw[8];
#pragma unroll
        for (int k = 0; k < 8; ++k) { const int tt = tq + k - 2; raw[k] = (v4u){0u, 0u, 0u, 0u}; if (tt >= lo && tt < hi) raw[k] = *(const v4u*)(XBC + (size_t)tt * CONVD + ch); }
        float o[4][8];
#pragma unroll
        for (int j = 0; j < 4; ++j)
#pragma unroll
            for (int e = 0; e < 8; ++e) o[j][e] = bias[e];
#pragma unroll
        for (int k = 0; k < 8; ++k) { const float rv[8] = {bf_lo(raw[k].x), bf_hi(raw[k].x), bf_lo(raw[k].y), bf_hi(raw[k].y), bf_lo(raw[k].z), bf_hi(raw[k].z), bf_lo(raw[k].w), bf_hi(raw[k].w)};
#pragma unroll
            for (int j = 0; j < 4; ++j) { const int kk = k - j;
                if (kk >= 0 && kk < 5) {
#pragma unroll
                    for (int e = 0; e < 8; ++e) o[j][e] += rv[e] * w[kk][e]; } } }
        unsigned pw[4][4];
#pragma unroll
        for (int j = 0; j < 4; ++j) {
#pragma unroll
            for (int e = 0; e < 8; ++e) o[j][e] = silu_f(o[j][e]);
            pw[j][0] = pk2(o[j][0], o[j][1]); pw[j][1] = pk2(o[j][2], o[j][3]); pw[j][2] = pk2(o[j][4], o[j][5]); pw[j][3] = pk2(o[j][6], o[j][7]); }
        if (cb >= 16) {
            bf16* dst = (cb < 20 ? BN + (cb - 16) * 256 : CN + (cb - 20) * 256) + co * 8;
#pragma unroll
            for (int j = 0; j < 4; ++j) *(v4u*)(dst + (size_t)(tq + j) * 1024) = (v4u){pw[j][0], pw[j][1], pw[j][2], pw[j][3]};
        }
        if (cb < 20) {
            __syncthreads();
#pragma unroll
            for (int e = 0; e < 8; ++e) { const int row = co * 8 + e; LAS bf16* rp = tile + row * 64 + (((tr >> 1) ^ (co & 7)) << 3) + (tr & 1) * 4;
                const unsigned sh = (e & 1) * 16;
                v2u pk; pk.x = ((pw[0][e >> 1] >> sh) & 0xffffu) | (((pw[1][e >> 1] >> sh) & 0xffffu) << 16); pk.y = ((pw[2][e >> 1] >> sh) & 0xffffu) | (((pw[3][e >> 1] >> sh) & 0xffffu) << 16);
                *(LAS v2u*)rp = pk; }
            __syncthreads();
            bf16* dstT = cb < 16 ? XT + (size_t)(cb * 256) * NTOK : BT + (size_t)((cb - 16) * 256) * NTOK;
#pragma unroll
            for (int k = 0; k < 4; ++k) { const int id = F.tid + 512 * k, row = id >> 3, oct = id & 7;
                const v4u v = *(const LAS v4u*)(tile + row * 64 + ((oct ^ ((row >> 3) & 7)) << 3));
                *(v4u*)(dstT + (size_t)row * NTOK + t0 + oct * 8) = v; }
        }
    }
}

namespace scan {
constexpr int CL = 64;
constexpr int P272 = 272, P144 = 144;
constexpr int CM_B = 64 * P272, BMT_B = 128 * P144, XT_B = 256 * P144, G_B = 64 * P144;
constexpr int CM_OFF = 0, BM_OFF = 2 * CM_B, BMT_OFF = 4 * CM_B, XT_OFF = BMT_OFF + 2 * BMT_B, G_OFF = XT_OFF + XT_B, TAB_OFF = G_OFF + G_B;
constexpr int TAB_B = 3 * 1024 + 64;
static_assert(TAB_OFF + 2 * TAB_B <= MISC_OFF, "scan LDS map");
__device__ __forceinline__ float softplus_f(float x) { return x > 20.f ? x : log1pf(expf(x)); }
__device__ __forceinline__ void glds16_asm(const char* sbase, unsigned voff, unsigned lds_dst) {
    unsigned keep;
    asm volatile("s_mov_b32 %0, m0\n\ts_mov_b32 m0, %3\n\ts_nop 0\n\tglobal_load_lds_dwordx4 %1, %2\n\ts_mov_b32 m0, %0" : "=&s"(keep) : "v"(voff), "s"(sbase), "s"(lds_dst) : "memory");
}
template <int PITCH>
__device__ __forceinline__ unsigned dma_off(int P, int lane, unsigned rstride) { const int x = 1024 * P + 16 * lane; const int row = x / PITCH; int ch = (x - row * PITCH) >> 4; ch = ch == (PITCH / 16 - 1) ? 0 : ch;
    return (unsigned)row * rstride + (unsigned)ch * 16u; }
template <int NP>
__device__ __forceinline__ void dma_image(LAS unsigned char* img, const char* src, const unsigned (&off)[3], int wid) {
    const unsigned base = (unsigned)(size_t)img;
#pragma unroll
    for (int i = 0; i < 3; ++i) { const int P = wid + 8 * i; if (P < NP) glds16_asm(src, off[i], (unsigned)__builtin_amdgcn_readfirstlane((int)(base + (unsigned)P * 1024u))); }
}
#define LD16(p) (*(const LAS bf16x8*)(p))
#define LD8(p) (*(const LAS v2u*)(p))

template <int AB>
__device__ __forceinline__ void scan_dir(Frame& F, const int bb, const int g, const int hh, const int dir) {
    LAS unsigned char* lds = F.lds;
    const int tid = F.tid, lane = F.lane, wid = F.wave, c16 = lane & 15, q = lane >> 4;
    const bool smp = bb >= NBP; const int L = smp ? LSA : LPR, nc = L / CL, row0 = row0_of(bb);
    const char* BNg = (const char*)(F.ws + WS_BN); const char* CNg = (const char*)(F.ws + WS_CN); const char* BTg = (const char*)(F.ws + WS_BT); const bf16* XTg = (const bf16*)(F.ws + WS_XT);
    const bf16* Zg = (const bf16*)(F.ws + WS_Z); const float* DTg = (const float*)(F.ws + WS_DT); bf16* Yg = (bf16*)(F.ws + (AB ? WS_T : WS_Y)); float* SSQ = (float*)(F.ws + (AB ? WS_T + 160 * MiB : WS_SSQ));
    const float* dt_bias = F.ap->in[14]; const float* a_log = F.ap->in[15];
    const int hbase = g * 8 + hh * 4, hd = wid >> 1, ph = wid & 1, h = hbase + hd;
    const int chl = hd * 64 + 32 * ph;
    const int aC8 = c16 * P272 + 8 * q;
    const int aR272 = c16 * P272 + 16 * q;
    const int aG8 = c16 * P144 + 8 * q;
    const int aX8 = (chl + c16) * P144 + 8 * q;
    const int aX16 = (chl + c16) * P144 + 16 * q;
    const int aXe = (chl + 4 * q) * P144 + 2 * c16;
    const int aBT = c16 * P144 + 16 * q;
    const int tdir = dir * 64;
    unsigned oN[3], oT[3];
#pragma unroll
    for (int i = 0; i < 3; ++i) { oN[i] = dma_off<P272>(wid + 8 * i, lane, 2048u); oT[i] = dma_off<P144>(wid + 8 * i, lane, (unsigned)NTOK * 2u); }
    const bf16* xsrc = XTg + (size_t)(hbase * 64 + (tid >> 3)) * NTOK + (tid & 7) * 8;
    const int xdst = XT_OFF + (tid >> 3) * P144 + (tid & 7) * 16;
    f32x4 S[8][2];
#pragma unroll
    for (int nt = 0; nt < 8; ++nt)
#pragma unroll
        for (int p2 = 0; p2 < 2; ++p2) {
            if (smp) S[nt][p2] = *(const f32x4*)(F.ap->in[2] + ((((size_t)(bb - NBP) * 2 + dir) * 64 + h) * 64 + 32 * ph + 16 * p2 + c16) * 128 + 16 * nt + 4 * q);
            else S[nt][p2] = (f32x4){0.f, 0.f, 0.f, 0.f}; }
    f32x4 nwv[2]; nwv[0] = *(const f32x4*)(F.ap->in[17] + h * 64 + 32 * ph + 4 * q); nwv[1] = *(const f32x4*)(F.ap->in[17] + h * 64 + 32 * ph + 16 + 4 * q);
    const float dsk = F.ap->in[16][h];
    auto make_tables = [&](float raw, int tb) {
        if (ph == 0) { LAS float* T = (LAS float*)(lds + TAB_OFF + tb * TAB_B); const int ti = hd * 64 + lane;
            const float dtv = softplus_f(raw + dt_bias[tdir + h]); const float da = dtv * (-expf(a_log[tdir + h]));
            float v = da;
#pragma unroll
            for (int o = 1; o < 64; o <<= 1) { const float t = __shfl_up(v, o); if (lane >= o) v += t; }
            const float tot = __shfl(v, 63);
            const float acs = dir == 0 ? v : (tot - v + da);
            T[ti] = __log2f(dtv) - acs * 1.4426950408889634f; T[256 + ti] = acs; T[512 + ti] = expf(tot - acs) * dtv; if (lane == 0) T[768 + hd] = tot; } };
    auto chunk_t0 = [&](int step) { return row0 + (dir == 0 ? step : nc - 1 - step) * CL; };
    v4u xr[4];
    __syncthreads();
    { const int t0 = chunk_t0(0);
      dma_image<17>(lds + CM_OFF, CNg + ((size_t)t0 * 1024 + g * 128) * 2, oN, wid);
      dma_image<17>(lds + BM_OFF, BNg + ((size_t)t0 * 1024 + g * 128) * 2, oN, wid);
      dma_image<18>(lds + BMT_OFF, BTg + ((size_t)(g * 128) * NTOK + t0) * 2, oT, wid);
#pragma unroll
      for (int i = 0; i < 4; ++i) xr[i] = *(const v4u*)(xsrc + (size_t)(64 * i) * NTOK + t0);
      const float raw = ph == 0 ? DTg[(size_t)(t0 + lane) * 128 + tdir + h] : 0.f;
      make_tables(raw, 0);
      asm volatile("s_waitcnt vmcnt(0) lgkmcnt(0)" ::: "memory");
      __syncthreads(); }
#pragma unroll 1
    for (int step = 0; step < nc; ++step) {
        const int b = step & 1; const int t0 = chunk_t0(step); const bool have_next = step + 1 < nc; const int t0n = have_next ? chunk_t0(step + 1) : t0;
        LAS unsigned char* CM = lds + CM_OFF + b * CM_B; LAS unsigned char* BMT = lds + BMT_OFF + b * BMT_B; LAS unsigned char* GI = lds + G_OFF;
        const LAS float* T = (const LAS float*)(lds + TAB_OFF + b * TAB_B);
#pragma unroll
        for (int i = 0; i < 4; ++i) *(LAS v4u*)(lds + xdst + i * (64 * P144)) = xr[i];
        if (have_next) {
            dma_image<17>(lds + CM_OFF + (b ^ 1) * CM_B, CNg + ((size_t)t0n * 1024 + g * 128) * 2, oN, wid);
            dma_image<17>(lds + BM_OFF + (b ^ 1) * CM_B, BNg + ((size_t)t0n * 1024 + g * 128) * 2, oN, wid);
            dma_image<18>(lds + BMT_OFF + (b ^ 1) * BMT_B, BTg + ((size_t)(g * 128) * NTOK + t0n) * 2, oT, wid);
#pragma unroll
            for (int i = 0; i < 4; ++i) xr[i] = *(const v4u*)(xsrc + (size_t)(64 * i) * NTOK + t0n); }
        const float raw_next = (have_next && ph == 0) ? DTg[(size_t)(t0n + lane) * 128 + tdir + h] : 0.f;
        { const int lt = wid & 3; bf16x8 cf[4], bfr[2][4];
#pragma unroll
          for (int ks = 0; ks < 4; ++ks) { cf[ks] = LD16(CM + aR272 + lt * (16 * P272) + 64 * ks);
#pragma unroll
              for (int s2 = 0; s2 < 2; ++s2) bfr[s2][ks] = LD16(lds + BM_OFF + b * CM_B + aR272 + (2 * (wid >> 2) + s2) * (16 * P272) + 64 * ks); }
#pragma unroll
          for (int s2 = 0; s2 < 2; ++s2) { f32x4 a = (f32x4){0.f, 0.f, 0.f, 0.f};
#pragma unroll
              for (int ks = 0; ks < 4; ++ks) a = __builtin_amdgcn_mfma_f32_16x16x32_bf16(bfr[s2][ks], cf[ks], a, 0, 0, 0);
              v2u w; w.x = pk2(a[0], a[1]); w.y = pk2(a[2], a[3]);
              *(LAS v2u*)(GI + (16 * lt + c16) * P144 + (16 * (2 * (wid >> 2) + s2) + 4 * q) * 2) = w; } }
        f32x4 acc[2][4];
#pragma unroll
        for (int p2 = 0; p2 < 2; ++p2)
#pragma unroll
            for (int lt = 0; lt < 4; ++lt) acc[p2][lt] = (f32x4){0.f, 0.f, 0.f, 0.f};
#pragma unroll
        for (int ks = 0; ks < 4; ++ks) { bf16x8 a5[2];
#pragma unroll
            for (int p2 = 0; p2 < 2; ++p2) { v4u w; w.x = pk2(S[2 * ks][p2][0], S[2 * ks][p2][1]); w.y = pk2(S[2 * ks][p2][2], S[2 * ks][p2][3]);
                w.z = pk2(S[2 * ks + 1][p2][0], S[2 * ks + 1][p2][1]); w.w = pk2(S[2 * ks + 1][p2][2], S[2 * ks + 1][p2][3]); a5[p2] = __builtin_bit_cast(bf16x8, w); }
#pragma unroll
            for (int lt = 0; lt < 4; ++lt) { const v2u c0 = LD8(CM + aC8 + lt * (16 * P272) + 64 * ks), c1 = LD8(CM + aC8 + lt * (16 * P272) + 64 * ks + 32);
                const bf16x8 b5 = __builtin_bit_cast(bf16x8, (v4u){c0.x, c0.y, c1.x, c1.y});
#pragma unroll
                for (int p2 = 0; p2 < 2; ++p2) acc[p2][lt] = __builtin_amdgcn_mfma_f32_16x16x32_bf16(a5[p2], b5, acc[p2][lt], 0, 0, 0); } }
        float al[4];
#pragma unroll
        for (int lt = 0; lt < 4; ++lt) { al[lt] = T[256 + hd * 64 + 16 * lt + c16]; const float e = __expf(al[lt]); acc[0][lt] = acc[0][lt] * e; acc[1][lt] = acc[1][lt] * e; }
        const size_t go = (size_t)(t0 + c16) * FW + h * 64 + 32 * ph + 4 * q;
        v2u zz[2][4], yp[2][4];
#pragma unroll
        for (int p2 = 0; p2 < 2; ++p2)
#pragma unroll
            for (int lt = 0; lt < 4; ++lt) { zz[p2][lt] = (v2u){0u, 0u}; yp[p2][lt] = (v2u){0u, 0u}; }
        if (dir == 1 && !(AB & 16)) {
#pragma unroll
            for (int p2 = 0; p2 < 2; ++p2)
#pragma unroll
                for (int lt = 0; lt < 2; ++lt) { zz[p2][lt] = *(const v2u*)(Zg + go + (size_t)(16 * lt) * FW + 16 * p2); yp[p2][lt] = *(const v2u*)(Yg + go + (size_t)(16 * lt) * FW + 16 * p2); } }
        asm volatile("s_waitcnt lgkmcnt(0)" ::: "memory"); if (!(AB & 4)) __builtin_amdgcn_s_barrier(); asm volatile("" ::: "memory");
#pragma unroll
        for (int ks = 0; ks < 2; ++ks) { const int s0 = 32 * ks + 4 * q;
            const f32x4 la0 = *(const LAS f32x4*)(T + hd * 64 + s0), la1 = *(const LAS f32x4*)(T + hd * 64 + s0 + 16);
            bf16x8 a3[2];
#pragma unroll
            for (int p2 = 0; p2 < 2; ++p2) { const v2u x0 = LD8(lds + XT_OFF + aX8 + p2 * (16 * P144) + 64 * ks), x1 = LD8(lds + XT_OFF + aX8 + p2 * (16 * P144) + 64 * ks + 32);
                a3[p2] = __builtin_bit_cast(bf16x8, (v4u){x0.x, x0.y, x1.x, x1.y}); }
#pragma unroll
            for (int lt = 0; lt < 4; ++lt) {
                if (dir == 0 ? (ks == 1 && lt < 2) : (ks == 0 && lt >= 2)) continue;
                const v2u g0 = LD8(GI + aG8 + lt * (16 * P144) + 64 * ks), g1 = LD8(GI + aG8 + lt * (16 * P144) + 64 * ks + 32);
                const unsigned gw[4] = {g0.x, g0.y, g1.x, g1.y}; const int lc = 16 * lt + c16; const float al2 = al[lt] * 1.4426950408889634f;
                float f[8];
#pragma unroll
                for (int j = 0; j < 8; ++j) { const int s = s0 + (j & 3) + 16 * (j >> 2); const bool in = dir == 0 ? (s <= lc) : (s >= lc);
                    const float la = j < 4 ? la0[j & 3] : la1[j & 3]; const float gv = (j & 1) ? bf_hi(gw[j >> 1]) : bf_lo(gw[j >> 1]);
                    f[j] = (AB & 2) ? gv : (in ? __builtin_amdgcn_exp2f(al2 + la) * gv : 0.f); }
                v4u bw; bw.x = pk2(f[0], f[1]); bw.y = pk2(f[2], f[3]); bw.z = pk2(f[4], f[5]); bw.w = pk2(f[6], f[7]); const bf16x8 b3 = __builtin_bit_cast(bf16x8, bw);
#pragma unroll
                for (int p2 = 0; p2 < 2; ++p2) acc[p2][lt] = __builtin_amdgcn_mfma_f32_16x16x32_bf16(a3[p2], b3, acc[p2][lt], 0, 0, 0); } }
        asm volatile("s_waitcnt vmcnt(0)" ::: "memory");
        if (dir == 1 && !(AB & 16)) {
#pragma unroll
            for (int p2 = 0; p2 < 2; ++p2)
#pragma unroll
                for (int lt = 2; lt < 4; ++lt) { zz[p2][lt] = *(const v2u*)(Zg + go + (size_t)(16 * lt) * FW + 16 * p2); yp[p2][lt] = *(const v2u*)(Yg + go + (size_t)(16 * lt) * FW + 16 * p2); } }
        if (have_next) make_tables(raw_next, b ^ 1);
#pragma unroll
        for (int lt = 0; lt < 4; ++lt) { float ssq = 0.f;
#pragma unroll
            for (int p2 = 0; p2 < 2; ++p2) { v2u o;
                if (dir == 0) { float y[4];
#pragma unroll
                    for (int r = 0; r < 4; ++r) y[r] = acc[p2][lt][r] + dsk * bf2f(*(const LAS bf16*)(lds + XT_OFF + aXe + (16 * p2 + r) * P144 + 32 * lt));
                    o.x = pk2(y[0], y[1]); o.y = pk2(y[2], y[3]);
                } else { const f32x4 nw = nwv[p2];
                    const float y0 = (acc[p2][lt][0] + bf_lo(yp[p2][lt].x)) * bf_lo(zz[p2][lt].x), y1 = (acc[p2][lt][1] + bf_hi(yp[p2][lt].x)) * bf_hi(zz[p2][lt].x);
                    const float y2 = (acc[p2][lt][2] + bf_lo(yp[p2][lt].y)) * bf_lo(zz[p2][lt].y), y3 = (acc[p2][lt][3] + bf_hi(yp[p2][lt].y)) * bf_hi(zz[p2][lt].y);
                    ssq += (y0 * y0 + y1 * y1) + (y2 * y2 + y3 * y3);
                    o.x = pk2(y0 * nw[0], y1 * nw[1]); o.y = pk2(y2 * nw[2], y3 * nw[3]); }
                if (!(AB & 16)) *(v2u*)(Yg + go + (size_t)(16 * lt) * FW + 16 * p2) = o; else asm volatile("" :: "v"(o.x), "v"(o.y)); }
            if (dir == 1) { float v = ssq; v += __shfl_xor(v, 16); v += __shfl_xor(v, 32); if (q == 0) atomicAdd(SSQ + (t0 + 16 * lt + c16), v); } }
        { const float dec = __expf(T[768 + hd]);
#pragma unroll
          for (int nt = 0; nt < 8; ++nt) { S[nt][0] = S[nt][0] * dec; S[nt][1] = S[nt][1] * dec; }
#pragma unroll
          for (int ks = 0; ks < 2; ++ks) { const int s0 = 32 * ks + 8 * q;
              const f32x4 w0 = *(const LAS f32x4*)(T + 512 + hd * 64 + s0), w1 = *(const LAS f32x4*)(T + 512 + hd * 64 + s0 + 4);
              bf16x8 b4[2];
#pragma unroll
              for (int p2 = 0; p2 < 2; ++p2) { const v4u x8 = *(const LAS v4u*)(lds + XT_OFF + aX16 + p2 * (16 * P144) + 64 * ks);
                  v4u w; w.x = pk2(bf_lo(x8.x) * w0[0], bf_hi(x8.x) * w0[1]); w.y = pk2(bf_lo(x8.y) * w0[2], bf_hi(x8.y) * w0[3]);
                  w.z = pk2(bf_lo(x8.z) * w1[0], bf_hi(x8.z) * w1[1]); w.w = pk2(bf_lo(x8.w) * w1[2], bf_hi(x8.w) * w1[3]); b4[p2] = __builtin_bit_cast(bf16x8, w); }
#pragma unroll
              for (int nt = 0; nt < 8; ++nt) { const bf16x8 a4 = LD16(BMT + aBT + nt * (16 * P144) + 64 * ks);
                  S[nt][0] = __builtin_amdgcn_mfma_f32_16x16x32_bf16(a4, b4[0], S[nt][0], 0, 0, 0); S[nt][1] = __builtin_amdgcn_mfma_f32_16x16x32_bf16(a4, b4[1], S[nt][1], 0, 0, 0); } } }
        asm volatile("s_waitcnt lgkmcnt(0)" ::: "memory"); if (!(AB & 4)) __builtin_amdgcn_s_barrier(); asm volatile("" ::: "memory");
    }
    if (!smp) {
        float* so = AB ? (float*)(F.ws + WS_T + 64 * MiB) : F.out + (size_t)NTOK * DM;
#pragma unroll
        for (int nt = 0; nt < 8; ++nt)
#pragma unroll
            for (int p2 = 0; p2 < 2; ++p2) *(f32x4*)(so + ((((size_t)bb * 2 + dir) * 64 + h) * 64 + 32 * ph + 16 * p2 + c16) * 128 + 16 * nt + 4 * q) = S[nt][p2];
    }
}
#undef LD16
#undef LD8
template <int AB>
__device__ __forceinline__ void unit(Frame& F, const int bb, const int g, const int hh) {
#pragma unroll 1
    for (int dir = 0; dir < 2; ++dir) scan_dir<AB>(F, bb, g, hh, dir);
}
template <int AB>
__device__ __forceinline__ void phase(Frame& F) {
    const bool bal = F.G == 256;
    const int nu = bal ? (F.bx < 128 ? 1 : 4) : (640 - F.bx + F.G - 1) / F.G;
#pragma unroll 1
    for (int i = 0; i < nu; ++i) {
        int bb, g, hh;
        if (bal) {
            if (F.bx < 128) { const int u = F.bx; bb = NBP + (u >> 4); g = u & 7; hh = (u >> 3) & 1; }
            else { const int w2 = F.bx - 128, rest = (w2 & 7) | ((w2 >> 4) << 3), idx = rest * 4 + i; hh = (w2 >> 3) & 1; bb = idx >> 3; g = idx & 7; }
        } else { const int u = F.bx + i * F.G; if (u < 128) { bb = NBP + (u >> 4); g = (u >> 1) & 7; hh = u & 1; } else { const int p = u - 128; bb = p >> 4; g = (p >> 1) & 7; hh = p & 1; } }
        unit<AB>(F, bb, g, hh);
    }
}
}

__global__ void __launch_bounds__(NTHR, 2) fwd_kernel(Args args) {
    extern __shared__ __attribute__((aligned(16))) unsigned char lds_raw[];
    Frame F;
    F.lds = (LAS unsigned char*)lds_raw; F.pacc = 0; F.pt0 = 0; F.abl = 0;
    F.tid = threadIdx.x; F.lane = F.tid & 63; F.wave = __builtin_amdgcn_readfirstlane(F.tid >> 6); F.G = gridDim.x; F.bx = blockIdx.x;
    F.ap = &args;
    F.out = args.out; F.ws = args.ws;
    volatile LAS unsigned* MISC = (volatile LAS unsigned*)(F.lds + MISC_OFF);
    if (F.tid < 64) MISC[F.tid] = 0u;
    __syncthreads();
    unsigned* ctl = (unsigned*)(F.ws + WS_CTL);
    const int lo = args.ph_lo, hi = args.ph_hi;
    XcdBarrier bar; bar.bar = ctl + CW_BAR; bar.x = 0; bar.st = nullptr;
    if (hi - lo > 1) bar = xcd_barrier_post(ctl + CW_BAR, MISC + 8);
#ifndef ONLY_PHASE
#define ONLY_PHASE -1
#endif
#define IN(k) ((ONLY_PHASE < 0 || ONLY_PHASE == (k)) && lo <= (k) && (k) < hi)
#define SEAM(k) do { if (IN(k) && IN((k) + 1)) xcd_barrier(bar); } while (0)
#ifndef DUP_MASK
#define DUP_MASK 0
#endif
#define REP(k) for (int _rep = 0; _rep < 1 + ((DUP_MASK >> (k)) & 1); ++_rep, __syncthreads())
    bf16* H = (bf16*)(F.ws + WS_H); bf16* U = (bf16*)(F.ws + WS_U); bf16* Z = (bf16*)(F.ws + WS_Z); bf16* T = (bf16*)(F.ws + WS_T); bf16* V = (bf16*)(F.ws + WS_V);
    const float* mod = (const float*)(F.ws + WS_MOD);

    if (IN(0)) REP(0) { PB(20); PB(40); p0_prologue(F); PE(20); } SEAM(0); PE(40);
    if (IN(1)) REP(1) { PB(21); PB(41); p1_ln_mod(F); PE(21); } SEAM(1); PE(41);
    if (IN(2)) REP(2) { PB(22); PB(42); SchedGrid S{H, (const bf16*)(F.ws + WS_WFI), 64, 32, DM, DM, F.G, F.bx}; EpiUZ E{U, Z};
                 pg8::gemm_phase<EpiUZ, SchedGrid, GP_ALIGN, GP_SP2>(F.lds, DM, DM, DM, S, E); PE(22); } SEAM(2); PE(42);
    if (IN(3)) REP(3) { PB(23); PB(43); SchedCDFT S{(const bf16*)(F.ws + WS_D256), U, F.G, F.bx}; EpiCDFT E{T, (bf16*)(F.ws + WS_NYQ)};
                 pg8::gemm_phase<EpiCDFT, SchedCDFT, GP_ALIGN, GP_SP2>(F.lds, 256, 256, FW, S, E); PE(23); } SEAM(3); PE(43);
    if (IN(4)) REP(4) { PB(24); PB(44); p4_nyquist(F);
                 { SchedLDFT S{(const bf16*)(F.ws + WS_A4S), T, 1, F.G, F.bx}; EpiLDFT E{Z, U, 1.0f / 512.0f};
                   pg8::gemm_phase<EpiLDFT, SchedLDFT, GP_ALIGN, GP_SP2>(F.lds, 2 * LSA, 2 * LSA, 2 * LSA, S, E); }
                 { SchedLDFT S{(const bf16*)(F.ws + WS_A4P), T, 0, F.G, F.bx}; EpiLDFT E{Z, U, 1.0f / 256.0f};
                   pg8::gemm_phase<EpiLDFT, SchedLDFT, GP_ALIGN, GP_SP2>(F.lds, 2 * LPR, 2 * LPR, 2 * LPR, S, E); } PE(24); } SEAM(4); PE(44);
    if (IN(5)) REP(5) { PB(25); PB(45); SchedGrid S{U, (const bf16*)(F.ws + WS_WFO), 64, 8, FW, FW, F.G, F.bx}; EpiRes0 E{F.ap->in[0], F.ap->in[1], (const float*)(F.ws + WS_POS), mod, V};
                 pg8::gemm_phase<EpiRes0, SchedGrid, GP_ALIGN, GP_SP2>(F.lds, FW, FW, FW, S, E); PE(25); } SEAM(5); PE(45);
    if (IN(6)) REP(6) { PB(26); PB(46); p6_ln_ln_mod(F); PE(26); } SEAM(6); PE(46);
    if (IN(7)) REP(7) { PB(27); PB(47); SchedGrid S{H, (const bf16*)(F.ws + WS_WSI), 64, 40, DM, DM, F.G, F.bx}; EpiProj E{Z, (bf16*)(F.ws + WS_XBC), (float*)(F.ws + WS_DT)};
                 pg8::gemm_phase<EpiProj, SchedGrid, GP_ALIGN, GP_SP2>(F.lds, DM, DM, DM, S, E); PE(27); } SEAM(7); PE(47);
    if (IN(8)) REP(8) { PB(28); PB(48);
        const bool dtw = (F.G == 256) && F.bx < 64;
        if (F.G != 256 || dtw) { SchedOne S{H, (const bf16*)(F.ws + WS_WSI), 0, 40, DM, DM}; EpiProj E{Z, (bf16*)(F.ws + WS_XBC), (float*)(F.ws + WS_DT)};
            if (F.G == 256) { S.pm = F.bx; pg8::gemm_phase<EpiProj, SchedOne, GP_ALIGN, GP_SP2>(F.lds, DM, DM, DM, S, E); }
            else for (int pm = F.bx; pm < 64; pm += F.G) { S.pm = pm; pg8::gemm_phase<EpiProj, SchedOne, GP_ALIGN, GP_SP2>(F.lds, DM, DM, DM, S, E); } }
        p8_conv(F); PE(28); } SEAM(8); PE(48);
    if (IN(9)) REP(9) { PB(29); PB(49); PB(1); scan::phase<0>(F); PE(1); PE(29);
        if (ABL) { __syncthreads(); scan::phase<ABL>(F); } } SEAM(9); PE(49);
    if (IN(10)) REP(10) { PB(30); PB(50); SchedGrid S{(const bf16*)(F.ws + WS_Y), (const bf16*)(F.ws + WS_WSO), 64, 8, FW, FW, F.G, F.bx}; EpiRes1 E{mod + 9 * 6144, (const float*)(F.ws + WS_SSQ), V};
                  pg8::gemm_phase<EpiRes1, SchedGrid, GP_ALIGN, GP_SP2>(F.lds, FW, FW, FW, S, E); PE(30); } SEAM(10); PE(50);
    if (IN(11)) REP(11) { PB(31); p11_final_ln(F); PE(31); }
    if (PROF_ID != 0 && F.bx == 0 && F.tid < 64) { const unsigned long long t0 = __builtin_amdgcn_s_memrealtime(), want = F.pacc * PROF_K;
        while (__builtin_amdgcn_s_memrealtime() - t0 < want) __builtin_amdgcn_s_sleep(8); }
#undef IN
#undef SEAM
}


extern "C" void kernel_launch(void* const* d_in, const int* in_sizes, int n_in, void* d_out, int out_size, void* d_ws, size_t ws_size, hipStream_t stream) {
    static int grid = 0;
    if (grid == 0) {
        int dev = 0, cus = 0;
        if (n_in != 19 || ws_size < WS_END || out_size != NTOK * DM + NBP * 2 * 64 * 64 * 128) { fprintf(stderr, "kernel_launch: unexpected shapes (n_in %d, ws %zu, out %d)\n", n_in, ws_size, out_size); grid = -1; return; }
        if (hipGetDevice(&dev) != hipSuccess || hipDeviceGetAttribute(&cus, hipDeviceAttributeMultiprocessorCount, dev) != hipSuccess) { grid = -1; return; }
        if (hipFuncSetAttribute((const void*)fwd_kernel, hipFuncAttributeMaxDynamicSharedMemorySize, LDS_BYTES) != hipSuccess) { fprintf(stderr, "kernel_launch: hipFuncSetAttribute failed\n"); grid = -1; return; }
        grid = cus;
    }
    if (grid < 0) return;
    (void)hipMemsetAsync((char*)d_ws + WS_CTL, 0, CTL_ZERO_BYTES, stream);
    Args a{};
    for (int i = 0; i < 19; ++i) a.in[i] = (const float*)d_in[i];
    a.out = (float*)d_out; a.ws = (unsigned char*)d_ws;
#if MK_PER_PHASE || MK_CHECK
    for (int p = 0; p < NPHASE; ++p) { a.ph_lo = p; a.ph_hi = p + 1; hipLaunchKernelGGL(fwd_kernel, dim3(grid), dim3(NTHR), LDS_BYTES, stream, a);
#if MK_CHECK
        check_after_phase(p, a, stream);
#endif
    }
#if MK_CHECK
    check_report(a, stream);
#endif
#else
    a.ph_lo = 0; a.ph_hi = NPHASE;
    hipLaunchKernelGGL(fwd_kernel, dim3(grid), dim3(NTHR), LDS_BYTES, stream, a);
#endif
}
```

```cpp
#include <hip/hip_runtime.h>
#include <cstdio>
#include <cstdint>

#ifndef MK_PER_PHASE
#define MK_PER_PHASE 0
#endif
#ifndef MK_CHECK
#define MK_CHECK 0
#endif

#define GAS __attribute__((address_space(1)))
#define LAS __attribute__((address_space(3)))
typedef unsigned short bf16;
typedef unsigned v4u __attribute__((ext_vector_type(4)));
typedef unsigned v2u __attribute__((ext_vector_type(2)));
typedef float f32x4 __attribute__((ext_vector_type(4)));
typedef short bf16x8 __attribute__((ext_vector_type(8)));
#define LDS_WAIT() asm volatile("s_waitcnt lgkmcnt(0)" ::: "memory")
#define VM_WAIT() asm volatile("s_waitcnt vmcnt(0)" ::: "memory")

constexpr int NWAVES = 8, NTHR = 512;
constexpr int DM = 2048, NTOK = 16384, NPR = 8192, LPR = 256, LSA = 1024, NBP = 32, NBS = 8;
constexpr int FW = 4096;
constexpr int SSD_IN = 10368, SSD_IN_PAD = 10496, CONVD = 6144;
constexpr float LN_EPS = 1e-5f;
constexpr float DN_ALPHA = 1.41421356237f;
constexpr int NPHASE = 12;

constexpr size_t MiB = 1u << 20;
constexpr size_t WS_CTL = 0, WS_MOD = 1 * MiB, WS_SSQ = 1 * MiB + 512 * 1024, CTL_ZERO_BYTES = 2 * MiB;
constexpr size_t WS_D256 = 2 * MiB, WS_NYQ = 2 * MiB + 512 * 1024, WS_A4P = 3 * MiB, WS_A4S = 4 * MiB, WS_POS = 8 * MiB;
constexpr size_t WS_WFI = 16 * MiB, WS_WFO = 48 * MiB, WS_WSI = 64 * MiB, WS_WSO = 106 * MiB;
constexpr size_t WS_DT = 122 * MiB;
constexpr size_t WS_H = 132 * MiB, WS_U = 196 * MiB, WS_Z = 324 * MiB, WS_T = 452 * MiB, WS_V = 708 * MiB, WS_Y = 836 * MiB, WS_END = 996 * MiB;
constexpr size_t WS_XBC = WS_T, WS_BN = 644 * MiB, WS_CN = 676 * MiB, WS_XT = WS_U, WS_BT = 964 * MiB;
constexpr int CW_BAR = 4096;

constexpr int LDS_BYTES = 163840;
constexpr int MISC_OFF = LDS_BYTES - 256;

__device__ __forceinline__ unsigned f2bf(float f) { unsigned u = __builtin_bit_cast(unsigned, f); return (u + 0x7fffu + ((u >> 16) & 1u)) >> 16; }
typedef __bf16 bf2_t __attribute__((ext_vector_type(2)));
typedef float f32x2_t __attribute__((ext_vector_type(2)));
__device__ __forceinline__ unsigned pk2(float lo, float hi) { const f32x2_t v = {lo, hi}; return __builtin_bit_cast(unsigned, __builtin_convertvector(v, bf2_t)); }
__device__ __forceinline__ float bf_lo(unsigned w) { return __builtin_bit_cast(float, w << 16); }
__device__ __forceinline__ float bf_hi(unsigned w) { return __builtin_bit_cast(float, w & 0xffff0000u); }
__device__ __forceinline__ float bf2f(bf16 b) { return __builtin_bit_cast(float, ((unsigned)b) << 16); }
__device__ __forceinline__ float silu_f(float x) { return x * __builtin_amdgcn_rcpf(1.f + __expf(-x)); }
__device__ __forceinline__ float wave_sum(float v) {
#pragma unroll
    for (int o = 1; o < 64; o <<= 1) v += __shfl_xor(v, o);
    return v;
}

#define XB_TMO      128
#define XB_XCNT(j)  (256  + 64 * (j))
#define XB_XSUB(j)  (1280 + 64 * (j))
#define XB_XGEN(j)  (2304 + 64 * (j))
#define XB_TOP      3328
#define XB_TOPGEN   3392
#define XCD_BAR_WORDS 3456
#define XB_SPIN_CAP (1u << 20)
__device__ __forceinline__ unsigned xb_ld(unsigned* p)              { return __hip_atomic_load(p, __ATOMIC_RELAXED, __HIP_MEMORY_SCOPE_AGENT); }
__device__ __forceinline__ unsigned xb_add(unsigned* p, unsigned v) { return __hip_atomic_fetch_add(p, v, __ATOMIC_RELAXED, __HIP_MEMORY_SCOPE_AGENT); }
__device__ __forceinline__ unsigned xb_xcc_id() { return (unsigned)__builtin_amdgcn_s_getreg((3 << 11) | 20) & 0xFu; }
#define XB_SPIN(cond, bar) do { unsigned _sp = 0; while (cond) { __builtin_amdgcn_s_sleep(1); \
    if ((++_sp & 255u) == 0u) { if (xb_ld(&(bar)[XB_TMO])) break; if (_sp > XB_SPIN_CAP) { atomicAdd(&(bar)[XB_TMO], 1u); break; } } } } while (0)
struct XcdBarrier { unsigned* bar; unsigned x; volatile LAS unsigned* st; };
__device__ __forceinline__ XcdBarrier xcd_barrier_post(unsigned* bar, volatile LAS unsigned* st) {
    XcdBarrier b; b.bar = bar; b.x = xb_xcc_id(); b.st = st;
    if (threadIdx.x == 0) (void)xb_add(&bar[XB_XCNT(b.x)], 1u);
    return b;
}
__device__ __forceinline__ void xcd_barrier_complete(unsigned* bar, unsigned x, unsigned& nloc, unsigned& nx) {
    const unsigned G = gridDim.x * gridDim.y * gridDim.z;
    unsigned sum, cnt, mine, sp = 0u;
    for (;;) {
        sum = 0u; cnt = 0u; mine = 0u;
#pragma unroll
        for (unsigned j = 0; j < 16; ++j) { const unsigned c = xb_ld(&bar[XB_XCNT(j)]); sum += c; cnt += (c > 0u) ? 1u : 0u; mine = (j == x) ? c : mine; }
        if (sum == G) break;
        __builtin_amdgcn_s_sleep(1);
        if ((++sp & 255u) == 0u) { if (xb_ld(&bar[XB_TMO])) break; if (sp > XB_SPIN_CAP) { atomicAdd(&bar[XB_TMO], 1u); break; } }
    }
    nloc = mine > 0u ? mine : 1u; nx = cnt > 0u ? cnt : 1u;
}
__device__ __forceinline__ void xcd_barrier(const XcdBarrier& b) {
    asm volatile("s_waitcnt vmcnt(0)" ::: "memory");
    __syncthreads();
    if (threadIdx.x == 0) {
        unsigned* bar = b.bar;
        __builtin_amdgcn_s_waitcnt(0);
        unsigned nloc = b.st[0], nx = b.st[1];
        if (nloc == 0u) { xcd_barrier_complete(bar, b.x, nloc, nx); b.st[0] = nloc; b.st[1] = nx; }
        const unsigned old = xb_add(&bar[XB_XSUB(b.x)], 1u);
        const unsigned gen = old / nloc;
        if (old + 1u == (gen + 1u) * nloc) {
            __builtin_amdgcn_fence(__ATOMIC_RELEASE, "agent");
            asm volatile("s_waitcnt vmcnt(0)" ::: "memory");
            const unsigned og = xb_add(&bar[XB_TOP], 1u);
            const unsigned tg = og / nx;
            if (og + 1u == (tg + 1u) * nx) xb_add(&bar[XB_TOPGEN], 1u);
            else XB_SPIN(xb_ld(&bar[XB_TOPGEN]) == tg, bar);
            __builtin_amdgcn_fence(__ATOMIC_ACQUIRE, "agent");
            xb_add(&bar[XB_XGEN(b.x)], 1u);
            asm volatile("s_waitcnt vmcnt(0)" ::: "memory");
        } else {
            XB_SPIN(xb_ld(&bar[XB_XGEN(b.x)]) == gen, bar);
            __builtin_amdgcn_fence(__ATOMIC_ACQUIRE, "agent");
            asm volatile("s_waitcnt vmcnt(0)" ::: "memory");
        }
    }
    __syncthreads();
}

struct Args { const float* in[19]; float* out; unsigned char* ws; int ph_lo, ph_hi; };
#ifndef PROF_ID
#define PROF_ID 0
#endif
#ifndef PROF_K
#define PROF_K 1
#endif
#define PB(id) do { if (PROF_ID == (id)) { F.pt0 = __builtin_amdgcn_s_memrealtime(); } } while (0)
#define PE(id) do { if (PROF_ID == (id)) { F.pacc += __builtin_amdgcn_s_memrealtime() - F.pt0; } } while (0)
#ifndef ABL
#define ABL 0
#endif
struct Frame {
    unsigned long long pacc, pt0; int abl;
    LAS unsigned char* lds;
    int tid, lane, wave, G, bx;
    const Args* ap;
    float* out; unsigned char* ws;
};
__device__ __forceinline__ int row0_of(int bb) { return bb < NBP ? bb * LPR : NPR + (bb - NBP) * LSA; }
__host__ __device__ __forceinline__ int k2_of_pos(int p) { return p <= 128 ? p : 384 - p; }
__device__ __forceinline__ size_t tb_of(int bb) { return bb < NBP ? (size_t)bb * 2048 * 2 * LPR : (size_t)NBP * 2048 * 2 * LPR + (size_t)(bb - NBP) * 2048 * 2 * LSA; }
__device__ __forceinline__ size_t nyq_of(int bb) { return bb < NBP ? (size_t)bb * 16 * LPR : (size_t)NBP * 16 * LPR + (size_t)(bb - NBP) * 16 * LSA; }
__device__ __forceinline__ int cond_of_row(int r) { return r < NPR ? 0 : 1 + (r - NPR) / LSA; }

namespace pg8 {
constexpr int BM = 256, BK = 64, HALF = 128, HTB = HALF * BK * 2, NXCD = 8, WGM = 8;
__host__ __device__ __forceinline__ int lds_byte(int r, int c) { const int st = (r >> 4) * 2 + (c >> 5), rr = r & 15, cc = c & 31, ob = rr * 64 + cc * 2; return st * 1024 + (ob ^ (((ob >> 9) & 1) << 5)); }
__host__ __device__ __forceinline__ void stage_rc(int b, int& R, int& C) { const int st = b / 1024, sb = b % 1024, swz = sb ^ (((sb >> 9) & 1) << 5); R = (st >> 1) * 16 + swz / 64; C = (st & 1) * 32 + (swz % 64) / 2; }
__host__ __device__ __forceinline__ int perm32(int rho) { const int n = rho >> 4, i = rho & 15; return 8 * (i >> 2) + 4 * n + (i & 3); }
struct Unit { const char* a; const char* b; int x0, x1; };
typedef f32x4 Acc[2][2][4][2];

__device__ __forceinline__ bool static_tile(int i, int G, int c, int nM, int nN, int& pm, int& pn) {
    const int nwg = nM * nN; const long L = (long)i * G + c; if (L >= nwg) return false;
    int wgid = (int)L; { const int q = nwg / NXCD, r = nwg % NXCD, xcd = wgid % NXCD, off = wgid / NXCD; wgid = (xcd < r ? xcd * (q + 1) : r * (q + 1) + (xcd - r) * q) + off; }
    const int nig = WGM * nN, gid = wgid / nig, fm = gid * WGM, gsz = (nM - fm) < WGM ? (nM - fm) : WGM;
    pm = fm + ((wgid % nig) % gsz); pn = (wgid % nig) / gsz; return true;
}

template <class Epi, class Sched, bool ALIGN_EPI, bool SP2>
__device__ __forceinline__ void gemm_phase(LAS unsigned char* lds, const int K, const int lda, const int ldb, const Sched& S, const Epi& E) {
    const int tid = threadIdx.x, wid = __builtin_amdgcn_readfirstlane(tid >> 6), lane = tid & 63, wr = wid >> 2, wc = wid & 3, fr = lane & 15, fq = lane >> 4;
    const int nt = K / BK;
    unsigned voffA[2], voffB[2];
#pragma unroll
    for (int i = 0; i < 2; ++i) { int R, C; stage_rc(tid * 16 + i * 8192, R, C); const int Rb = Epi::PERM ? ((R & ~31) + perm32(R & 31)) : R;
        voffA[i] = (unsigned)(R * lda + C) * 2u; voffB[i] = (unsigned)(Rb * ldb + C) * 2u; }
    const size_t kstep = (size_t)(BK * 2);
    const size_t hstepA = (size_t)HALF * lda * 2, hstepB = (size_t)HALF * ldb * 2;
    const unsigned ldsw = (unsigned)wid * 1024u;
    const int aoff = lds_byte(wr * 64 + fr, fq * 8), boff = lds_byte(wc * 32 + fr, fq * 8);
#define PG8_SA(b, h) (((b) * 2 + (h)) * HTB)
#define PG8_SB(b, h) ((4 + (b) * 2 + (h)) * HTB)
#define PG8_STAGE(bufoff, gbase, voff) do { _Pragma("unroll") for (int _i = 0; _i < 2; ++_i) \
        __builtin_amdgcn_global_load_lds((const unsigned*)((const char*)(gbase) + (voff)[_i]), (LAS unsigned*)(lds + (bufoff) + ldsw + _i * 8192), 16, 0, 0); } while (0)
#define PG8_LDA(dst, b, h) do { _Pragma("unroll") for (int m = 0; m < 4; ++m) _Pragma("unroll") for (int k = 0; k < 2; ++k) dst[m][k] = *(const LAS bf16x8*)(lds + PG8_SA(b, h) + aoff + m * 2048 + k * 1024); } while (0)
#define PG8_LDB(dst, b, h) do { _Pragma("unroll") for (int n = 0; n < 2; ++n) _Pragma("unroll") for (int k = 0; k < 2; ++k) dst[n][k] = *(const LAS bf16x8*)(lds + PG8_SB(b, h) + boff + n * 2048 + k * 1024); } while (0)
#define PG8_MMA(ai, bj, At, Bt) do { __builtin_amdgcn_s_setprio(1); _Pragma("unroll") for (int m = 0; m < 4; ++m) _Pragma("unroll") for (int n = 0; n < 2; ++n) _Pragma("unroll") for (int k = 0; k < 2; ++k) \
        acc[ai][bj][m][n] = __builtin_amdgcn_mfma_f32_16x16x32_bf16(Bt[n][k], At[m][k], acc[ai][bj][m][n], 0, 0, 0); __builtin_amdgcn_s_setprio(0); } while (0)
#define PG8_WAIT_V(n) asm volatile("s_waitcnt vmcnt(" #n ")" ::: "memory")
#define PG8_WAIT_L(n) asm volatile("s_waitcnt lgkmcnt(" #n ")" ::: "memory")
#define PG8_BAR __builtin_amdgcn_s_barrier()
#define PG8_SCHED __builtin_amdgcn_sched_barrier(0)
    Unit cur, nxt; int ui = 0;
    if (!S.next(0, cur)) return;
    Acc acc;
#pragma unroll
    for (int a = 0; a < 2; ++a)
#pragma unroll
        for (int b = 0; b < 2; ++b)
#pragma unroll
            for (int m = 0; m < 4; ++m)
#pragma unroll
                for (int n = 0; n < 2; ++n) acc[a][b][m][n] = (f32x4){0.f, 0.f, 0.f, 0.f};
    bf16x8 At[4][2], B0[2][2], B1[2][2];
    const char* cA = cur.a; const char* cB = cur.b;
    if constexpr (SP2) {
        PG8_STAGE(PG8_SB(0, 0), cB, voffB); PG8_STAGE(PG8_SB(0, 1), cB + hstepB, voffB); PG8_STAGE(PG8_SA(0, 0), cA, voffA); PG8_STAGE(PG8_SA(0, 1), cA + hstepA, voffA);
        if (wr == 1) PG8_BAR;
        PG8_WAIT_V(2); PG8_BAR;
        PG8_STAGE(PG8_SB(1, 0), cB + kstep, voffB); PG8_STAGE(PG8_SA(1, 0), cA + kstep, voffA); PG8_STAGE(PG8_SB(1, 1), cB + hstepB + kstep, voffB);
        PG8_WAIT_V(6); PG8_BAR;
    } else {
        PG8_STAGE(PG8_SB(0, 0), cB, voffB); PG8_STAGE(PG8_SA(0, 0), cA, voffA); PG8_STAGE(PG8_SB(0, 1), cB + hstepB, voffB); PG8_STAGE(PG8_SA(0, 1), cA + hstepA, voffA);
        if (wr == 1) PG8_BAR;
        PG8_WAIT_V(4); PG8_BAR;
        PG8_STAGE(PG8_SB(1, 0), cB + kstep, voffB); PG8_STAGE(PG8_SA(1, 0), cA + kstep, voffA); PG8_STAGE(PG8_SB(1, 1), cB + hstepB + kstep, voffB);
        PG8_WAIT_V(6); PG8_BAR;
    }
    for (;;) {
        const bool has_next = S.next(ui + 1, nxt);
        const char* nA = has_next ? nxt.a : cA; const char* nB = has_next ? nxt.b : cB;
#pragma unroll 1
        for (int t = 0; t < nt; t += 2) {
            const bool last = (t == nt - 2);
            const char* a1 = cA + (size_t)(t + 1) * kstep;
            const char* a2 = last ? nA : cA + (size_t)(t + 2) * kstep; const char* b2 = last ? nB : cB + (size_t)(t + 2) * kstep;
            const char* a3 = a2 + kstep; const char* b3 = b2 + kstep;
            if constexpr (SP2) {
            PG8_LDB(B0, 0, 0); PG8_LDB(B1, 0, 1); PG8_SCHED; PG8_LDA(At, 0, 0); PG8_STAGE(PG8_SA(1, 1), a1 + hstepA, voffA);
            PG8_WAIT_V(8); PG8_WAIT_L(0); PG8_BAR; PG8_MMA(0, 0, At, B0); PG8_MMA(0, 1, At, B1); PG8_BAR; PG8_SCHED;
            PG8_LDA(At, 0, 1); PG8_STAGE(PG8_SB(0, 0), b2, voffB); PG8_STAGE(PG8_SB(0, 1), b2 + hstepB, voffB); PG8_STAGE(PG8_SA(0, 0), a2, voffA);
            PG8_WAIT_V(8); PG8_WAIT_L(0); PG8_BAR; PG8_MMA(1, 0, At, B0); PG8_MMA(1, 1, At, B1); PG8_BAR; PG8_SCHED;
            PG8_LDB(B0, 1, 0); PG8_LDB(B1, 1, 1); PG8_SCHED; PG8_LDA(At, 1, 0); PG8_STAGE(PG8_SA(0, 1), a2 + hstepA, voffA);
            PG8_WAIT_V(8); PG8_WAIT_L(0); PG8_BAR; PG8_MMA(0, 0, At, B0); PG8_MMA(0, 1, At, B1); PG8_BAR; PG8_SCHED;
            PG8_LDA(At, 1, 1); PG8_STAGE(PG8_SB(1, 0), b3, voffB); PG8_STAGE(PG8_SB(1, 1), b3 + hstepB, voffB); PG8_STAGE(PG8_SA(1, 0), a3, voffA);
            PG8_WAIT_V(8); PG8_WAIT_L(0); PG8_BAR; PG8_MMA(1, 0, At, B0); PG8_MMA(1, 1, At, B1); PG8_BAR; PG8_SCHED;
            } else {
            PG8_LDB(B0, 0, 0); PG8_SCHED; PG8_LDA(At, 0, 0); PG8_STAGE(PG8_SA(1, 1), a1 + hstepA, voffA);
            PG8_WAIT_L(8); PG8_BAR; PG8_WAIT_L(0); PG8_MMA(0, 0, At, B0); PG8_BAR; PG8_SCHED;
            PG8_LDB(B1, 0, 1); PG8_STAGE(PG8_SB(0, 0), b2, voffB);
            PG8_BAR; PG8_WAIT_L(0); PG8_MMA(0, 1, At, B1); PG8_BAR;
            PG8_LDA(At, 0, 1); PG8_STAGE(PG8_SA(0, 0), a2, voffA);
            PG8_BAR; PG8_WAIT_L(0); PG8_MMA(1, 0, At, B0); PG8_BAR; PG8_SCHED;
            PG8_STAGE(PG8_SB(0, 1), b2 + hstepB, voffB);
            PG8_WAIT_V(6); PG8_BAR; PG8_MMA(1, 1, At, B1); PG8_BAR;
            PG8_LDB(B0, 1, 0); PG8_SCHED; PG8_LDA(At, 1, 0); PG8_STAGE(PG8_SA(0, 1), a2 + hstepA, voffA);
            PG8_WAIT_L(8); PG8_BAR; PG8_WAIT_L(0); PG8_MMA(0, 0, At, B0); PG8_BAR; PG8_SCHED;
            PG8_LDB(B1, 1, 1); PG8_STAGE(PG8_SB(1, 0), b3, voffB);
            PG8_BAR; PG8_WAIT_L(0); PG8_MMA(0, 1, At, B1); PG8_BAR;
            PG8_LDA(At, 1, 1); PG8_STAGE(PG8_SA(1, 0), a3, voffA);
            PG8_BAR; PG8_WAIT_L(0); PG8_MMA(1, 0, At, B0); PG8_BAR; PG8_SCHED;
            PG8_STAGE(PG8_SB(1, 1), b3 + hstepB, voffB);
            PG8_WAIT_V(6); PG8_BAR; PG8_MMA(1, 1, At, B1); PG8_BAR;
            }
        }
        if constexpr (ALIGN_EPI) { if (wr == 0) PG8_BAR; }
        E(acc, cur, wr, wc, fr, fq);
        if (!has_next) break;
#pragma unroll
        for (int a = 0; a < 2; ++a)
#pragma unroll
            for (int b = 0; b < 2; ++b)
#pragma unroll
                for (int m = 0; m < 4; ++m)
#pragma unroll
                    for (int n = 0; n < 2; ++n) acc[a][b][m][n] = (f32x4){0.f, 0.f, 0.f, 0.f};
        cur = nxt; cA = nA; cB = nB; ++ui;
        if constexpr (ALIGN_EPI) { if (wr == 1) PG8_BAR; }
    }
    PG8_WAIT_V(0);
    if constexpr (!ALIGN_EPI) { if (wr == 0) PG8_BAR; }
    PG8_BAR;
#undef PG8_SA
#undef PG8_SB
#undef PG8_STAGE
#undef PG8_LDA
#undef PG8_LDB
#undef PG8_MMA
#undef PG8_WAIT_V
#undef PG8_WAIT_L
#undef PG8_BAR
#undef PG8_SCHED
}
}
using pg8::Unit; using pg8::Acc;
constexpr bool GP_ALIGN = true, GP_SP2 = true;

struct SchedGrid {
    const bf16* A; const bf16* B; int nM, nN, lda, ldb, G, c;
    __device__ __forceinline__ bool next(int i, Unit& u) const { int pm, pn; if (!pg8::static_tile(i, G, c, nM, nN, pm, pn)) return false;
        u.a = (const char*)(A + (size_t)pm * 256 * lda); u.b = (const char*)(B + (size_t)pn * 256 * ldb); u.x0 = pm; u.x1 = pn; return true; }
};
struct SchedOne {
    const bf16* A; const bf16* B; int pm, pn, lda, ldb;
    __device__ __forceinline__ bool next(int i, Unit& u) const { if (i != 0 || pm < 0) return false;
        u.a = (const char*)(A + (size_t)pm * 256 * lda); u.b = (const char*)(B + (size_t)pn * 256 * ldb); u.x0 = pm; u.x1 = pn; return true; }
};
struct EpiUZ { static constexpr bool PERM = true; bf16* U; bf16* Z;
    __device__ __forceinline__ void operator()(const Acc& acc, const Unit& u, int wr, int wc, int fr, int fq) const {
        const int pm = u.x0, pn = u.x1; const bool isz = pn >= 16; bf16* base = isz ? Z : U; const int colt = (isz ? pn - 16 : pn) * 256 + wc * 32 + 8 * fq;
#pragma unroll
        for (int ai = 0; ai < 2; ++ai)
#pragma unroll
            for (int m = 0; m < 4; ++m) { const int r = pm * 256 + ai * 128 + wr * 64 + m * 16 + fr; bf16* rowp = base + (size_t)r * FW + colt;
#pragma unroll
                for (int bj = 0; bj < 2; ++bj) { f32x4 v0 = acc[ai][bj][m][0], v1 = acc[ai][bj][m][1];
                    if (isz) {
#pragma unroll
                        for (int j = 0; j < 4; ++j) { v0[j] = silu_f(v0[j]); v1[j] = silu_f(v1[j]); } }
                    v4u w; w.x = pk2(v0[0], v0[1]); w.y = pk2(v0[2], v0[3]); w.z = pk2(v1[0], v1[1]); w.w = pk2(v1[2], v1[3]);
                    *(v4u*)(rowp + bj * 128) = w; } }
    } };
struct SchedCDFT { const bf16* D; const bf16* U; int G, c;
    __device__ __forceinline__ bool next(int i, Unit& u) const { const long e = (long)i * G + c; if (e >= 1024) return false;
        const int q = (int)e; int bb, g, tn;
        if (q < 512) { bb = q >> 4; g = q & 15; tn = 0; } else { const int q2 = q - 512; bb = NBP + (q2 >> 6); g = (q2 >> 2) & 15; tn = q2 & 3; }
        u.a = (const char*)D; u.b = (const char*)(U + ((size_t)(row0_of(bb) + tn * 256) * FW + g * 256));
        u.x0 = bb | (g << 8) | (tn << 20); u.x1 = 0; return true; } };
struct EpiCDFT { static constexpr bool PERM = true; bf16* T; bf16* NYQ;
    __device__ __forceinline__ void operator()(const Acc& acc, const Unit& u, int wr, int wc, int fr, int fq) const {
        const int bb = u.x0 & 255, g = (u.x0 >> 8) & 255, tn = u.x0 >> 20; const int L = bb < NBP ? LPR : LSA;
        bf16* base = T + tb_of(bb) + (size_t)(g * 128) * (2 * L) + tn * 256;
        bf16* nq = NYQ + nyq_of(bb) + (size_t)g * L + tn * 256;
        const unsigned L2 = 2u * (unsigned)L; const unsigned coff = (unsigned)(wc * 32 + 8 * fq);
#pragma unroll
        for (int ai = 0; ai < 2; ++ai)
#pragma unroll
            for (int m = 0; m < 4; ++m) { const int k2 = wr * 64 + m * 16 + fr;
                const unsigned off = (unsigned)k2 * L2 + (unsigned)(ai * L) + coff; const bool nyq = (ai == 1) && (k2 == 0);
#pragma unroll
                for (int bj = 0; bj < 2; ++bj) { const f32x4 v0 = acc[ai][bj][m][0], v1 = acc[ai][bj][m][1];
                    v4u w; w.x = pk2(v0[0], v0[1]); w.y = pk2(v0[2], v0[3]); w.z = pk2(v1[0], v1[1]); w.w = pk2(v1[2], v1[3]);
                    if (nyq) { *(v4u*)(nq + coff + bj * 128) = w; w = (v4u){0u, 0u, 0u, 0u}; }
                    *(v4u*)(base + off + bj * 128) = w; }
                asm volatile("" ::: "memory"); }
    } };
struct SchedLDFT { const bf16* A4; const bf16* T; int sample, G, c;
    __device__ __forceinline__ bool next(int i, Unit& u) const { const long e = (long)i * G + c; if (e >= 256) return false; int bb, pm, pn;
        if (sample) { bb = NBP + ((int)e >> 5); pm = ((int)e >> 3) & 3; pn = (int)e & 7; } else { bb = (int)e >> 3; pm = 0; pn = (int)e & 7; }
        const int L2 = sample ? 2 * LSA : 2 * LPR;
        u.a = (const char*)(A4 + (size_t)pm * 256 * L2); u.b = (const char*)(T + tb_of(bb) + (size_t)pn * 256 * L2);
        u.x0 = bb | (pm << 8); u.x1 = pn; return true; } };
struct EpiLDFT { static constexpr bool PERM = true; const bf16* Z; bf16* YG; float sc;
    __device__ __forceinline__ void operator()(const Acc& acc, const Unit& u, int wr, int wc, int fr, int fq) const {
        const int bb = u.x0 & 255, pm = u.x0 >> 8, pn = u.x1; const int L = bb < NBP ? LPR : LSA, r0 = row0_of(bb);
        const int k2 = wc * 32 + 8 * fq;
#pragma unroll
        for (int ai = 0; ai < 2; ++ai) { v4u zd[4][2], zm[4][2];
#pragma unroll
            for (int m = 0; m < 4; ++m) { const int k1 = pm * 256 + ai * 128 + wr * 64 + m * 16 + fr; const int k1m = (L - k1) & (L - 1);
#pragma unroll
                for (int bj = 0; bj < 2; ++bj) { const int gc = (2 * pn + bj) * 256; zd[m][bj] = *(const v4u*)(Z + (size_t)(r0 + k1) * FW + k2 + gc); zm[m][bj] = *(const v4u*)(Z + (size_t)(r0 + k1m) * FW + 128 + k2 + gc); } }
#pragma unroll
            for (int m = 0; m < 4; ++m) { const int k1 = pm * 256 + ai * 128 + wr * 64 + m * 16 + fr; const int k1m = (L - k1) & (L - 1);
                const size_t od = (size_t)(r0 + k1) * FW + k2, om = (size_t)(r0 + k1m) * FW + 128 + k2;
#pragma unroll
                for (int bj = 0; bj < 2; ++bj) { const f32x4 v0 = acc[ai][bj][m][0] * sc, v1 = acc[ai][bj][m][1] * sc; const int gc = (2 * pn + bj) * 256;
                    { const v4u z = zd[m][bj];
                      v4u w; w.x = pk2(v0[0] * bf_lo(z.x), v0[1] * bf_hi(z.x)); w.y = pk2(v0[2] * bf_lo(z.y), v0[3] * bf_hi(z.y));
                      w.z = pk2(v1[0] * bf_lo(z.z), v1[1] * bf_hi(z.z)); w.w = pk2(v1[2] * bf_lo(z.w), v1[3] * bf_hi(z.w));
                      *(v4u*)(YG + od + gc) = w; }
                    { const v4u z = zm[m][bj];
                      v4u w; w.x = pk2(v0[0] * bf_lo(z.x), v0[1] * bf_hi(z.x)); w.y = pk2(v0[2] * bf_lo(z.y), v0[3] * bf_hi(z.y));
                      w.z = pk2(v1[0] * bf_lo(z.z), v1[1] * bf_hi(z.z)); w.w = pk2(v1[2] * bf_lo(z.w), v1[3] * bf_hi(z.w));
                      bf16* d = YG + om + gc;
                      if (k2 != 0) *(v4u*)d = w;
                      else { d[1] = (bf16)(w.x >> 16); *(unsigned*)(d + 2) = w.y; *(v2u*)(d + 4) = (v2u){w.z, w.w}; } }
                } }
            asm volatile("" ::: "memory"); }
    } };
struct EpiRes0 { static constexpr bool PERM = true; const float* xp; const float* xs; const float* pos; const float* mod0; bf16* V;
    __device__ __forceinline__ void operator()(const Acc& acc, const Unit& u, int wr, int wc, int fr, int fq) const {
        const int pm = u.x0, pn = u.x1; const int rt = pm * 256; const bool smp = rt >= NPR;
        const float* gate = mod0 + (size_t)cond_of_row(rt) * 6144 + 4096;
        const int col0 = pn * 256 + wc * 32 + 8 * fq;
        f32x4 gv[2][2];
#pragma unroll
        for (int bj = 0; bj < 2; ++bj)
#pragma unroll
            for (int n = 0; n < 2; ++n) gv[bj][n] = *(const f32x4*)(gate + col0 + bj * 128 + n * 4);
#pragma unroll
        for (int ai = 0; ai < 2; ++ai)
#pragma unroll
            for (int mp = 0; mp < 2; ++mp) { f32x4 x0[2][2][2], pv[2][2][2];
#pragma unroll
                for (int mm = 0; mm < 2; ++mm) { const int r = rt + ai * 128 + wr * 64 + (2 * mp + mm) * 16 + fr;
                    const float* xr = smp ? xs + (size_t)(r - NPR) * DM : xp + (size_t)r * DM; const float* pr = pos + (size_t)((r - NPR) & (LSA - 1)) * DM;
#pragma unroll
                    for (int bj = 0; bj < 2; ++bj)
#pragma unroll
                        for (int n = 0; n < 2; ++n) { const int cc = col0 + bj * 128 + n * 4; x0[mm][bj][n] = *(const f32x4*)(xr + cc); pv[mm][bj][n] = smp ? *(const f32x4*)(pr + cc) : (f32x4){0.f, 0.f, 0.f, 0.f}; } }
#pragma unroll
                for (int mm = 0; mm < 2; ++mm) { const int m = 2 * mp + mm; const int r = rt + ai * 128 + wr * 64 + m * 16 + fr;
#pragma unroll
                    for (int bj = 0; bj < 2; ++bj) { const f32x4 v0 = (x0[mm][bj][0] + pv[mm][bj][0]) * DN_ALPHA + gv[bj][0] * acc[ai][bj][m][0], v1 = (x0[mm][bj][1] + pv[mm][bj][1]) * DN_ALPHA + gv[bj][1] * acc[ai][bj][m][1];
                        v4u w; w.x = pk2(v0[0], v0[1]); w.y = pk2(v0[2], v0[3]); w.z = pk2(v1[0], v1[1]); w.w = pk2(v1[2], v1[3]);
                        *(v4u*)(V + (size_t)r * DM + col0 + bj * 128) = w; } }
                asm volatile("" ::: "memory"); }
    } };
struct EpiProj { static constexpr bool PERM = true; bf16* Z; bf16* XBC; float* DT;
    __device__ __forceinline__ void operator()(const Acc& acc, const Unit& u, int wr, int wc, int fr, int fq) const {
        const int pm = u.x0, pn = u.x1;
#pragma unroll
        for (int ai = 0; ai < 2; ++ai)
#pragma unroll
            for (int m = 0; m < 4; ++m) { const int r = pm * 256 + ai * 128 + wr * 64 + m * 16 + fr;
#pragma unroll
                for (int bj = 0; bj < 2; ++bj) { f32x4 v0 = acc[ai][bj][m][0], v1 = acc[ai][bj][m][1]; const int cl = bj * 128 + wc * 32 + 8 * fq;
                    if (pn < 16) {
#pragma unroll
                        for (int j = 0; j < 4; ++j) { v0[j] = silu_f(v0[j]); v1[j] = silu_f(v1[j]); }
                        v4u w; w.x = pk2(v0[0], v0[1]); w.y = pk2(v0[2], v0[3]); w.z = pk2(v1[0], v1[1]); w.w = pk2(v1[2], v1[3]);
                        *(v4u*)(Z + (size_t)r * FW + pn * 256 + cl) = w;
                    } else if (pn < 40) {
                        v4u w; w.x = pk2(v0[0], v0[1]); w.y = pk2(v0[2], v0[3]); w.z = pk2(v1[0], v1[1]); w.w = pk2(v1[2], v1[3]);
                        *(v4u*)(XBC + (size_t)r * CONVD + (pn - 16) * 256 + cl) = w;
                    } else if (bj == 0) {
                        *(f32x4*)(DT + (size_t)r * 128 + cl) = v0; *(f32x4*)(DT + (size_t)r * 128 + cl + 4) = v1;
                    } } }
    } };
struct EpiRes1 { static constexpr bool PERM = true; const float* mod1; const float* SSQ; bf16* V;
    __device__ __forceinline__ void operator()(const Acc& acc, const Unit& u, int wr, int wc, int fr, int fq) const {
        const int pm = u.x0, pn = u.x1; const int rt = pm * 256;
        const float* gate = mod1 + (size_t)cond_of_row(rt) * 6144 + 4096;
        const int col0 = pn * 256 + wc * 32 + 8 * fq;
        f32x4 gv[2][2];
#pragma unroll
        for (int bj = 0; bj < 2; ++bj)
#pragma unroll
            for (int n = 0; n < 2; ++n) gv[bj][n] = *(const f32x4*)(gate + col0 + bj * 128 + n * 4);
#pragma unroll
        for (int ai = 0; ai < 2; ++ai) { v4u x1[4][2]; float ss[4];
#pragma unroll
            for (int m = 0; m < 4; ++m) { const int r = rt + ai * 128 + wr * 64 + m * 16 + fr; ss[m] = SSQ[r];
#pragma unroll
                for (int bj = 0; bj < 2; ++bj) x1[m][bj] = *(const v4u*)(V + (size_t)r * DM + col0 + bj * 128); }
#pragma unroll
            for (int m = 0; m < 4; ++m) { const int r = rt + ai * 128 + wr * 64 + m * 16 + fr; const float rs = 1.0f / sqrtf(ss[m] * (1.0f / FW) + LN_EPS);
#pragma unroll
                for (int bj = 0; bj < 2; ++bj) { const v4u xw = x1[m][bj]; const f32x4 a0 = acc[ai][bj][m][0] * rs, a1 = acc[ai][bj][m][1] * rs;
                    v4u w; w.x = pk2(bf_lo(xw.x) * DN_ALPHA + gv[bj][0][0] * a0[0], bf_hi(xw.x) * DN_ALPHA + gv[bj][0][1] * a0[1]);
                    w.y = pk2(bf_lo(xw.y) * DN_ALPHA + gv[bj][0][2] * a0[2], bf_hi(xw.y) * DN_ALPHA + gv[bj][0][3] * a0[3]);
                    w.z = pk2(bf_lo(xw.z) * DN_ALPHA + gv[bj][1][0] * a1[0], bf_hi(xw.z) * DN_ALPHA + gv[bj][1][1] * a1[1]);
                    w.w = pk2(bf_lo(xw.w) * DN_ALPHA + gv[bj][1][2] * a1[2], bf_hi(xw.w) * DN_ALPHA + gv[bj][1][3] * a1[3]);
                    *(v4u*)(V + (size_t)r * DM + col0 + bj * 128) = w; } }
            asm volatile("" ::: "memory"); }
    } };

template <int MODE>
__device__ __forceinline__ void p0_transpose_item(const float* W, int K, int N, bf16* WT, LAS float* scr, int item, int lane) {
    const int nblk = N / 64, kb = item / nblk, nb = item % nblk, k0 = 64 * kb, n0 = 64 * nb;
    const int c4 = (lane & 15) * 4, r4 = lane >> 4;
    f32x4 v[16];
#pragma unroll
    for (int i = 0; i < 16; ++i) { int kr = k0 + r4 + 4 * i; if (MODE == 2) kr = (kr & ~255) + k2_of_pos(kr & 255);
        v[i] = *(const f32x4*)(W + (size_t)kr * N + n0 + c4); }
#pragma unroll
    for (int i = 0; i < 16; ++i) { LAS float* d = scr + (r4 + 4 * i) * 65 + c4; d[0] = v[i][0]; d[1] = v[i][1]; d[2] = v[i][2]; d[3] = v[i][3]; }
    LDS_WAIT(); asm volatile("" ::: "memory");
    const int c = lane & 7;
#pragma unroll
    for (int j = 0; j < 8; ++j) { const int n = (lane >> 3) + 8 * j; const LAS float* sp = scr + (8 * c) * 65 + n;
        v4u o; o.x = pk2(sp[0 * 65], sp[1 * 65]); o.y = pk2(sp[2 * 65], sp[3 * 65]); o.z = pk2(sp[4 * 65], sp[5 * 65]); o.w = pk2(sp[6 * 65], sp[7 * 65]);
        int nr = n0 + n; if (MODE == 1 && nr >= FW) nr = (nr & ~255) + k2_of_pos(nr & 255);
        *(v4u*)(WT + (size_t)nr * K + k0 + 8 * c) = o; }
    LDS_WAIT(); asm volatile("" ::: "memory");
}
__device__ __forceinline__ void p0_prologue(Frame& F) {
    const int gw = F.bx * NWAVES + F.wave, NGW = F.G * NWAVES;
    const size_t gt = (size_t)F.bx * NTHR + F.tid, NGT = (size_t)F.G * NTHR;
    LAS float* sc = (LAS float*)F.lds;
    for (int i = F.tid; i < 9 * DM; i += NTHR) { const float v = i < DM ? F.ap->in[4][i] : F.ap->in[3][i - DM]; sc[i] = silu_f(v); }
    __syncthreads();
    float* mod = (float*)(F.ws + WS_MOD);
    LAS float* part = (LAS float*)(F.lds + 9 * DM * 4);
    for (int it = F.bx; it < 2 * 96; it += F.G) {
        const int cb = it % 96, layer = it / 96; const int n = cb * 64 + F.lane; const float* wp = F.ap->in[5] + ((size_t)layer * DM + F.wave * 256) * 6144 + n;
        float a[9];
#pragma unroll
        for (int r = 0; r < 9; ++r) a[r] = 0.f;
#pragma unroll 16
        for (int k = 0; k < 256; ++k) { const float w = wp[(size_t)k * 6144];
#pragma unroll
            for (int r = 0; r < 9; ++r) a[r] += sc[r * DM + F.wave * 256 + k] * w; }
#pragma unroll
        for (int r = 0; r < 9; ++r) part[(F.wave * 9 + r) * 64 + F.lane] = a[r];
        __syncthreads();
        for (int o = F.tid; o < 9 * 64; o += NTHR) { float t = F.ap->in[6][layer * 6144 + cb * 64 + (o & 63)];
#pragma unroll
            for (int w = 0; w < 8; ++w) t += part[w * 576 + o];
            mod[((size_t)layer * 9 + (o >> 6)) * 6144 + cb * 64 + (o & 63)] = t; }
        __syncthreads();
    }
    __syncthreads();
    LAS float* scr = (LAS float*)(F.lds + F.wave * 16896);
    constexpr int I_FI = (DM / 64) * (8192 / 64);
    for (int it = gw; it < I_FI; it += NGW) p0_transpose_item<1>(F.ap->in[9], DM, 8192, (bf16*)(F.ws + WS_WFI), scr, it, F.lane);
    { bf16* D = (bf16*)(F.ws + WS_D256);
      for (size_t i = gt; i < 256 * 256; i += NGT) { const int j = (int)(i >> 8), n = (int)i & 255; const int idx = ((j & 127) * n) & 255; float sn, cs; sincospif((float)idx * (1.0f / 128.0f), &sn, &cs);
          D[i] = (bf16)f2bf(j < 128 ? cs : (j == 128 ? ((n & 1) ? -1.0f : 1.0f) : sn)); } }
    { bf16* A = (bf16*)(F.ws + WS_A4P);
      for (size_t i = gt; i < 256 * 512; i += NGT) { const int k = (int)(i >> 9), kk = (int)i & 511; const int idx = (k * (kk & 255)) & 255; float s, c; sincospif((float)idx * (1.0f / 128.0f), &s, &c); A[i] = (bf16)f2bf(kk < 256 ? c : -s); } }
    { bf16* A = (bf16*)(F.ws + WS_A4S);
      for (size_t i = gt; i < (size_t)1024 * 2048; i += NGT) { const int k = (int)(i >> 11), kk = (int)i & 2047; const int idx = (k * (kk & 1023)) & 1023; float s, c; sincospif((float)idx * (1.0f / 512.0f), &s, &c); A[i] = (bf16)f2bf(kk < 1024 ? c : -s); } }
    { float* P = (float*)(F.ws + WS_POS);
      for (size_t i = gt; i < (size_t)LSA * DM; i += NGT) { const int t = (int)(i >> 11), j = (int)i & 2047; const int qd = j >> 9, ii = j & 511; const int p = qd < 2 ? (t >> 6) : (t & 63);
          const float om = expf(-9.210340371976184f * (float)ii * (1.0f / 512.0f)); const float ang = (float)p * om; P[i] = (qd & 1) ? cosf(ang) : sinf(ang); } }
}

__device__ __forceinline__ void p0_late_weights(Frame& F) {
    const int gw = F.bx * NWAVES + F.wave, NGW = F.G * NWAVES; const size_t gt = (size_t)F.bx * NTHR + F.tid, NGT = (size_t)F.G * NTHR;
    LAS float* scr = (LAS float*)(F.lds + F.wave * 16896);
    constexpr int I_FO = (FW / 64) * (DM / 64), I_SI = (DM / 64) * (SSD_IN / 64), I_SO = (FW / 64) * (DM / 64);
    __syncthreads();
    for (int it = gw; it < I_FO + I_SI + I_SO; it += NGW) {
        int r = it;
        if (r < I_FO) { p0_transpose_item<2>(F.ap->in[10], FW, DM, (bf16*)(F.ws + WS_WFO), scr, r, F.lane); continue; } r -= I_FO;
        if (r < I_SI) { p0_transpose_item<0>(F.ap->in[11], DM, SSD_IN, (bf16*)(F.ws + WS_WSI), scr, r, F.lane); continue; } r -= I_SI;
        p0_transpose_item<0>(F.ap->in[18], FW, DM, (bf16*)(F.ws + WS_WSO), scr, r, F.lane);
    }
    { v4u* zp = (v4u*)((bf16*)(F.ws + WS_WSI) + (size_t)SSD_IN * DM); const size_t nz = (size_t)(SSD_IN_PAD - SSD_IN) * DM / 8;
      for (size_t i = gt; i < nz; i += NGT) zp[i] = (v4u){0u, 0u, 0u, 0u}; }
    __syncthreads();
}

__device__ __forceinline__ void p4_nyquist(Frame& F) {
    const bf16* NYQ = (const bf16*)(F.ws + WS_NYQ); const bf16* Z = (const bf16*)(F.ws + WS_Z); bf16* YG = (bf16*)(F.ws + WS_U);
    LAS bf16* nl = (LAS bf16*)F.lds;
    for (int item = F.bx; item < 256; item += F.G) {
        int bb, kb; if (item < 128) { bb = NBP + (item >> 4); kb = item & 15; } else { bb = (item - 128) >> 2; kb = (item - 128) & 3; }
        const int L = bb < NBP ? LPR : LSA; const float sc = bb < NBP ? 1.0f / 256.0f : 1.0f / 512.0f;
        const bf16* A4 = (const bf16*)(F.ws + (bb < NBP ? WS_A4P : WS_A4S));
        __syncthreads();
        for (int i = F.tid; i < 16 * L / 8; i += NTHR) *(LAS v4u*)(nl + 8 * i) = *(const v4u*)(NYQ + nyq_of(bb) + 8 * i);
        __syncthreads();
        const int k1 = kb * 64 + (F.tid >> 3), g0 = (F.tid & 7) * 2; const bf16* ar = A4 + (size_t)k1 * (2 * L);
        float a0 = 0.f, a1 = 0.f;
        for (int n = 0; n < L; n += 8) { const v4u c = *(const v4u*)(ar + n); const v4u x0 = *(const LAS v4u*)(nl + g0 * L + n), x1 = *(const LAS v4u*)(nl + (g0 + 1) * L + n);
            a0 += bf_lo(c.x) * bf_lo(x0.x) + bf_hi(c.x) * bf_hi(x0.x) + bf_lo(c.y) * bf_lo(x0.y) + bf_hi(c.y) * bf_hi(x0.y) + bf_lo(c.z) * bf_lo(x0.z) + bf_hi(c.z) * bf_hi(x0.z) + bf_lo(c.w) * bf_lo(x0.w) + bf_hi(c.w) * bf_hi(x0.w);
            a1 += bf_lo(c.x) * bf_lo(x1.x) + bf_hi(c.x) * bf_hi(x1.x) + bf_lo(c.y) * bf_lo(x1.y) + bf_hi(c.y) * bf_hi(x1.y) + bf_lo(c.z) * bf_lo(x1.z) + bf_hi(c.z) * bf_hi(x1.z) + bf_lo(c.w) * bf_lo(x1.w) + bf_hi(c.w) * bf_hi(x1.w); }
        const size_t o = (size_t)(row0_of(bb) + k1) * FW + g0 * 256 + 128;
        YG[o] = (bf16)f2bf(a0 * sc * bf2f(Z[o])); YG[o + 256] = (bf16)f2bf(a1 * sc * bf2f(Z[o + 256]));
    }
    __syncthreads();
}

__device__ __forceinline__ void row_stats(const f32x4 (&v)[8], float& mean, float& rstd) {
    float s = 0.f;
#pragma unroll
    for (int j = 0; j < 8; ++j) s += (v[j][0] + v[j][1]) + (v[j][2] + v[j][3]);
    mean = wave_sum(s) * (1.f / DM); float s2 = 0.f;
#pragma unroll
    for (int j = 0; j < 8; ++j) { const f32x4 d = v[j] - mean; s2 += (d[0] * d[0] + d[1] * d[1]) + (d[2] * d[2] + d[3] * d[3]); }
    rstd = 1.f / sqrtf(wave_sum(s2) * (1.f / DM) + LN_EPS);
}
struct ModRow { f32x4 sh[8], sc[8]; };
__device__ __forceinline__ void mod_load(ModRow& m, const float* modrow, int lane) {
    const f32x4* sh = (const f32x4*)modrow + lane; const f32x4* scp = (const f32x4*)(modrow + DM) + lane;
#pragma unroll
    for (int j = 0; j < 8; ++j) { m.sh[j] = sh[64 * j]; m.sc[j] = scp[64 * j]; }
}
__device__ __forceinline__ void modulate_store(const f32x4 (&v)[8], float mean, float rstd, const ModRow& m, bf16* hrow, int lane) {
    v2u* o = (v2u*)hrow + lane;
#pragma unroll
    for (int j = 0; j < 8; ++j) { const f32x4 y = (v[j] - mean) * rstd * (m.sc[j] + 1.0f) + m.sh[j]; v2u w; w.x = pk2(y[0], y[1]); w.y = pk2(y[2], y[3]); o[64 * j] = w; }
}
__device__ __forceinline__ void p1_load(Frame& F, int r, const float* pos, f32x4 (&v)[8], f32x4 (&p)[8]) {
    const bool smp = r >= NPR; const f32x4* xr = (const f32x4*)(smp ? F.ap->in[1] + (size_t)(r - NPR) * DM : F.ap->in[0] + (size_t)r * DM) + F.lane;
    const f32x4* pr = (const f32x4*)(pos + (size_t)((r - NPR) & (LSA - 1)) * DM) + F.lane;
#pragma unroll
    for (int j = 0; j < 8; ++j) { v[j] = xr[64 * j]; p[j] = smp ? pr[64 * j] : (f32x4){0.f, 0.f, 0.f, 0.f}; }
}
__device__ __forceinline__ void p1_ln_mod(Frame& F) {
    const int gw = F.bx * NWAVES + F.wave, NGW = F.G * NWAVES; const float* mod0 = (const float*)(F.ws + WS_MOD); const float* pos = (const float*)(F.ws + WS_POS); bf16* H = (bf16*)(F.ws + WS_H);
    f32x4 v[8], p[8], vn[8], pn[8];
    if (gw < NTOK) p1_load(F, gw, pos, v, p);
    for (int r = gw; r < NTOK; r += NGW) {
        const int rn = r + NGW; if (rn < NTOK) p1_load(F, rn, pos, vn, pn);
        ModRow m; mod_load(m, mod0 + (size_t)cond_of_row(r) * 6144, F.lane);
#pragma unroll
        for (int j = 0; j < 8; ++j) v[j] = v[j] + p[j];
        float mean, rstd; row_stats(v, mean, rstd);
        modulate_store(v, mean, rstd, m, H + (size_t)r * DM, F.lane);
#pragma unroll
        for (int j = 0; j < 8; ++j) { v[j] = vn[j]; p[j] = pn[j]; }
    }
}
__device__ __forceinline__ void v_unpack(const v2u (&w)[8], f32x4 (&v)[8]) {
#pragma unroll
    for (int j = 0; j < 8; ++j) v[j] = (f32x4){bf_lo(w[j].x), bf_hi(w[j].x), bf_lo(w[j].y), bf_hi(w[j].y)};
}
__device__ __forceinline__ void p6_ln_ln_mod(Frame& F) {
    const int gw = F.bx * NWAVES + F.wave, NGW = F.G * NWAVES; const float* mod1 = (const float*)(F.ws + WS_MOD) + 9 * 6144; bf16* V = (bf16*)(F.ws + WS_V); bf16* H = (bf16*)(F.ws + WS_H);
    f32x4 gp[8], bp[8];
#pragma unroll
    for (int j = 0; j < 8; ++j) { gp[j] = ((const f32x4*)F.ap->in[7] + F.lane)[64 * j]; bp[j] = ((const f32x4*)F.ap->in[8] + F.lane)[64 * j]; }
    v2u w[8], wn[8]; f32x4 v[8];
    if (gw < NTOK) { const v2u* vr = (const v2u*)(V + (size_t)gw * DM) + F.lane;
#pragma unroll
        for (int j = 0; j < 8; ++j) w[j] = vr[64 * j]; }
    for (int r = gw; r < NTOK; r += NGW) {
        const int rn = r + NGW; if (rn < NTOK) { const v2u* vr = (const v2u*)(V + (size_t)rn * DM) + F.lane;
#pragma unroll
            for (int j = 0; j < 8; ++j) wn[j] = vr[64 * j]; }
        v2u* vw = (v2u*)(V + (size_t)r * DM) + F.lane;
        ModRow m; mod_load(m, mod1 + (size_t)cond_of_row(r) * 6144, F.lane);
        v_unpack(w, v);
        float mean, rstd; row_stats(v, mean, rstd);
#pragma unroll
        for (int j = 0; j < 8; ++j) { v[j] = (v[j] - mean) * rstd * gp[j] + bp[j]; v2u o; o.x = pk2(v[j][0], v[j][1]); o.y = pk2(v[j][2], v[j][3]); vw[64 * j] = o; }
        row_stats(v, mean, rstd);
        modulate_store(v, mean, rstd, m, H + (size_t)r * DM, F.lane);
#pragma unroll
        for (int j = 0; j < 8; ++j) w[j] = wn[j];
    }
}
__device__ __forceinline__ void p11_final_ln(Frame& F) {
    const int gw = F.bx * NWAVES + F.wave, NGW = F.G * NWAVES; const bf16* V = (const bf16*)(F.ws + WS_V);
    f32x4 gp[8], bp[8];
#pragma unroll
    for (int j = 0; j < 8; ++j) { gp[j] = ((const f32x4*)(F.ap->in[7] + DM) + F.lane)[64 * j]; bp[j] = ((const f32x4*)(F.ap->in[8] + DM) + F.lane)[64 * j]; }
    v2u w[8], wn[8]; f32x4 v[8];
    if (gw < NTOK) { const v2u* vr = (const v2u*)(V + (size_t)gw * DM) + F.lane;
#pragma unroll
        for (int j = 0; j < 8; ++j) w[j] = vr[64 * j]; }
    for (int r = gw; r < NTOK; r += NGW) {
        const int rn = r + NGW; if (rn < NTOK) { const v2u* vr = (const v2u*)(V + (size_t)rn * DM) + F.lane;
#pragma unroll
            for (int j = 0; j < 8; ++j) wn[j] = vr[64 * j]; }
        f32x4* o = (f32x4*)(F.out + (size_t)r * DM) + F.lane;
        v_unpack(w, v);
        float mean, rstd; row_stats(v, mean, rstd);
#pragma unroll
        for (int j = 0; j < 8; ++j) o[64 * j] = (v[j] - mean) * rstd * gp[j] + bp[j];
#pragma unroll
        for (int j = 0; j < 8; ++j) w[j] = wn[j];
    }
}
struct ConvIn { v4u raw[8]; f32x4 w[5][2], bias[2]; };
__device__ __forceinline__ void p8_load(Frame& F, const bf16* XBC, int item, int co, int tr, ConvIn& c) {
    const int tb = item / 192, cb = item % 192; const int t0 = tb * 64;
    const int lo = t0 < NPR ? (t0 & ~(LPR - 1)) : NPR + ((t0 - NPR) & ~(LSA - 1)); const int hi = lo + (t0 < NPR ? LPR : LSA);
    const int ch = cb * 32 + co * 8; const int tq = t0 + 4 * tr;
#pragma unroll
    for (int k = 0; k < 5; ++k) { c.w[k][0] = *(const f32x4*)(F.ap->in[12] + (size_t)k * CONVD + ch); c.w[k][1] = *(const f32x4*)(F.ap->in[12] + (size_t)k * CONVD + ch + 4); }
    c.bias[0] = *(const f32x4*)(F.ap->in[13] + ch); c.bias[1] = *(const f32x4*)(F.ap->in[13] + ch + 4);
#pragma unroll
    for (int k = 0; k < 8; ++k) { const int tt = tq + k - 2; c.raw[k] = (v4u){0u, 0u, 0u, 0u}; if (tt >= lo && tt < hi) c.raw[k] = *(const v4u*)(XBC + (size_t)tt * CONVD + ch); }
}
__device__ __forceinline__ void p8_conv(Frame& F) {
    const bf16* XBC = (const bf16*)(F.ws + WS_XBC); bf16* XT = (bf16*)(F.ws + WS_XT); bf16* BN = (bf16*)(F.ws + WS_BN); bf16* CN = (bf16*)(F.ws + WS_CN); bf16* BT = (bf16*)(F.ws + WS_BT);
    LAS bf16* tile = (LAS bf16*)(F.lds + F.wave * 4096);
    const int co = F.lane & 3, tr = F.lane >> 2;
    const bool bal = F.G == 256; const int NIT = (NTOK / 64) * 192; constexpr int NDT = 14 * 512;
    const int i0 = bal ? (F.bx < 64 ? F.bx * 8 + F.wave : NDT + (F.bx - 64) * 8 + F.wave) : F.bx * 8 + F.wave, istep = bal ? (F.bx < 64 ? 512 : 1536) : F.G * 8, iend = bal && F.bx < 64 ? NDT : NIT;
    ConvIn cur, nxt;
    if (i0 < iend) p8_load(F, XBC, i0, co, tr, cur);
    for (int item = i0; item < iend; item += istep) {
        const int tb = item / 192, cb = item % 192; const int t0 = tb * 64;
        if (item + istep < iend) p8_load(F, XBC, item + istep, co, tr, nxt);
        float o[4][8];
#pragma unroll
        for (int j = 0; j < 4; ++j)
#pragma unroll
            for (int e = 0; e < 8; ++e) o[j][e] = cur.bias[e >> 2][e & 3];
#pragma unroll
        for (int k = 0; k < 8; ++k) { const float rv[8] = {bf_lo(cur.raw[k].x), bf_hi(cur.raw[k].x), bf_lo(cur.raw[k].y), bf_hi(cur.raw[k].y), bf_lo(cur.raw[k].z), bf_hi(cur.raw[k].z), bf_lo(cur.raw[k].w), bf_hi(cur.raw[k].w)};
#pragma unroll
            for (int j = 0; j < 4; ++j) { const int kk = k - j;
                if (kk >= 0 && kk < 5) {
#pragma unroll
                    for (int e = 0; e < 8; ++e) o[j][e] += rv[e] * cur.w[kk][e >> 2][e & 3]; } } }
        unsigned pw[4][4];
#pragma unroll
        for (int j = 0; j < 4; ++j) {
#pragma unroll
            for (int e = 0; e < 8; ++e) o[j][e] = silu_f(o[j][e]);
            pw[j][0] = pk2(o[j][0], o[j][1]); pw[j][1] = pk2(o[j][2], o[j][3]); pw[j][2] = pk2(o[j][4], o[j][5]); pw[j][3] = pk2(o[j][6], o[j][7]); }
        if (cb >= 128) {
            const int cq = cb < 160 ? cb - 128 : cb - 160;
            bf16* dst = (cb < 160 ? BN : CN) + ((size_t)(tb * 8 + (cq >> 2)) * 64 + 4 * tr) * 128 + 32 * (cq & 3) + co * 8;
#pragma unroll
            for (int j = 0; j < 4; ++j) *(v4u*)(dst + (size_t)j * 128) = (v4u){pw[j][0], pw[j][1], pw[j][2], pw[j][3]};
        }
        if (cb < 160) {
#pragma unroll
            for (int e = 0; e < 8; ++e) { const int row = co * 8 + e; LAS bf16* rp = tile + row * 64 + (((tr >> 1) ^ (2 * co)) << 3) + (tr & 1) * 4;
                const unsigned sh = (e & 1) * 16;
                v2u pk; pk.x = ((pw[0][e >> 1] >> sh) & 0xffffu) | (((pw[1][e >> 1] >> sh) & 0xffffu) << 16); pk.y = ((pw[2][e >> 1] >> sh) & 0xffffu) | (((pw[3][e >> 1] >> sh) & 0xffffu) << 16);
                *(LAS v2u*)rp = pk; }
            LDS_WAIT(); asm volatile("" ::: "memory");
            bf16* dstT = cb < 128 ? XT + ((size_t)tb * FW + cb * 32) * 64 : BT + ((size_t)tb * 1024 + (cb - 128) * 32) * 64;
#pragma unroll
            for (int k = 0; k < 4; ++k) { const int row = 8 * k + (F.lane >> 3), oct = F.lane & 7;
                const v4u v = *(const LAS v4u*)(tile + row * 64 + ((oct ^ (2 * (row >> 3))) << 3));
                *(v4u*)(dstT + row * 64 + oct * 8) = v; }
            LDS_WAIT(); asm volatile("" ::: "memory");
        }
        cur = nxt;
    }
    __syncthreads();
}

namespace scan {
constexpr int CL = 64;
constexpr int P272 = 272, P144 = 144;
constexpr int CM_B = 64 * P272, BMT_B = 128 * P144, XT_B = 256 * P144, G_B = 64 * P144;
constexpr int CM_OFF = 0, BM_OFF = 2 * CM_B, BMT_OFF = 4 * CM_B, XT_OFF = BMT_OFF + 2 * BMT_B, G_OFF = XT_OFF + XT_B, TAB_OFF = G_OFF + G_B;
constexpr int TAB_B = 3 * 1024 + 64;
static_assert(TAB_OFF + 2 * TAB_B <= MISC_OFF, "scan LDS map");
__device__ __forceinline__ float softplus_f(float x) { return x > 20.f ? x : log1pf(expf(x)); }
__device__ __forceinline__ void glds16_asm(const char* sbase, unsigned voff, unsigned lds_dst) {
    unsigned keep;
    asm volatile("s_mov_b32 %0, m0\n\ts_mov_b32 m0, %3\n\ts_nop 0\n\tglobal_load_lds_dwordx4 %1, %2\n\ts_mov_b32 m0, %0" : "=&s"(keep) : "v"(voff), "s"(sbase), "s"(lds_dst) : "memory");
}
template <int PITCH>
__device__ __forceinline__ unsigned dma_off(int P, int lane, unsigned rstride) { const int x = 1024 * P + 16 * lane; const int row = x / PITCH; int ch = (x - row * PITCH) >> 4; ch = ch == (PITCH / 16 - 1) ? 0 : ch;
    return (unsigned)row * rstride + (unsigned)ch * 16u; }
template <int NP>
__device__ __forceinline__ void dma_image(LAS unsigned char* img, const char* src, const unsigned (&off)[3], int wid) {
    const unsigned base = (unsigned)(size_t)img;
#pragma unroll
    for (int i = 0; i < 3; ++i) { const int P = wid + 8 * i; if (P < NP) glds16_asm(src, off[i], (unsigned)__builtin_amdgcn_readfirstlane((int)(base + (unsigned)P * 1024u))); }
}
#define LD16(p) (*(const LAS bf16x8*)(p))
#define LD8(p) (*(const LAS v2u*)(p))

struct Scan { int bb, g, dir, nc, row0, hbase, h, tdir; bool smp; };
__device__ __forceinline__ bool scan_decode(const Frame& F, int si, int wid, Scan& d) {
    const bool bal = F.G == 256; const int i = si >> 1; int bb, g, hh;
    if (bal) { const int nu = F.bx < 128 ? 1 : 4; if (i >= nu) return false;
        if (F.bx < 128) { const int u = F.bx; bb = NBP + (u >> 4); g = u & 7; hh = (u >> 3) & 1; }
        else { const int w2 = F.bx - 128, rest = (w2 & 7) | ((w2 >> 4) << 3), idx = rest * 4 + i; hh = (w2 >> 3) & 1; bb = idx >> 3; g = idx & 7; }
    } else { const int u = F.bx + i * F.G; if (u >= 640) return false; if (u < 128) { bb = NBP + (u >> 4); g = (u >> 1) & 7; hh = u & 1; } else { const int p = u - 128; bb = p >> 4; g = (p >> 1) & 7; hh = p & 1; } }
    d.bb = bb; d.g = g; d.dir = si & 1; d.smp = bb >= NBP; d.nc = (d.smp ? LSA : LPR) / CL; d.row0 = row0_of(bb); d.hbase = g * 8 + hh * 4; d.h = d.hbase + (wid >> 1); d.tdir = d.dir * 64; return true;
}
template <int AB>
__device__ __forceinline__ void scan_wg(Frame& F) {
    LAS unsigned char* lds = F.lds;
    const int tid = F.tid, lane = F.lane, wid = F.wave, c16 = lane & 15, q = lane >> 4;
    const char* BNg = (const char*)(F.ws + WS_BN); const char* CNg = (const char*)(F.ws + WS_CN); const char* BTg = (const char*)(F.ws + WS_BT); const bf16* XTg = (const bf16*)(F.ws + WS_XT);
    const bf16* Zg = (const bf16*)(F.ws + WS_Z); const float* DTg = (const float*)(F.ws + WS_DT); bf16* Yg = (bf16*)(F.ws + (AB ? WS_T : WS_Y)); float* SSQ = (float*)(F.ws + (AB ? WS_T + 160 * MiB : WS_SSQ));
    const float* dt_bias = F.ap->in[14]; const float* a_log = F.ap->in[15];
    const int hd = wid >> 1, ph = wid & 1;
    const int chl = hd * 64 + 32 * ph;
    const int aC8 = c16 * P272 + 8 * q;
    const int aR272 = c16 * P272 + 16 * q;
    const int aG8 = c16 * P144 + 8 * q;
    const int prow = chl + 8 * (c16 >> 2) + (c16 & 3);
    const int aX8 = prow * P144 + 8 * q;
    const int aX16 = prow * P144 + 16 * q;
    const int aXe = (chl + 8 * q) * P144 + 2 * c16;
    const int aBT = c16 * P144 + 16 * q;
    unsigned oN[3], oT[3];
#pragma unroll
    for (int i = 0; i < 3; ++i) { oN[i] = dma_off<P272>(wid + 8 * i, lane, 256u); oT[i] = dma_off<P144>(wid + 8 * i, lane, 128u); }
    const size_t xoff = (size_t)(tid >> 3) * 64 + (tid & 7) * 8;
    const int xdst = XT_OFF + (tid >> 3) * P144 + (tid & 7) * 16;
    auto make_tables = [&](float raw, int tb, int dir_, int tdir_, int h_) {
        if (ph == 0) { LAS float* T = (LAS float*)(lds + TAB_OFF + tb * TAB_B); const int ti = hd * 64 + lane;
            const float xr_ = raw + dt_bias[tdir_ + h_]; const float dtv = xr_ > 20.f ? xr_ : __logf(1.0f + __expf(xr_)); const float da = dtv * (-__expf(a_log[tdir_ + h_]));
            float v = da;
#pragma unroll
            for (int o = 1; o < 64; o <<= 1) { const float t = __shfl_up(v, o); if (lane >= o) v += t; }
            const float tot = __shfl(v, 63);
            const float acs = dir_ == 0 ? v : (tot - v + da);
            T[ti] = __log2f(dtv) - acs * 1.4426950408889634f; T[256 + ti] = acs; T[512 + ti] = __expf(tot - acs) * dtv; if (lane == 0) T[768 + hd] = tot; } };
    auto chunk_t0 = [&](const Scan& d, int step) { return d.row0 + (d.dir == 0 ? step : d.nc - 1 - step) * CL; };
    Scan cu, nx; int si = 0, step = 0, flat = 0;
    if (!scan_decode(F, 0, wid, cu)) return;
    v4u xr[4];
    f32x4 S[8][2];
    f32x4 nwv[2]; float dsk = 0.f;
    __syncthreads();
    { const int t0 = chunk_t0(cu, 0); const int g = cu.g;
      const size_t cbk = (size_t)(t0 >> 6);
      dma_image<17>(lds + CM_OFF, CNg + (cbk * 8 + g) * (64 * 128 * 2), oN, wid);
      dma_image<17>(lds + BM_OFF, BNg + (cbk * 8 + g) * (64 * 128 * 2), oN, wid);
      dma_image<18>(lds + BMT_OFF, BTg + (cbk * 1024 + g * 128) * (64 * 2), oT, wid);
#pragma unroll
      for (int i = 0; i < 4; ++i) xr[i] = *(const v4u*)(XTg + xoff + (cbk * FW + cu.hbase * 64 + 64 * i) * 64);
      const float raw = ph == 0 ? DTg[(size_t)(t0 + lane) * 128 + cu.tdir + cu.h] : 0.f;
      make_tables(raw, 0, cu.dir, cu.tdir, cu.h);
      asm volatile("s_waitcnt vmcnt(0) lgkmcnt(0)" ::: "memory");
      __syncthreads(); }
#pragma unroll 1
    for (;;) {
        const int dir = cu.dir, g = cu.g, h = cu.h, bb = cu.bb; const bool smp = cu.smp;
        int sin = si, stepn = step + 1; bool have_next = true; nx = cu;
        if (stepn == cu.nc) { sin = si + 1; stepn = 0; have_next = scan_decode(F, sin, wid, nx); }
        if (step == 0) {
#pragma unroll
            for (int nt = 0; nt < 8; ++nt)
#pragma unroll
                for (int p2 = 0; p2 < 2; ++p2) {
                    if (smp) S[nt][p2] = *(const f32x4*)(F.ap->in[2] + ((((size_t)(bb - NBP) * 2 + dir) * 64 + h) * 64 + 32 * ph + 8 * (c16 >> 2) + 4 * p2 + (c16 & 3)) * 128 + 16 * nt + 4 * q);
                    else S[nt][p2] = (f32x4){0.f, 0.f, 0.f, 0.f}; }
            nwv[0] = *(const f32x4*)(F.ap->in[17] + h * 64 + 32 * ph + 8 * q); nwv[1] = *(const f32x4*)(F.ap->in[17] + h * 64 + 32 * ph + 8 * q + 4);
            dsk = F.ap->in[16][h]; }
        const int b = flat & 1; const int t0 = chunk_t0(cu, step); const int t0n = have_next ? chunk_t0(nx, stepn) : t0;
        LAS unsigned char* CM = lds + CM_OFF + b * CM_B; LAS unsigned char* BMT = lds + BMT_OFF + b * BMT_B; LAS unsigned char* GI = lds + G_OFF;
        const LAS float* T = (const LAS float*)(lds + TAB_OFF + b * TAB_B);
        PB(2);
#pragma unroll
        for (int i = 0; i < 4; ++i) *(LAS v4u*)(lds + xdst + i * (64 * P144)) = xr[i];
        if (have_next) { const int gn = nx.g; const size_t cbk = (size_t)(t0n >> 6);
            dma_image<17>(lds + CM_OFF + (b ^ 1) * CM_B, CNg + (cbk * 8 + gn) * (64 * 128 * 2), oN, wid);
            dma_image<17>(lds + BM_OFF + (b ^ 1) * CM_B, BNg + (cbk * 8 + gn) * (64 * 128 * 2), oN, wid);
            dma_image<18>(lds + BMT_OFF + (b ^ 1) * BMT_B, BTg + (cbk * 1024 + gn * 128) * (64 * 2), oT, wid);
#pragma unroll
            for (int i = 0; i < 4; ++i) xr[i] = *(const v4u*)(XTg + xoff + (cbk * FW + nx.hbase * 64 + 64 * i) * 64); }
        const float raw_next = (have_next && ph == 0) ? DTg[(size_t)(t0n + lane) * 128 + nx.tdir + nx.h] : 0.f;
        PE(2); PB(3);
        { const int lt = wid & 3; bf16x8 cf[4], bfr[2][4];
#pragma unroll
          for (int ks = 0; ks < 4; ++ks) { cf[ks] = LD16(CM + aR272 + lt * (16 * P272) + 64 * ks);
#pragma unroll
              for (int s2 = 0; s2 < 2; ++s2) bfr[s2][ks] = LD16(lds + BM_OFF + b * CM_B + aR272 + (2 * (wid >> 2) + s2) * (16 * P272) + 64 * ks); }
#pragma unroll
          for (int s2 = 0; s2 < 2; ++s2) { f32x4 a = (f32x4){0.f, 0.f, 0.f, 0.f};
#pragma unroll
              for (int ks = 0; ks < 4; ++ks) a = __builtin_amdgcn_mfma_f32_16x16x32_bf16(bfr[s2][ks], cf[ks], a, 0, 0, 0);
              v2u w; w.x = pk2(a[0], a[1]); w.y = pk2(a[2], a[3]);
              *(LAS v2u*)(GI + (16 * lt + c16) * P144 + (16 * (2 * (wid >> 2) + s2) + 4 * q) * 2) = w; } }
        f32x4 acc[2][4];
#pragma unroll
        for (int p2 = 0; p2 < 2; ++p2)
#pragma unroll
            for (int lt = 0; lt < 4; ++lt) acc[p2][lt] = (f32x4){0.f, 0.f, 0.f, 0.f};
#pragma unroll
        for (int ks = 0; ks < 4; ++ks) { bf16x8 a5[2];
#pragma unroll
            for (int p2 = 0; p2 < 2; ++p2) { v4u w; w.x = pk2(S[2 * ks][p2][0], S[2 * ks][p2][1]); w.y = pk2(S[2 * ks][p2][2], S[2 * ks][p2][3]);
                w.z = pk2(S[2 * ks + 1][p2][0], S[2 * ks + 1][p2][1]); w.w = pk2(S[2 * ks + 1][p2][2], S[2 * ks + 1][p2][3]); a5[p2] = __builtin_bit_cast(bf16x8, w); }
#pragma unroll
            for (int lt = 0; lt < 4; ++lt) { const v2u c0 = LD8(CM + aC8 + lt * (16 * P272) + 64 * ks), c1 = LD8(CM + aC8 + lt * (16 * P272) + 64 * ks + 32);
                const bf16x8 b5 = __builtin_bit_cast(bf16x8, (v4u){c0.x, c0.y, c1.x, c1.y});
#pragma unroll
                for (int p2 = 0; p2 < 2; ++p2) acc[p2][lt] = __builtin_amdgcn_mfma_f32_16x16x32_bf16(a5[p2], b5, acc[p2][lt], 0, 0, 0); } }
        float al[4];
#pragma unroll
        for (int lt = 0; lt < 4; ++lt) { al[lt] = T[256 + hd * 64 + 16 * lt + c16]; const float e = __expf(al[lt]); acc[0][lt] = acc[0][lt] * e; acc[1][lt] = acc[1][lt] * e; }
        const size_t go = (size_t)(t0 + c16) * FW + h * 64 + 32 * ph + 8 * q;
        v4u zz[4], yp[4];
#pragma unroll
        for (int lt = 0; lt < 4; ++lt) { zz[lt] = (v4u){0u, 0u, 0u, 0u}; yp[lt] = (v4u){0u, 0u, 0u, 0u}; }
        if (dir == 1 && !(AB & 16)) {
#pragma unroll
            for (int lt = 0; lt < 2; ++lt) { zz[lt] = *(const v4u*)(Zg + go + (size_t)(16 * lt) * FW); yp[lt] = *(const v4u*)(Yg + go + (size_t)(16 * lt) * FW); } }
        PE(3); PB(4);
        asm volatile("s_waitcnt lgkmcnt(0)" ::: "memory"); if (!(AB & 4)) __builtin_amdgcn_s_barrier(); asm volatile("" ::: "memory");
        PE(4); PB(5);
#pragma unroll
        for (int ks = 0; ks < 2; ++ks) { const int s0 = 32 * ks + 4 * q;
            const f32x4 la0 = *(const LAS f32x4*)(T + hd * 64 + s0), la1 = *(const LAS f32x4*)(T + hd * 64 + s0 + 16);
            bf16x8 a3[2];
#pragma unroll
            for (int p2 = 0; p2 < 2; ++p2) { const v2u x0 = LD8(lds + XT_OFF + aX8 + p2 * (4 * P144) + 64 * ks), x1 = LD8(lds + XT_OFF + aX8 + p2 * (4 * P144) + 64 * ks + 32);
                a3[p2] = __builtin_bit_cast(bf16x8, (v4u){x0.x, x0.y, x1.x, x1.y}); }
#pragma unroll
            for (int lt = 0; lt < 4; ++lt) {
                if (dir == 0 ? (ks == 1 && lt < 2) : (ks == 0 && lt >= 2)) continue;
                const v2u g0 = LD8(GI + aG8 + lt * (16 * P144) + 64 * ks), g1 = LD8(GI + aG8 + lt * (16 * P144) + 64 * ks + 32);
                const unsigned gw[4] = {g0.x, g0.y, g1.x, g1.y}; const int lc = 16 * lt + c16; const float al2 = al[lt] * 1.4426950408889634f;
                float f[8];
#pragma unroll
                for (int j = 0; j < 8; ++j) { const int s = s0 + (j & 3) + 16 * (j >> 2); const bool in = dir == 0 ? (s <= lc) : (s >= lc);
                    const float la = j < 4 ? la0[j & 3] : la1[j & 3]; const float gv = (j & 1) ? bf_hi(gw[j >> 1]) : bf_lo(gw[j >> 1]);
                    f[j] = (AB & 2) ? gv : (in ? __builtin_amdgcn_exp2f(al2 + la) * gv : 0.f); }
                v4u bw; bw.x = pk2(f[0], f[1]); bw.y = pk2(f[2], f[3]); bw.z = pk2(f[4], f[5]); bw.w = pk2(f[6], f[7]); const bf16x8 b3 = __builtin_bit_cast(bf16x8, bw);
#pragma unroll
                for (int p2 = 0; p2 < 2; ++p2) acc[p2][lt] = __builtin_amdgcn_mfma_f32_16x16x32_bf16(a3[p2], b3, acc[p2][lt], 0, 0, 0); } }
        PE(5); PB(6);
        asm volatile("s_waitcnt vmcnt(0)" ::: "memory");
        PE(6); PB(7);
        if (dir == 1 && !(AB & 16)) {
#pragma unroll
            for (int lt = 2; lt < 4; ++lt) { zz[lt] = *(const v4u*)(Zg + go + (size_t)(16 * lt) * FW); yp[lt] = *(const v4u*)(Yg + go + (size_t)(16 * lt) * FW); } }
        if (have_next) make_tables(raw_next, b ^ 1, nx.dir, nx.tdir, nx.h);
#pragma unroll
        for (int lt = 0; lt < 4; ++lt) { float ssq = 0.f; v4u o;
            if (dir == 0) { float y[8];
#pragma unroll
                for (int p2 = 0; p2 < 2; ++p2)
#pragma unroll
                    for (int r = 0; r < 4; ++r) y[4 * p2 + r] = acc[p2][lt][r] + dsk * bf2f(*(const LAS bf16*)(lds + XT_OFF + aXe + (4 * p2 + r) * P144 + 32 * lt));
                o.x = pk2(y[0], y[1]); o.y = pk2(y[2], y[3]); o.z = pk2(y[4], y[5]); o.w = pk2(y[6], y[7]);
            } else { const unsigned zw[4] = {zz[lt].x, zz[lt].y, zz[lt].z, zz[lt].w}, yw[4] = {yp[lt].x, yp[lt].y, yp[lt].z, yp[lt].w}; unsigned ow[4];
#pragma unroll
                for (int p2 = 0; p2 < 2; ++p2) { const f32x4 nw = nwv[p2];
                    const float y0 = (acc[p2][lt][0] + bf_lo(yw[2 * p2])) * bf_lo(zw[2 * p2]), y1 = (acc[p2][lt][1] + bf_hi(yw[2 * p2])) * bf_hi(zw[2 * p2]);
                    const float y2 = (acc[p2][lt][2] + bf_lo(yw[2 * p2 + 1])) * bf_lo(zw[2 * p2 + 1]), y3 = (acc[p2][lt][3] + bf_hi(yw[2 * p2 + 1])) * bf_hi(zw[2 * p2 + 1]);
                    ssq += (y0 * y0 + y1 * y1) + (y2 * y2 + y3 * y3);
                    ow[2 * p2] = pk2(y0 * nw[0], y1 * nw[1]); ow[2 * p2 + 1] = pk2(y2 * nw[2], y3 * nw[3]); }
                o = (v4u){ow[0], ow[1], ow[2], ow[3]}; }
            if (!(AB & 16)) *(v4u*)(Yg + go + (size_t)(16 * lt) * FW) = o; else asm volatile("" :: "v"(o.x), "v"(o.y), "v"(o.z), "v"(o.w));
            if (dir == 1) { float v = ssq; v += __shfl_xor(v, 16); v += __shfl_xor(v, 32); if (q == 0) atomicAdd(SSQ + (t0 + 16 * lt + c16), v); } }
        PE(7); PB(8);
        { const float dec = __expf(T[768 + hd]);
#pragma unroll
          for (int nt = 0; nt < 8; ++nt) { S[nt][0] = S[nt][0] * dec; S[nt][1] = S[nt][1] * dec; }
#pragma unroll
          for (int ks = 0; ks < 2; ++ks) { const int s0 = 32 * ks + 8 * q;
              const f32x4 w0 = *(const LAS f32x4*)(T + 512 + hd * 64 + s0), w1 = *(const LAS f32x4*)(T + 512 + hd * 64 + s0 + 4);
              bf16x8 b4[2];
#pragma unroll
              for (int p2 = 0; p2 < 2; ++p2) { const v4u x8 = *(const LAS v4u*)(lds + XT_OFF + aX16 + p2 * (4 * P144) + 64 * ks);
                  v4u w; w.x = pk2(bf_lo(x8.x) * w0[0], bf_hi(x8.x) * w0[1]); w.y = pk2(bf_lo(x8.y) * w0[2], bf_hi(x8.y) * w0[3]);
                  w.z = pk2(bf_lo(x8.z) * w1[0], bf_hi(x8.z) * w1[1]); w.w = pk2(bf_lo(x8.w) * w1[2], bf_hi(x8.w) * w1[3]); b4[p2] = __builtin_bit_cast(bf16x8, w); }
#pragma unroll
              for (int nt = 0; nt < 8; ++nt) { const bf16x8 a4 = LD16(BMT + aBT + nt * (16 * P144) + 64 * ks);
                  S[nt][0] = __builtin_amdgcn_mfma_f32_16x16x32_bf16(a4, b4[0], S[nt][0], 0, 0, 0); S[nt][1] = __builtin_amdgcn_mfma_f32_16x16x32_bf16(a4, b4[1], S[nt][1], 0, 0, 0); } } }
        PE(8); PB(9);
        if (step == cu.nc - 1 && !smp) {
            float* so = AB ? (float*)(F.ws + WS_T + 64 * MiB) : F.out + (size_t)NTOK * DM;
#pragma unroll
            for (int nt = 0; nt < 8; ++nt)
#pragma unroll
                for (int p2 = 0; p2 < 2; ++p2) *(f32x4*)(so + ((((size_t)bb * 2 + dir) * 64 + h) * 64 + 32 * ph + 8 * (c16 >> 2) + 4 * p2 + (c16 & 3)) * 128 + 16 * nt + 4 * q) = S[nt][p2];
        }
        asm volatile("s_waitcnt lgkmcnt(0)" ::: "memory"); if (!(AB & 4)) __builtin_amdgcn_s_barrier(); asm volatile("" ::: "memory");
        PE(9);
        if (!have_next) break;
        cu = nx; si = sin; step = stepn; ++flat;
    }
    __syncthreads();
}
#undef LD16
#undef LD8
template <int AB>
__device__ __forceinline__ void phase(Frame& F) { scan_wg<AB>(F); }
}

__global__ void __launch_bounds__(NTHR, 2) fwd_kernel(Args args) {
    extern __shared__ __attribute__((aligned(16))) unsigned char lds_raw[];
    Frame F;
    F.lds = (LAS unsigned char*)lds_raw; F.pacc = 0; F.pt0 = 0; F.abl = 0;
    F.tid = threadIdx.x; F.lane = F.tid & 63; F.wave = __builtin_amdgcn_readfirstlane(F.tid >> 6); F.G = gridDim.x; F.bx = blockIdx.x;
    F.ap = &args;
    F.out = args.out; F.ws = args.ws;
    volatile LAS unsigned* MISC = (volatile LAS unsigned*)(F.lds + MISC_OFF);
    if (F.tid < 64) MISC[F.tid] = 0u;
    __syncthreads();
    unsigned* ctl = (unsigned*)(F.ws + WS_CTL);
    const int lo = args.ph_lo, hi = args.ph_hi;
    XcdBarrier bar; bar.bar = ctl + CW_BAR; bar.x = 0; bar.st = nullptr;
    if (hi - lo > 1) bar = xcd_barrier_post(ctl + CW_BAR, MISC + 8);
#ifndef ONLY_PHASE
#define ONLY_PHASE -1
#endif
#define IN(k) ((ONLY_PHASE < 0 || ONLY_PHASE == (k)) && lo <= (k) && (k) < hi)
#define SEAM(k) do { if (IN(k) && IN((k) + 1)) xcd_barrier(bar); } while (0)
#ifndef DUP_MASK
#define DUP_MASK 0
#endif
#define REP(k) for (int _rep = 0; _rep < 1 + ((DUP_MASK >> (k)) & 1); ++_rep, __syncthreads())
    bf16* H = (bf16*)(F.ws + WS_H); bf16* U = (bf16*)(F.ws + WS_U); bf16* Z = (bf16*)(F.ws + WS_Z); bf16* T = (bf16*)(F.ws + WS_T); bf16* V = (bf16*)(F.ws + WS_V);
    const float* mod = (const float*)(F.ws + WS_MOD);

    if (IN(0)) REP(0) { PB(20); PB(40); p0_prologue(F); PE(20); } SEAM(0); PE(40);
    if (IN(1)) REP(1) { PB(21); PB(41); p1_ln_mod(F); PE(21); } SEAM(1); PE(41);
    if (IN(2)) REP(2) { PB(22); PB(42); SchedGrid S{H, (const bf16*)(F.ws + WS_WFI), 64, 32, DM, DM, F.G, F.bx}; EpiUZ E{U, Z};
                 if (F.bx & 8) p0_late_weights(F);
                 pg8::gemm_phase<EpiUZ, SchedGrid, GP_ALIGN, GP_SP2>(F.lds, DM, DM, DM, S, E);
                 if (!(F.bx & 8)) p0_late_weights(F); PE(22); } SEAM(2); PE(42);
    if (IN(3)) REP(3) { PB(23); PB(43); SchedCDFT S{(const bf16*)(F.ws + WS_D256), U, F.G, F.bx}; EpiCDFT E{T, (bf16*)(F.ws + WS_NYQ)};
                 pg8::gemm_phase<EpiCDFT, SchedCDFT, GP_ALIGN, GP_SP2>(F.lds, 256, 256, FW, S, E); PE(23); } SEAM(3); PE(43);
    if (IN(4)) REP(4) { PB(24); PB(44); p4_nyquist(F);
                 { SchedLDFT S{(const bf16*)(F.ws + WS_A4S), T, 1, F.G, F.bx}; EpiLDFT E{Z, U, 1.0f / 512.0f};
                   pg8::gemm_phase<EpiLDFT, SchedLDFT, GP_ALIGN, GP_SP2>(F.lds, 2 * LSA, 2 * LSA, 2 * LSA, S, E); }
                 { SchedLDFT S{(const bf16*)(F.ws + WS_A4P), T, 0, F.G, F.bx}; EpiLDFT E{Z, U, 1.0f / 256.0f};
                   pg8::gemm_phase<EpiLDFT, SchedLDFT, GP_ALIGN, GP_SP2>(F.lds, 2 * LPR, 2 * LPR, 2 * LPR, S, E); } PE(24); } SEAM(4); PE(44);
    if (IN(5)) REP(5) { PB(25); PB(45); SchedGrid S{U, (const bf16*)(F.ws + WS_WFO), 64, 8, FW, FW, F.G, F.bx}; EpiRes0 E{F.ap->in[0], F.ap->in[1], (const float*)(F.ws + WS_POS), mod, V};
                 pg8::gemm_phase<EpiRes0, SchedGrid, GP_ALIGN, GP_SP2>(F.lds, FW, FW, FW, S, E); PE(25); } SEAM(5); PE(45);
    if (IN(6)) REP(6) { PB(26); PB(46); p6_ln_ln_mod(F); PE(26); } SEAM(6); PE(46);
    if (IN(7)) REP(7) { PB(27); PB(47); SchedGrid S{H, (const bf16*)(F.ws + WS_WSI), 64, 40, DM, DM, F.G, F.bx}; EpiProj E{Z, (bf16*)(F.ws + WS_XBC), (float*)(F.ws + WS_DT)};
                 pg8::gemm_phase<EpiProj, SchedGrid, GP_ALIGN, GP_SP2>(F.lds, DM, DM, DM, S, E); PE(27); } SEAM(7); PE(47);
    if (IN(8)) REP(8) { PB(28); PB(48);
        const bool dtw = (F.G == 256) && F.bx < 64;
        if (F.G != 256 || dtw) { SchedOne S{H, (const bf16*)(F.ws + WS_WSI), 0, 40, DM, DM}; EpiProj E{Z, (bf16*)(F.ws + WS_XBC), (float*)(F.ws + WS_DT)};
            if (F.G == 256) { S.pm = F.bx; pg8::gemm_phase<EpiProj, SchedOne, GP_ALIGN, GP_SP2>(F.lds, DM, DM, DM, S, E); }
            else for (int pm = F.bx; pm < 64; pm += F.G) { S.pm = pm; pg8::gemm_phase<EpiProj, SchedOne, GP_ALIGN, GP_SP2>(F.lds, DM, DM, DM, S, E); } }
        p8_conv(F); PE(28); } SEAM(8); PE(48);
    if (IN(9)) REP(9) { PB(29); PB(49); PB(1); scan::phase<0>(F); PE(1); PE(29);
        if (ABL) { __syncthreads(); scan::phase<ABL>(F); } } SEAM(9); PE(49);
    if (IN(10)) REP(10) { PB(30); PB(50); SchedGrid S{(const bf16*)(F.ws + WS_Y), (const bf16*)(F.ws + WS_WSO), 64, 8, FW, FW, F.G, F.bx}; EpiRes1 E{mod + 9 * 6144, (const float*)(F.ws + WS_SSQ), V};
                  pg8::gemm_phase<EpiRes1, SchedGrid, GP_ALIGN, GP_SP2>(F.lds, FW, FW, FW, S, E); PE(30); } SEAM(10); PE(50);
    if (IN(11)) REP(11) { PB(31); p11_final_ln(F); PE(31); }
    if (PROF_ID != 0 && F.bx == 0 && F.tid < 64) { const unsigned long long t0 = __builtin_amdgcn_s_memrealtime(), want = F.pacc * PROF_K;
        while (__builtin_amdgcn_s_memrealtime() - t0 < want) __builtin_amdgcn_s_sleep(8); }
#undef IN
#undef SEAM
}


extern "C" void kernel_launch(void* const* d_in, const int* in_sizes, int n_in, void* d_out, int out_size, void* d_ws, size_t ws_size, hipStream_t stream) {
    static int grid = 0;
    if (grid == 0) {
        int dev = 0, cus = 0;
        if (n_in != 19 || ws_size < WS_END || out_size != NTOK * DM + NBP * 2 * 64 * 64 * 128) { fprintf(stderr, "kernel_launch: unexpected shapes (n_in %d, ws %zu, out %d)\n", n_in, ws_size, out_size); grid = -1; return; }
        if (hipGetDevice(&dev) != hipSuccess || hipDeviceGetAttribute(&cus, hipDeviceAttributeMultiprocessorCount, dev) != hipSuccess) { grid = -1; return; }
        if (hipFuncSetAttribute((const void*)fwd_kernel, hipFuncAttributeMaxDynamicSharedMemorySize, LDS_BYTES) != hipSuccess) { fprintf(stderr, "kernel_launch: hipFuncSetAttribute failed\n"); grid = -1; return; }
        grid = cus;
    }
    if (grid < 0) return;
    (void)hipMemsetAsync((char*)d_ws + WS_CTL, 0, CTL_ZERO_BYTES, stream);
    Args a{};
    for (int i = 0; i < 19; ++i) a.in[i] = (const float*)d_in[i];
    a.out = (float*)d_out; a.ws = (unsigned char*)d_ws;
#if MK_PER_PHASE || MK_CHECK
    for (int p = 0; p < NPHASE; ++p) { a.ph_lo = p; a.ph_hi = p + 1; hipLaunchKernelGGL(fwd_kernel, dim3(grid), dim3(NTHR), LDS_BYTES, stream, a);
#if MK_CHECK
        check_after_phase(p, a, stream);
#endif
    }
#if MK_CHECK
    check_report(a, stream);
#endif
#else
    a.ph_lo = 0; a.ph_hi = NPHASE;
    hipLaunchKernelGGL(fwd_kernel, dim3(grid), dim3(NTHR), LDS_BYTES, stream, a);
#endif
}
```
